# Optimizing an MI355X kernel written in HIP

```python
import math
import jax, jax.numpy as jnp
from jax import lax
import numpy as np

D_MODEL = 1024
BATCH = 8
SEQ = 2048
DEPTH = 1

N_META = 16
BLOCK_Q = 128
RMS_EPS = 1e-6

FOX_HEADS = 8
FOX_HEAD_DIM = 64
FOX_WIDTH = FOX_HEADS * FOX_HEAD_DIM
FORGET_BIAS_INIT = 3.0

MLA_HEADS = 8
MLA_Q_RANK = 384
MLA_KV_RANK = 256
MLA_NOPE_DIM = 64
MLA_ROPE_DIM = 32
MLA_QK_DIM = MLA_NOPE_DIM + MLA_ROPE_DIM
MLA_V_DIM = 64
MLA_WIDTH = MLA_HEADS * MLA_V_DIM
ROPE_THETA = 10000.0

MIX_WIDTH = FOX_WIDTH + MLA_WIDTH

IN_SPLITS = [FOX_WIDTH, FOX_WIDTH, FOX_WIDTH, FOX_HEADS, MLA_Q_RANK, MLA_KV_RANK, MLA_ROPE_DIM]
IN_OFFSETS = [sum(IN_SPLITS[:i + 1]) for i in range(len(IN_SPLITS) - 1)]
IN_COLS = sum(IN_SPLITS)

N_GROUPS = 4
EXPERTS_PER_GROUP = 8
N_EXPERTS = N_GROUPS * EXPERTS_PER_GROUP
TOP_K = 2
D_EXPERT = 256

kernel_name = "hymba_fox_mla_hier_moe"


def rmsnorm(x, g):
    xf = x.astype(jnp.float32)
    y = xf * lax.rsqrt(jnp.mean(xf * xf, axis=-1, keepdims=True) + RMS_EPS)
    return (y * g.astype(jnp.float32)).astype(x.dtype)


def rope(x, pos):
    half = x.shape[-1] // 2
    inv_freq = jnp.exp(-math.log(ROPE_THETA) * jnp.arange(half, dtype=jnp.float32) / half)
    ang = pos[:, None] * inv_freq[None, :]
    cos = jnp.cos(ang)[None, :, None, :]
    sin = jnp.sin(ang)[None, :, None, :]
    xf = x.astype(jnp.float32)
    x1, x2 = xf[..., :half], xf[..., half:]
    return jnp.concatenate([x1 * cos - x2 * sin, x1 * sin + x2 * cos], axis=-1).astype(x.dtype)


def blocked_causal_attention(q, k, v, cum=None):
    L = q.shape[2]
    scale = 1.0 / math.sqrt(q.shape[-1])
    bounds = [0] + list(range(N_META, L + 1, BLOCK_Q))
    outs = []
    for s0, s1 in zip(bounds[:-1], bounds[1:]):
        qb = q[:, :, s0:s1]
        kb = k[:, :, :s1]
        vb = v[:, :, :s1]
        logits = jnp.einsum('bhqd,bhkd->bhqk', qb, kb).astype(jnp.float32) * scale
        if cum is not None:
            logits = logits + cum[:, :, s0:s1, None] - cum[:, :, None, :s1]
        causal = jnp.arange(s0, s1)[:, None] >= jnp.arange(s1)[None, :]
        logits = jnp.where(causal[None, None], logits, -jnp.inf)
        probs = jax.nn.softmax(logits, axis=-1).astype(v.dtype)
        outs.append(jnp.einsum('bhqk,bhkd->bhqd', probs, vb))
    return jnp.concatenate(outs, axis=2)


def to_heads(x, n_heads):
    B, L, W = x.shape
    return x.reshape(B, L, n_heads, W // n_heads).transpose(0, 2, 1, 3)


def from_heads(x):
    B, H, L, d = x.shape
    return x.transpose(0, 2, 1, 3).reshape(B, L, H * d)


def mixer_block(h, pos, g_attn, w_in, b_f, g_fox_q, g_fox_k, g_q_lat, w_uq, g_kv_lat, w_ukv,
                g_mla_q, g_mla_k, g_fox_out, g_mla_out, w_o):
    B, L, _ = h.shape
    u = rmsnorm(h, g_attn)
    proj = u @ w_in
    fq, fk, fv, ff, cq, ckv, kr = jnp.split(proj, IN_OFFSETS, axis=-1)

    fq = rmsnorm(to_heads(fq, FOX_HEADS), g_fox_q)
    fk = rmsnorm(to_heads(fk, FOX_HEADS), g_fox_k)
    fv = to_heads(fv, FOX_HEADS)
    log_f = jax.nn.log_sigmoid((ff + b_f).astype(jnp.float32))
    cum = jnp.cumsum(log_f.transpose(0, 2, 1), axis=-1)
    o_fox = from_heads(blocked_causal_attention(fq, fk, fv, cum))

    q = (rmsnorm(cq, g_q_lat) @ w_uq).reshape(B, L, MLA_HEADS, MLA_QK_DIM)
    kv = (rmsnorm(ckv, g_kv_lat) @ w_ukv).reshape(B, L, MLA_HEADS, MLA_NOPE_DIM + MLA_V_DIM)
    k_nope, mv = kv[..., :MLA_NOPE_DIM], kv[..., MLA_NOPE_DIM:]
    k_rope = jnp.broadcast_to(kr[:, :, None, :], (B, L, MLA_HEADS, MLA_ROPE_DIM))
    k = jnp.concatenate([k_nope, k_rope], axis=-1)
    q = rmsnorm(q, g_mla_q)
    k = rmsnorm(k, g_mla_k)
    q = jnp.concatenate([q[..., :MLA_NOPE_DIM], rope(q[..., MLA_NOPE_DIM:], pos)], axis=-1)
    k = jnp.concatenate([k[..., :MLA_NOPE_DIM], rope(k[..., MLA_NOPE_DIM:], pos)], axis=-1)
    o_mla = from_heads(blocked_causal_attention(q.transpose(0, 2, 1, 3), k.transpose(0, 2, 1, 3),
                                                mv.transpose(0, 2, 1, 3)))

    mix = jnp.concatenate([rmsnorm(o_fox, g_fox_out), rmsnorm(o_mla, g_mla_out)], axis=-1)
    return h + mix @ w_o


def hier_moe_block(h, g_ffn, w_group, b_group, w_expert, b_expert, w1, w3, w2):
    B, L, D = h.shape
    u = rmsnorm(h, g_ffn).reshape(B * L, D)
    group_logits = (u @ w_group + b_group).astype(jnp.float32)
    p_group = jax.nn.softmax(group_logits, axis=-1)
    g_idx = jnp.argmax(group_logits, axis=-1)
    p_sel = jnp.max(p_group, axis=-1, keepdims=True)
    exp_logits = (u @ w_expert + b_expert).astype(jnp.float32).reshape(-1, N_GROUPS, EXPERTS_PER_GROUP)
    within = jnp.einsum('tg,tge->te', jax.nn.one_hot(g_idx, N_GROUPS, dtype=jnp.float32), exp_logits)
    top_v, top_i = lax.top_k(within, TOP_K)
    w_sel = jax.nn.softmax(top_v, axis=-1) * p_sel
    e_idx = g_idx[:, None] * EXPERTS_PER_GROUP + top_i
    combine = jnp.sum(jax.nn.one_hot(e_idx, N_EXPERTS, dtype=jnp.float32) * w_sel[..., None], axis=1)
    combine = combine.astype(u.dtype)
    y = jnp.zeros_like(u)
    for e in range(N_EXPERTS):
        hid = jax.nn.silu(u @ w1[e]) * (u @ w3[e])
        y = y + combine[:, e:e + 1] * (hid @ w2[e])
    return h + y.reshape(B, L, D)


def setup_inputs(seed: int = 0) -> dict:
    key = jax.random.key(seed)
    ks = jax.random.split(key, 24)
    f32 = jnp.float32

    def nrm(k, shape, scale):
        return jax.random.normal(k, shape, f32) * scale

    def gain(k, shape):
        return 1.0 + 0.02 * jax.random.normal(k, shape, f32)

    return {
        "x": nrm(ks[0], (BATCH, SEQ, D_MODEL), 1.0),
        "meta_tokens": nrm(ks[1], (N_META, D_MODEL), 1.0),
        "g_attn": gain(ks[2], (DEPTH, D_MODEL)),
        "w_in": nrm(ks[3], (DEPTH, D_MODEL, IN_COLS), D_MODEL ** -0.5),
        "b_f": FORGET_BIAS_INIT + 0.1 * jax.random.normal(ks[4], (DEPTH, FOX_HEADS), f32),
        "g_fox_q": gain(ks[5], (DEPTH, FOX_HEAD_DIM)),
        "g_fox_k": gain(ks[6], (DEPTH, FOX_HEAD_DIM)),
        "g_q_lat": gain(ks[7], (DEPTH, MLA_Q_RANK)),
        "w_uq": nrm(ks[8], (DEPTH, MLA_Q_RANK, MLA_HEADS * MLA_QK_DIM), MLA_Q_RANK ** -0.5),
        "g_kv_lat": gain(ks[9], (DEPTH, MLA_KV_RANK)),
        "w_ukv": nrm(ks[10], (DEPTH, MLA_KV_RANK, MLA_HEADS * (MLA_NOPE_DIM + MLA_V_DIM)), MLA_KV_RANK ** -0.5),
        "g_mla_q": gain(ks[11], (DEPTH, MLA_QK_DIM)),
        "g_mla_k": gain(ks[12], (DEPTH, MLA_QK_DIM)),
        "g_fox_out": gain(ks[13], (DEPTH, FOX_WIDTH)),
        "g_mla_out": gain(ks[14], (DEPTH, MLA_WIDTH)),
        "w_o": nrm(ks[15], (DEPTH, MIX_WIDTH, D_MODEL), MIX_WIDTH ** -0.5),
        "g_ffn": gain(ks[16], (DEPTH, D_MODEL)),
        "w_group": nrm(ks[17], (DEPTH, D_MODEL, N_GROUPS), D_MODEL ** -0.5),
        "b_group": nrm(ks[18], (DEPTH, N_GROUPS), 0.01),
        "w_expert": nrm(ks[19], (DEPTH, D_MODEL, N_EXPERTS), D_MODEL ** -0.5),
        "b_expert": nrm(ks[20], (DEPTH, N_EXPERTS), 0.01),
        "w1": nrm(ks[21], (DEPTH, N_EXPERTS, D_MODEL, D_EXPERT), D_MODEL ** -0.5),
        "w3": nrm(ks[22], (DEPTH, N_EXPERTS, D_MODEL, D_EXPERT), D_MODEL ** -0.5),
        "w2": nrm(ks[23], (DEPTH, N_EXPERTS, D_EXPERT, D_MODEL), D_EXPERT ** -0.5),
    }


def reference(x, meta_tokens, g_attn, w_in, b_f, g_fox_q, g_fox_k, g_q_lat, w_uq, g_kv_lat, w_ukv,
              g_mla_q, g_mla_k, g_fox_out, g_mla_out, w_o, g_ffn, w_group, b_group, w_expert,
              b_expert, w1, w3, w2):
    B = x.shape[0]
    meta = jnp.broadcast_to(meta_tokens[None].astype(x.dtype), (B, N_META, x.shape[-1]))
    h = jnp.concatenate([meta, x], axis=1)
    pos = jnp.arange(h.shape[1], dtype=jnp.float32)
    for i in range(DEPTH):
        h = mixer_block(h, pos, g_attn[i], w_in[i], b_f[i], g_fox_q[i], g_fox_k[i], g_q_lat[i], w_uq[i],
                        g_kv_lat[i], w_ukv[i], g_mla_q[i], g_mla_k[i], g_fox_out[i], g_mla_out[i], w_o[i])
        h = hier_moe_block(h, g_ffn[i], w_group[i], b_group[i], w_expert[i], b_expert[i],
                           w1[i], w3[i], w2[i])
    return h[:, N_META:]
```

```cpp
#include <hip/hip_runtime.h>
#include <cstdio>
#include <cstdint>
#include <cmath>

namespace nv {
constexpr int D_MODEL = 1024, BATCH = 8, SEQ = 2048, N_META = 16, L = SEQ + N_META;
constexpr int FOX_H = 8, FOX_D = 64, FOX_W = 512;
constexpr int MLA_H = 8, QR = 384, KVR = 256, NOPE = 64, ROPE = 32, QK = 96, VD = 64, MLA_W = 512;
constexpr int IN_COLS = 2216;
constexpr int OFF_FQ = 0, OFF_FK = 512, OFF_FV = 1024, OFF_FF = 1536, OFF_CQ = 1544, OFF_CKV = 1928, OFF_KR = 2184;
constexpr int NG = 4, EPG = 8, NE = 32, DE = 256;
constexpr float EPS = 1e-6f;

__device__ __forceinline__ float wave_sum(float v) {
#pragma unroll
    for (int o = 1; o < 64; o <<= 1) v += __shfl_xor(v, o);
    return v;
}
__device__ __forceinline__ float block_sum256(float v, float* red) {
    v = wave_sum(v);
    __syncthreads();
    if ((threadIdx.x & 63) == 0) red[threadIdx.x >> 6] = v;
    __syncthreads();
    return red[0] + red[1] + red[2] + red[3];
}

__global__ void k_rms_in(const float* __restrict__ x, const float* __restrict__ meta, const float* __restrict__ g, float* __restrict__ u, int b) {
    __shared__ float red[4];
    const int r = blockIdx.x;
    const float* src = r < N_META ? meta + (size_t)r * D_MODEL : x + ((size_t)b * SEQ + (r - N_META)) * D_MODEL;
    float v[4]; float ss = 0.f;
#pragma unroll
    for (int i = 0; i < 4; ++i) { v[i] = src[threadIdx.x + 256 * i]; ss += v[i] * v[i]; }
    ss = block_sum256(ss, red);
    const float rs = 1.0f / sqrtf(ss * (1.0f / D_MODEL) + EPS);
#pragma unroll
    for (int i = 0; i < 4; ++i) u[(size_t)r * D_MODEL + threadIdx.x + 256 * i] = v[i] * rs * g[threadIdx.x + 256 * i];
}
__global__ void k_rms_rows(const float* __restrict__ in, int ld, int off, int n, const float* __restrict__ g, float* __restrict__ out, int ldo, int offo) {
    __shared__ float red[4];
    const int r = blockIdx.x;
    float ss = 0.f;
    for (int i = threadIdx.x; i < n; i += 256) { const float v = in[(size_t)r * ld + off + i]; ss += v * v; }
    ss = block_sum256(ss, red);
    const float rs = 1.0f / sqrtf(ss / (float)n + EPS);
    for (int i = threadIdx.x; i < n; i += 256) out[(size_t)r * ldo + offo + i] = in[(size_t)r * ld + off + i] * rs * g[i];
}

__global__ void k_gemm(const float* __restrict__ A, int lda, const float* __restrict__ B, int ldb, float* __restrict__ C, int ldc, const float* __restrict__ R, int ldr, int M, int N, int K) {
    __shared__ float As[16][65];
    __shared__ float Bs[16][65];
    const int tx = threadIdx.x & 15, ty = threadIdx.x >> 4;
    const int m0 = blockIdx.y * 64, n0 = blockIdx.x * 64;
    float acc[4][4] = {};
    for (int k0 = 0; k0 < K; k0 += 16) {
        for (int i = threadIdx.x; i < 64 * 16; i += 256) {
            const int mm = i >> 4, kk = i & 15;
            As[kk][mm] = (m0 + mm < M) ? A[(size_t)(m0 + mm) * lda + k0 + kk] : 0.f;
        }
        for (int i = threadIdx.x; i < 64 * 16; i += 256) {
            const int kk = i >> 6, nn = i & 63;
            Bs[kk][nn] = (n0 + nn < N) ? B[(size_t)(k0 + kk) * ldb + n0 + nn] : 0.f;
        }
        __syncthreads();
#pragma unroll
        for (int kk = 0; kk < 16; ++kk) {
            float a[4], bb[4];
#pragma unroll
            for (int i = 0; i < 4; ++i) { a[i] = As[kk][ty * 4 + i]; bb[i] = Bs[kk][tx * 4 + i]; }
#pragma unroll
            for (int i = 0; i < 4; ++i)
#pragma unroll
                for (int j = 0; j < 4; ++j) acc[i][j] += a[i] * bb[j];
        }
        __syncthreads();
    }
#pragma unroll
    for (int i = 0; i < 4; ++i)
#pragma unroll
        for (int j = 0; j < 4; ++j) {
            const int m = m0 + ty * 4 + i, n = n0 + tx * 4 + j;
            if (m < M && n < N) C[(size_t)m * ldc + n] = acc[i][j] + (R ? R[(size_t)m * ldr + n] : 0.f);
        }
}

__device__ __forceinline__ float log_sigmoid(float x) { return fminf(x, 0.f) - log1pf(expf(-fabsf(x))); }

__global__ void k_fox_prep(float* __restrict__ proj, const float* __restrict__ gq, const float* __restrict__ gk, const float* __restrict__ bf, float* __restrict__ logf) {
    const int r = blockIdx.x, h = threadIdx.x >> 6, d = threadIdx.x & 63;
    float* row = proj + (size_t)r * IN_COLS;
    float q = row[OFF_FQ + h * 64 + d], k = row[OFF_FK + h * 64 + d];
    const float sq = wave_sum(q * q), sk = wave_sum(k * k);
    row[OFF_FQ + h * 64 + d] = q * (1.0f / sqrtf(sq * (1.0f / 64) + EPS)) * gq[d];
    row[OFF_FK + h * 64 + d] = k * (1.0f / sqrtf(sk * (1.0f / 64) + EPS)) * gk[d];
    if (d == 0) logf[r * 8 + h] = log_sigmoid(row[OFF_FF + h] + bf[h]);
}
__global__ void k_cumsum(const float* __restrict__ logf, float* __restrict__ cum) {
    const int h = threadIdx.x; float c = 0.f;
    for (int r = 0; r < L; ++r) { c += logf[r * 8 + h]; cum[h * L + r] = c; }
}

__global__ void k_attn(const float* __restrict__ q, int ldq, int hq, const float* __restrict__ k, int ldk, int hk, const float* __restrict__ v, int ldv, int hv,
                       int dk, float scale, const float* __restrict__ cum, float* __restrict__ o, int ldo) {
    __shared__ float sc[L];
    __shared__ float qs[96];
    __shared__ float red[4];
    __shared__ float part[4][64];
    const int t = blockIdx.x, h = blockIdx.y, tid = threadIdx.x;
    if (tid < dk) qs[tid] = q[(size_t)t * ldq + h * hq + tid];
    __syncthreads();
    const float ct = cum ? cum[h * L + t] : 0.f;
    float mx = -INFINITY;
    for (int s = tid; s <= t; s += 256) {
        const float* kr = k + (size_t)s * ldk + h * hk;
        float a = 0.f;
        for (int d = 0; d < dk; ++d) a += qs[d] * kr[d];
        a *= scale;
        if (cum) a += ct - cum[h * L + s];
        sc[s] = a; mx = fmaxf(mx, a);
    }
#pragma unroll
    for (int off = 1; off < 64; off <<= 1) mx = fmaxf(mx, __shfl_xor(mx, off));
    __syncthreads();
    if ((tid & 63) == 0) red[tid >> 6] = mx;
    __syncthreads();
    mx = fmaxf(fmaxf(red[0], red[1]), fmaxf(red[2], red[3]));
    float sum = 0.f;
    for (int s = tid; s <= t; s += 256) { const float p = expf(sc[s] - mx); sc[s] = p; sum += p; }
    sum = block_sum256(sum, red);
    const int d = tid & 63, gq = tid >> 6;
    float acc = 0.f;
    for (int s = gq; s <= t; s += 4) acc += sc[s] * v[(size_t)s * ldv + h * hv + d];
    part[gq][d] = acc;
    __syncthreads();
    if (tid < 64) o[(size_t)t * ldo + h * 64 + tid] = (part[0][tid] + part[1][tid] + part[2][tid] + part[3][tid]) / sum;
}

__global__ void k_mla_prep(const float* __restrict__ qup, const float* __restrict__ kvup, const float* __restrict__ proj, const float* __restrict__ gq, const float* __restrict__ gk,
                           float* __restrict__ mq, float* __restrict__ mk) {
    __shared__ float sq[8][96], sk[8][96];
    __shared__ float rq[8], rk[8];
    const int r = blockIdx.x, h = threadIdx.x / 96, j = threadIdx.x % 96;
    const float qv = qup[(size_t)r * 768 + h * 96 + j];
    const float kv = j < 64 ? kvup[(size_t)r * 1024 + h * 128 + j] : proj[(size_t)r * IN_COLS + OFF_KR + (j - 64)];
    sq[h][j] = qv; sk[h][j] = kv;
    __syncthreads();
    if (j == 0) { float a = 0.f, b = 0.f; for (int i = 0; i < 96; ++i) { a += sq[h][i] * sq[h][i]; b += sk[h][i] * sk[h][i]; }
        rq[h] = 1.0f / sqrtf(a * (1.0f / 96) + EPS); rk[h] = 1.0f / sqrtf(b * (1.0f / 96) + EPS); }
    __syncthreads();
    sq[h][j] = qv * rq[h] * gq[j]; sk[h][j] = kv * rk[h] * gk[j];
    __syncthreads();
    float oq = sq[h][j], ok = sk[h][j];
    if (j >= 64) {
        const int i = (j - 64) & 15; const bool second = (j - 64) >= 16;
        const float inv_freq = expf(-logf(10000.0f) * (float)i / 16.0f);
        const float ang = (float)r * inv_freq, c = cosf(ang), s = sinf(ang);
        const float q1 = sq[h][64 + i], q2 = sq[h][80 + i], k1 = sk[h][64 + i], k2 = sk[h][80 + i];
        oq = second ? q1 * s + q2 * c : q1 * c - q2 * s;
        ok = second ? k1 * s + k2 * c : k1 * c - k2 * s;
    }
    mq[(size_t)r * 768 + h * 96 + j] = oq; mk[(size_t)r * 768 + h * 96 + j] = ok;
}

__global__ void k_res_rms(const float* __restrict__ x, const float* __restrict__ meta, const float* __restrict__ att, const float* __restrict__ g, float* __restrict__ h1, float* __restrict__ u2, int b) {
    __shared__ float red[4];
    const int r = blockIdx.x;
    const float* src = r < N_META ? meta + (size_t)r * D_MODEL : x + ((size_t)b * SEQ + (r - N_META)) * D_MODEL;
    float v[4]; float ss = 0.f;
#pragma unroll
    for (int i = 0; i < 4; ++i) { v[i] = src[threadIdx.x + 256 * i] + att[(size_t)r * D_MODEL + threadIdx.x + 256 * i]; ss += v[i] * v[i]; h1[(size_t)r * D_MODEL + threadIdx.x + 256 * i] = v[i]; }
    ss = block_sum256(ss, red);
    const float rs = 1.0f / sqrtf(ss * (1.0f / D_MODEL) + EPS);
#pragma unroll
    for (int i = 0; i < 4; ++i) u2[(size_t)r * D_MODEL + threadIdx.x + 256 * i] = v[i] * rs * g[threadIdx.x + 256 * i];
}

__global__ void k_moe(const float* __restrict__ u2, const float* __restrict__ h1, const float* __restrict__ wg, const float* __restrict__ bg, const float* __restrict__ we, const float* __restrict__ be,
                      const float* __restrict__ w1, const float* __restrict__ w3, const float* __restrict__ w2, float* __restrict__ out, int b) {
    __shared__ float us[D_MODEL];
    __shared__ float lg[36];
    __shared__ float hid[DE];
    __shared__ int eidx[2];
    __shared__ float wsel[2];
    const int r = blockIdx.x + N_META, tid = threadIdx.x;
#pragma unroll
    for (int i = 0; i < 4; ++i) us[tid + 256 * i] = u2[(size_t)r * D_MODEL + tid + 256 * i];
    __syncthreads();
    if (tid < 36) {
        float a = 0.f;
        if (tid < 4) { for (int k = 0; k < D_MODEL; ++k) a += us[k] * wg[k * NG + tid]; a += bg[tid]; }
        else { const int e = tid - 4; for (int k = 0; k < D_MODEL; ++k) a += us[k] * we[k * NE + e]; a += be[e]; }
        lg[tid] = a;
    }
    __syncthreads();
    if (tid == 0) {
        int gi = 0; float gm = lg[0];
        for (int i = 1; i < 4; ++i) if (lg[i] > gm) { gm = lg[i]; gi = i; }
        float den = 0.f; for (int i = 0; i < 4; ++i) den += expf(lg[i] - gm);
        const float psel = 1.0f / den;
        const float* w = lg + 4 + gi * 8;
        int i0 = 0; for (int i = 1; i < 8; ++i) if (w[i] > w[i0]) i0 = i;
        int i1 = -1; for (int i = 0; i < 8; ++i) if (i != i0 && (i1 < 0 || w[i] > w[i1])) i1 = i;
        const float e1 = expf(w[i1] - w[i0]);
        wsel[0] = psel / (1.0f + e1); wsel[1] = psel * e1 / (1.0f + e1);
        eidx[0] = gi * 8 + i0; eidx[1] = gi * 8 + i1;
    }
    __syncthreads();
    float y[4] = {0.f, 0.f, 0.f, 0.f};
    for (int j = 0; j < 2; ++j) {
        const int e = eidx[j]; const float ws = wsel[j];
        const float* W1 = w1 + (size_t)e * D_MODEL * DE; const float* W3 = w3 + (size_t)e * D_MODEL * DE; const float* W2 = w2 + (size_t)e * DE * D_MODEL;
        float a = 0.f, c = 0.f;
        for (int k = 0; k < D_MODEL; ++k) { a += us[k] * W1[(size_t)k * DE + tid]; c += us[k] * W3[(size_t)k * DE + tid]; }
        __syncthreads();
        hid[tid] = (a / (1.0f + expf(-a))) * c;
        __syncthreads();
#pragma unroll
        for (int i = 0; i < 4; ++i) { float s = 0.f; for (int k = 0; k < DE; ++k) s += hid[k] * W2[(size_t)k * D_MODEL + tid + 256 * i]; y[i] += ws * s; }
    }
#pragma unroll
    for (int i = 0; i < 4; ++i) out[((size_t)b * SEQ + (r - N_META)) * D_MODEL + tid + 256 * i] = h1[(size_t)r * D_MODEL + tid + 256 * i] + y[i];
}

inline void gemm(hipStream_t st, const float* A, int lda, const float* B, int ldb, float* C, int ldc, const float* R, int ldr, int M, int N, int K) {
    dim3 grid((N + 63) / 64, (M + 63) / 64);
    hipLaunchKernelGGL(k_gemm, grid, dim3(256), 0, st, A, lda, B, ldb, C, ldc, R, ldr, M, N, K);
}

inline void naive_forward(void* const* d_in, float* out, unsigned char* ws, hipStream_t st) {
    const float* x = (const float*)d_in[0]; const float* meta = (const float*)d_in[1]; const float* g_attn = (const float*)d_in[2]; const float* w_in = (const float*)d_in[3];
    const float* b_f = (const float*)d_in[4]; const float* g_fox_q = (const float*)d_in[5]; const float* g_fox_k = (const float*)d_in[6]; const float* g_q_lat = (const float*)d_in[7];
    const float* w_uq = (const float*)d_in[8]; const float* g_kv_lat = (const float*)d_in[9]; const float* w_ukv = (const float*)d_in[10]; const float* g_mla_q = (const float*)d_in[11];
    const float* g_mla_k = (const float*)d_in[12]; const float* g_fox_out = (const float*)d_in[13]; const float* g_mla_out = (const float*)d_in[14]; const float* w_o = (const float*)d_in[15];
    const float* g_ffn = (const float*)d_in[16]; const float* w_group = (const float*)d_in[17]; const float* b_group = (const float*)d_in[18]; const float* w_expert = (const float*)d_in[19];
    const float* b_expert = (const float*)d_in[20]; const float* w1 = (const float*)d_in[21]; const float* w3 = (const float*)d_in[22]; const float* w2 = (const float*)d_in[23];
    size_t off = 0;
    auto carve = [&](size_t nfloats) { float* p = (float*)(ws + off); off += ((nfloats * 4 + 255) / 256) * 256; return p; };
    float* U = carve((size_t)L * D_MODEL); float* PROJ = carve((size_t)L * IN_COLS); float* LOGF = carve((size_t)L * 8); float* CUM = carve((size_t)8 * L);
    float* CQN = carve((size_t)L * QR); float* CKVN = carve((size_t)L * KVR); float* QUP = carve((size_t)L * 768); float* KVUP = carve((size_t)L * 1024);
    float* MQ = carve((size_t)L * 768); float* MK = carve((size_t)L * 768); float* O = carve((size_t)L * 1024); float* MIX = carve((size_t)L * 1024);
    float* ATT = carve((size_t)L * 1024); float* H1 = carve((size_t)L * 1024); float* U2 = carve((size_t)L * 1024);
    for (int b = 0; b < BATCH; ++b) {
        hipLaunchKernelGGL(k_rms_in, dim3(L), dim3(256), 0, st, x, meta, g_attn, U, b);
        gemm(st, U, D_MODEL, w_in, IN_COLS, PROJ, IN_COLS, nullptr, 0, L, IN_COLS, D_MODEL);
        hipLaunchKernelGGL(k_fox_prep, dim3(L), dim3(512), 0, st, PROJ, g_fox_q, g_fox_k, b_f, LOGF);
        hipLaunchKernelGGL(k_cumsum, dim3(1), dim3(8), 0, st, LOGF, CUM);
        hipLaunchKernelGGL(k_attn, dim3(L, 8), dim3(256), 0, st, PROJ + OFF_FQ, IN_COLS, 64, PROJ + OFF_FK, IN_COLS, 64, PROJ + OFF_FV, IN_COLS, 64, 64, 0.125f, CUM, O, 1024);
        hipLaunchKernelGGL(k_rms_rows, dim3(L), dim3(256), 0, st, PROJ, IN_COLS, OFF_CQ, QR, g_q_lat, CQN, QR, 0);
        hipLaunchKernelGGL(k_rms_rows, dim3(L), dim3(256), 0, st, PROJ, IN_COLS, OFF_CKV, KVR, g_kv_lat, CKVN, KVR, 0);
        gemm(st, CQN, QR, w_uq, 768, QUP, 768, nullptr, 0, L, 768, QR);
        gemm(st, CKVN, KVR, w_ukv, 1024, KVUP, 1024, nullptr, 0, L, 1024, KVR);
        hipLaunchKernelGGL(k_mla_prep, dim3(L), dim3(768), 0, st, QUP, KVUP, PROJ, g_mla_q, g_mla_k, MQ, MK);
        hipLaunchKernelGGL(k_attn, dim3(L, 8), dim3(256), 0, st, MQ, 768, 96, MK, 768, 96, KVUP + 64, 1024, 128, 96, 1.0f / sqrtf(96.0f), (const float*)nullptr, O + 512, 1024);
        hipLaunchKernelGGL(k_rms_rows, dim3(L), dim3(256), 0, st, O, 1024, 0, 512, g_fox_out, MIX, 1024, 0);
        hipLaunchKernelGGL(k_rms_rows, dim3(L), dim3(256), 0, st, O, 1024, 512, 512, g_mla_out, MIX, 1024, 512);
        gemm(st, MIX, 1024, w_o, 1024, ATT, 1024, nullptr, 0, L, 1024, 1024);
        hipLaunchKernelGGL(k_res_rms, dim3(L), dim3(256), 0, st, x, meta, ATT, g_ffn, H1, U2, b);
        hipLaunchKernelGGL(k_moe, dim3(SEQ), dim3(256), 0, st, U2, H1, w_group, b_group, w_expert, b_expert, w1, w3, w2, out, b);
    }
}
}

extern "C" void kernel_launch(void* const* d_in, const int* in_sizes, int n_in, void* d_out, int out_size, void* d_ws, size_t ws_size, hipStream_t stream) {
    nv::naive_forward(d_in, (float*)d_out, (unsigned char*)d_ws, stream);
}
```

```cpp
#include <hip/hip_runtime.h>
#include <cstdio>
#include <cstdint>
#include <cmath>
#ifndef DEBUG_STAGE
#define DEBUG_STAGE 0
#endif
#undef DEBUG_STAGE
#define DEBUG_STAGE 0
#if DEBUG_STAGE
#ifndef DBG_B
#define DBG_B 7
#endif
namespace nv {
constexpr int D_MODEL = 1024, BATCH = 8, SEQ = 2048, N_META = 16, L = SEQ + N_META;
constexpr int FOX_H = 8, FOX_D = 64, FOX_W = 512;
constexpr int MLA_H = 8, QR = 384, KVR = 256, NOPE = 64, ROPE = 32, QK = 96, VD = 64, MLA_W = 512;
constexpr int IN_COLS = 2216;
constexpr int OFF_FQ = 0, OFF_FK = 512, OFF_FV = 1024, OFF_FF = 1536, OFF_CQ = 1544, OFF_CKV = 1928, OFF_KR = 2184;
constexpr int NG = 4, EPG = 8, NE = 32, DE = 256;
constexpr float EPS = 1e-6f;

__device__ __forceinline__ float wave_sum(float v) {
#pragma unroll
    for (int o = 1; o < 64; o <<= 1) v += __shfl_xor(v, o);
    return v;
}
__device__ __forceinline__ float block_sum256(float v, float* red) {
    v = wave_sum(v);
    __syncthreads();
    if ((threadIdx.x & 63) == 0) red[threadIdx.x >> 6] = v;
    __syncthreads();
    return red[0] + red[1] + red[2] + red[3];
}

__global__ void k_rms_in(const float* __restrict__ x, const float* __restrict__ meta, const float* __restrict__ g, float* __restrict__ u, int b) {
    __shared__ float red[4];
    const int r = blockIdx.x;
    const float* src = r < N_META ? meta + (size_t)r * D_MODEL : x + ((size_t)b * SEQ + (r - N_META)) * D_MODEL;
    float v[4]; float ss = 0.f;
#pragma unroll
    for (int i = 0; i < 4; ++i) { v[i] = src[threadIdx.x + 256 * i]; ss += v[i] * v[i]; }
    ss = block_sum256(ss, red);
    const float rs = 1.0f / sqrtf(ss * (1.0f / D_MODEL) + EPS);
#pragma unroll
    for (int i = 0; i < 4; ++i) u[(size_t)r * D_MODEL + threadIdx.x + 256 * i] = v[i] * rs * g[threadIdx.x + 256 * i];
}
__global__ void k_rms_rows(const float* __restrict__ in, int ld, int off, int n, const float* __restrict__ g, float* __restrict__ out, int ldo, int offo) {
    __shared__ float red[4];
    const int r = blockIdx.x;
    float ss = 0.f;
    for (int i = threadIdx.x; i < n; i += 256) { const float v = in[(size_t)r * ld + off + i]; ss += v * v; }
    ss = block_sum256(ss, red);
    const float rs = 1.0f / sqrtf(ss / (float)n + EPS);
    for (int i = threadIdx.x; i < n; i += 256) out[(size_t)r * ldo + offo + i] = in[(size_t)r * ld + off + i] * rs * g[i];
}

__global__ void k_gemm(const float* __restrict__ A, int lda, const float* __restrict__ B, int ldb, float* __restrict__ C, int ldc, const float* __restrict__ R, int ldr, int M, int N, int K) {
    __shared__ float As[16][65];
    __shared__ float Bs[16][65];
    const int tx = threadIdx.x & 15, ty = threadIdx.x >> 4;
    const int m0 = blockIdx.y * 64, n0 = blockIdx.x * 64;
    float acc[4][4] = {};
    for (int k0 = 0; k0 < K; k0 += 16) {
        for (int i = threadIdx.x; i < 64 * 16; i += 256) {
            const int mm = i >> 4, kk = i & 15;
            As[kk][mm] = (m0 + mm < M) ? A[(size_t)(m0 + mm) * lda + k0 + kk] : 0.f;
        }
        for (int i = threadIdx.x; i < 64 * 16; i += 256) {
            const int kk = i >> 6, nn = i & 63;
            Bs[kk][nn] = (n0 + nn < N) ? B[(size_t)(k0 + kk) * ldb + n0 + nn] : 0.f;
        }
        __syncthreads();
#pragma unroll
        for (int kk = 0; kk < 16; ++kk) {
            float a[4], bb[4];
#pragma unroll
            for (int i = 0; i < 4; ++i) { a[i] = As[kk][ty * 4 + i]; bb[i] = Bs[kk][tx * 4 + i]; }
#pragma unroll
            for (int i = 0; i < 4; ++i)
#pragma unroll
                for (int j = 0; j < 4; ++j) acc[i][j] += a[i] * bb[j];
        }
        __syncthreads();
    }
#pragma unroll
    for (int i = 0; i < 4; ++i)
#pragma unroll
        for (int j = 0; j < 4; ++j) {
            const int m = m0 + ty * 4 + i, n = n0 + tx * 4 + j;
            if (m < M && n < N) C[(size_t)m * ldc + n] = acc[i][j] + (R ? R[(size_t)m * ldr + n] : 0.f);
        }
}

__device__ __forceinline__ float log_sigmoid(float x) { return fminf(x, 0.f) - log1pf(expf(-fabsf(x))); }

__global__ void k_fox_prep(float* __restrict__ proj, const float* __restrict__ gq, const float* __restrict__ gk, const float* __restrict__ bf, float* __restrict__ logf) {
    const int r = blockIdx.x, h = threadIdx.x >> 6, d = threadIdx.x & 63;
    float* row = proj + (size_t)r * IN_COLS;
    float q = row[OFF_FQ + h * 64 + d], k = row[OFF_FK + h * 64 + d];
    const float sq = wave_sum(q * q), sk = wave_sum(k * k);
    row[OFF_FQ + h * 64 + d] = q * (1.0f / sqrtf(sq * (1.0f / 64) + EPS)) * gq[d];
    row[OFF_FK + h * 64 + d] = k * (1.0f / sqrtf(sk * (1.0f / 64) + EPS)) * gk[d];
    if (d == 0) logf[r * 8 + h] = log_sigmoid(row[OFF_FF + h] + bf[h]);
}
__global__ void k_cumsum(const float* __restrict__ logf, float* __restrict__ cum) {
    const int h = threadIdx.x; float c = 0.f;
    for (int r = 0; r < L; ++r) { c += logf[r * 8 + h]; cum[h * L + r] = c; }
}

__global__ void k_attn(const float* __restrict__ q, int ldq, int hq, const float* __restrict__ k, int ldk, int hk, const float* __restrict__ v, int ldv, int hv,
                       int dk, float scale, const float* __restrict__ cum, float* __restrict__ o, int ldo) {
    __shared__ float sc[L];
    __shared__ float qs[96];
    __shared__ float red[4];
    __shared__ float part[4][64];
    const int t = blockIdx.x, h = blockIdx.y, tid = threadIdx.x;
    if (tid < dk) qs[tid] = q[(size_t)t * ldq + h * hq + tid];
    __syncthreads();
    const float ct = cum ? cum[h * L + t] : 0.f;
    float mx = -INFINITY;
    for (int s = tid; s <= t; s += 256) {
        const float* kr = k + (size_t)s * ldk + h * hk;
        float a = 0.f;
        for (int d = 0; d < dk; ++d) a += qs[d] * kr[d];
        a *= scale;
        if (cum) a += ct - cum[h * L + s];
        sc[s] = a; mx = fmaxf(mx, a);
    }
#pragma unroll
    for (int off = 1; off < 64; off <<= 1) mx = fmaxf(mx, __shfl_xor(mx, off));
    __syncthreads();
    if ((tid & 63) == 0) red[tid >> 6] = mx;
    __syncthreads();
    mx = fmaxf(fmaxf(red[0], red[1]), fmaxf(red[2], red[3]));
    float sum = 0.f;
    for (int s = tid; s <= t; s += 256) { const float p = expf(sc[s] - mx); sc[s] = p; sum += p; }
    sum = block_sum256(sum, red);
    const int d = tid & 63, gq = tid >> 6;
    float acc = 0.f;
    for (int s = gq; s <= t; s += 4) acc += sc[s] * v[(size_t)s * ldv + h * hv + d];
    part[gq][d] = acc;
    __syncthreads();
    if (tid < 64) o[(size_t)t * ldo + h * 64 + tid] = (part[0][tid] + part[1][tid] + part[2][tid] + part[3][tid]) / sum;
}

__global__ void k_mla_prep(const float* __restrict__ qup, const float* __restrict__ kvup, const float* __restrict__ proj, const float* __restrict__ gq, const float* __restrict__ gk,
                           float* __restrict__ mq, float* __restrict__ mk) {
    __shared__ float sq[8][96], sk[8][96];
    __shared__ float rq[8], rk[8];
    const int r = blockIdx.x, h = threadIdx.x / 96, j = threadIdx.x % 96;
    const float qv = qup[(size_t)r * 768 + h * 96 + j];
    const float kv = j < 64 ? kvup[(size_t)r * 1024 + h * 128 + j] : proj[(size_t)r * IN_COLS + OFF_KR + (j - 64)];
    sq[h][j] = qv; sk[h][j] = kv;
    __syncthreads();
    if (j == 0) { float a = 0.f, b = 0.f; for (int i = 0; i < 96; ++i) { a += sq[h][i] * sq[h][i]; b += sk[h][i] * sk[h][i]; }
        rq[h] = 1.0f / sqrtf(a * (1.0f / 96) + EPS); rk[h] = 1.0f / sqrtf(b * (1.0f / 96) + EPS); }
    __syncthreads();
    sq[h][j] = qv * rq[h] * gq[j]; sk[h][j] = kv * rk[h] * gk[j];
    __syncthreads();
    float oq = sq[h][j], ok = sk[h][j];
    if (j >= 64) {
        const int i = (j - 64) & 15; const bool second = (j - 64) >= 16;
        const float inv_freq = expf(-logf(10000.0f) * (float)i / 16.0f);
        const float ang = (float)r * inv_freq, c = cosf(ang), s = sinf(ang);
        const float q1 = sq[h][64 + i], q2 = sq[h][80 + i], k1 = sk[h][64 + i], k2 = sk[h][80 + i];
        oq = second ? q1 * s + q2 * c : q1 * c - q2 * s;
        ok = second ? k1 * s + k2 * c : k1 * c - k2 * s;
    }
    mq[(size_t)r * 768 + h * 96 + j] = oq; mk[(size_t)r * 768 + h * 96 + j] = ok;
}

__global__ void k_res_rms(const float* __restrict__ x, const float* __restrict__ meta, const float* __restrict__ att, const float* __restrict__ g, float* __restrict__ h1, float* __restrict__ u2, int b) {
    __shared__ float red[4];
    const int r = blockIdx.x;
    const float* src = r < N_META ? meta + (size_t)r * D_MODEL : x + ((size_t)b * SEQ + (r - N_META)) * D_MODEL;
    float v[4]; float ss = 0.f;
#pragma unroll
    for (int i = 0; i < 4; ++i) { v[i] = src[threadIdx.x + 256 * i] + att[(size_t)r * D_MODEL + threadIdx.x + 256 * i]; ss += v[i] * v[i]; h1[(size_t)r * D_MODEL + threadIdx.x + 256 * i] = v[i]; }
    ss = block_sum256(ss, red);
    const float rs = 1.0f / sqrtf(ss * (1.0f / D_MODEL) + EPS);
#pragma unroll
    for (int i = 0; i < 4; ++i) u2[(size_t)r * D_MODEL + threadIdx.x + 256 * i] = v[i] * rs * g[threadIdx.x + 256 * i];
}

__global__ void k_moe(const float* __restrict__ u2, const float* __restrict__ h1, const float* __restrict__ wg, const float* __restrict__ bg, const float* __restrict__ we, const float* __restrict__ be,
                      const float* __restrict__ w1, const float* __restrict__ w3, const float* __restrict__ w2, float* __restrict__ out, int b, float* __restrict__ yab) {
    __shared__ float us[D_MODEL];
    __shared__ float lg[36];
    __shared__ float hid[DE];
    __shared__ int eidx[2];
    __shared__ float wsel[2];
    const int r = blockIdx.x + N_META, tid = threadIdx.x;
#pragma unroll
    for (int i = 0; i < 4; ++i) us[tid + 256 * i] = u2[(size_t)r * D_MODEL + tid + 256 * i];
    __syncthreads();
    if (tid < 36) {
        float a = 0.f;
        if (tid < 4) { for (int k = 0; k < D_MODEL; ++k) a += us[k] * wg[k * NG + tid]; a += bg[tid]; }
        else { const int e = tid - 4; for (int k = 0; k < D_MODEL; ++k) a += us[k] * we[k * NE + e]; a += be[e]; }
        lg[tid] = a;
    }
    __syncthreads();
    if (tid == 0) {
        int gi = 0; float gm = lg[0];
        for (int i = 1; i < 4; ++i) if (lg[i] > gm) { gm = lg[i]; gi = i; }
        float den = 0.f; for (int i = 0; i < 4; ++i) den += expf(lg[i] - gm);
        const float psel = 1.0f / den;
        const float* w = lg + 4 + gi * 8;
        int i0 = 0; for (int i = 1; i < 8; ++i) if (w[i] > w[i0]) i0 = i;
        int i1 = -1; for (int i = 0; i < 8; ++i) if (i != i0 && (i1 < 0 || w[i] > w[i1])) i1 = i;
        const float e1 = expf(w[i1] - w[i0]);
        wsel[0] = psel / (1.0f + e1); wsel[1] = psel * e1 / (1.0f + e1);
        eidx[0] = gi * 8 + i0; eidx[1] = gi * 8 + i1;
    }
    __syncthreads();
    float y[4] = {0.f, 0.f, 0.f, 0.f};
    for (int j = 0; j < 2; ++j) {
        const int e = eidx[j]; const float ws = wsel[j];
        const float* W1 = w1 + (size_t)e * D_MODEL * DE; const float* W3 = w3 + (size_t)e * D_MODEL * DE; const float* W2 = w2 + (size_t)e * DE * D_MODEL;
        float a = 0.f, c = 0.f;
        for (int k = 0; k < D_MODEL; ++k) { a += us[k] * W1[(size_t)k * DE + tid]; c += us[k] * W3[(size_t)k * DE + tid]; }
        __syncthreads();
        hid[tid] = (a / (1.0f + expf(-a))) * c;
        __syncthreads();
#pragma unroll
        for (int i = 0; i < 4; ++i) { float s = 0.f; for (int k = 0; k < DE; ++k) s += hid[k] * W2[(size_t)k * D_MODEL + tid + 256 * i]; y[i] += ws * s; if (yab) yab[((size_t)j * L + r) * D_MODEL + tid + 256 * i] = ws * s; }
    }
#pragma unroll
    for (int i = 0; i < 4; ++i) out[((size_t)b * SEQ + (r - N_META)) * D_MODEL + tid + 256 * i] = h1[(size_t)r * D_MODEL + tid + 256 * i] + y[i];
}

inline void gemm(hipStream_t st, const float* A, int lda, const float* B, int ldb, float* C, int ldc, const float* R, int ldr, int M, int N, int K) {
    dim3 grid((N + 63) / 64, (M + 63) / 64);
    hipLaunchKernelGGL(k_gemm, grid, dim3(256), 0, st, A, lda, B, ldb, C, ldc, R, ldr, M, N, K);
}

struct Bufs { float *PROJ, *CUM, *QUP, *KVUP, *MK, *O, *H1, *U2, *YAB; };
inline void naive_forward(void* const* d_in, float* out, unsigned char* ws, hipStream_t st, Bufs* bufs) {
    const float* x = (const float*)d_in[0]; const float* meta = (const float*)d_in[1]; const float* g_attn = (const float*)d_in[2]; const float* w_in = (const float*)d_in[3];
    const float* b_f = (const float*)d_in[4]; const float* g_fox_q = (const float*)d_in[5]; const float* g_fox_k = (const float*)d_in[6]; const float* g_q_lat = (const float*)d_in[7];
    const float* w_uq = (const float*)d_in[8]; const float* g_kv_lat = (const float*)d_in[9]; const float* w_ukv = (const float*)d_in[10]; const float* g_mla_q = (const float*)d_in[11];
    const float* g_mla_k = (const float*)d_in[12]; const float* g_fox_out = (const float*)d_in[13]; const float* g_mla_out = (const float*)d_in[14]; const float* w_o = (const float*)d_in[15];
    const float* g_ffn = (const float*)d_in[16]; const float* w_group = (const float*)d_in[17]; const float* b_group = (const float*)d_in[18]; const float* w_expert = (const float*)d_in[19];
    const float* b_expert = (const float*)d_in[20]; const float* w1 = (const float*)d_in[21]; const float* w3 = (const float*)d_in[22]; const float* w2 = (const float*)d_in[23];
    size_t off = 0;
    auto carve = [&](size_t nfloats) { float* p = (float*)(ws + off); off += ((nfloats * 4 + 255) / 256) * 256; return p; };
    float* U = carve((size_t)L * D_MODEL); float* PROJ = carve((size_t)L * IN_COLS); float* LOGF = carve((size_t)L * 8); float* CUM = carve((size_t)8 * L);
    float* CQN = carve((size_t)L * QR); float* CKVN = carve((size_t)L * KVR); float* QUP = carve((size_t)L * 768); float* KVUP = carve((size_t)L * 1024);
    float* MQ = carve((size_t)L * 768); float* MK = carve((size_t)L * 768); float* O = carve((size_t)L * 1024); float* MIX = carve((size_t)L * 1024);
    float* ATT = carve((size_t)L * 1024); float* H1 = carve((size_t)L * 1024); float* U2 = carve((size_t)L * 1024); float* YAB = carve((size_t)2 * L * 1024);
    if (bufs) { bufs->PROJ = PROJ; bufs->CUM = CUM; bufs->QUP = QUP; bufs->KVUP = KVUP; bufs->MK = MK; bufs->O = O; bufs->H1 = H1; bufs->U2 = U2; bufs->YAB = YAB; }
    for (int bi = 0; bi < BATCH; ++bi) {
        const int b = (bi + DBG_B + 1) % BATCH;
        hipLaunchKernelGGL(k_rms_in, dim3(L), dim3(256), 0, st, x, meta, g_attn, U, b);
        gemm(st, U, D_MODEL, w_in, IN_COLS, PROJ, IN_COLS, nullptr, 0, L, IN_COLS, D_MODEL);
        hipLaunchKernelGGL(k_fox_prep, dim3(L), dim3(512), 0, st, PROJ, g_fox_q, g_fox_k, b_f, LOGF);
        hipLaunchKernelGGL(k_cumsum, dim3(1), dim3(8), 0, st, LOGF, CUM);
        hipLaunchKernelGGL(k_attn, dim3(L, 8), dim3(256), 0, st, PROJ + OFF_FQ, IN_COLS, 64, PROJ + OFF_FK, IN_COLS, 64, PROJ + OFF_FV, IN_COLS, 64, 64, 0.125f, CUM, O, 1024);
        hipLaunchKernelGGL(k_rms_rows, dim3(L), dim3(256), 0, st, PROJ, IN_COLS, OFF_CQ, QR, g_q_lat, CQN, QR, 0);
        hipLaunchKernelGGL(k_rms_rows, dim3(L), dim3(256), 0, st, PROJ, IN_COLS, OFF_CKV, KVR, g_kv_lat, CKVN, KVR, 0);
        gemm(st, CQN, QR, w_uq, 768, QUP, 768, nullptr, 0, L, 768, QR);
        gemm(st, CKVN, KVR, w_ukv, 1024, KVUP, 1024, nullptr, 0, L, 1024, KVR);
        hipLaunchKernelGGL(k_mla_prep, dim3(L), dim3(768), 0, st, QUP, KVUP, PROJ, g_mla_q, g_mla_k, MQ, MK);
        hipLaunchKernelGGL(k_attn, dim3(L, 8), dim3(256), 0, st, MQ, 768, 96, MK, 768, 96, KVUP + 64, 1024, 128, 96, 1.0f / sqrtf(96.0f), (const float*)nullptr, O + 512, 1024);
        hipLaunchKernelGGL(k_rms_rows, dim3(L), dim3(256), 0, st, O, 1024, 0, 512, g_fox_out, MIX, 1024, 0);
        hipLaunchKernelGGL(k_rms_rows, dim3(L), dim3(256), 0, st, O, 1024, 512, 512, g_mla_out, MIX, 1024, 512);
        gemm(st, MIX, 1024, w_o, 1024, ATT, 1024, nullptr, 0, L, 1024, 1024);
        hipLaunchKernelGGL(k_res_rms, dim3(L), dim3(256), 0, st, x, meta, ATT, g_ffn, H1, U2, b);
        hipLaunchKernelGGL(k_moe, dim3(SEQ), dim3(256), 0, st, U2, H1, w_group, b_group, w_expert, b_expert, w1, w3, w2, out, b, YAB);
    }
}
}
#endif
namespace pg8 {
#define PG8_LAS __attribute__((address_space(3)))
typedef unsigned short bf16_t;
typedef short bf16x8 __attribute__((ext_vector_type(8)));
typedef float f32x4 __attribute__((ext_vector_type(4)));
typedef unsigned u32x4 __attribute__((ext_vector_type(4)));
typedef unsigned u32x2 __attribute__((ext_vector_type(2)));
constexpr int BM = 256, BK = 64, HALF = 128, HTB = HALF * BK * 2  , STAGE_BYTES = 8 * HTB, NXCD = 8, WGM = 8;

__host__ __device__ __forceinline__ int lds_byte(int r, int c) { const int st = (r >> 4) * 2 + (c >> 5), rr = r & 15, cc = c & 31, ob = rr * 64 + cc * 2; return st * 1024 + (ob ^ (((ob >> 9) & 1) << 5)); }
__host__ __device__ __forceinline__ void stage_rc(int b, int& R, int& C) { const int st = b / 1024, sb = b % 1024, swz = sb ^ (((sb >> 9) & 1) << 5); R = (st >> 1) * 16 + swz / 64; C = (st & 1) * 32 + (swz % 64) / 2; }
__host__ __device__ __forceinline__ int perm32(int rho) { const int n = rho >> 4, i = rho & 15; return 8 * (i >> 2) + 4 * n + (i & 3); }

struct Unit { int pm, pn, ex; const char* A; const char* B; };

struct StaticOrder {
    int nM, nN, nwg, G, c; const char* A; const char* B; size_t tstep;
    __device__ void init(const void* A_, const void* Bt_, int M, int N, int K, int G_, int c_) { nM = M / BM; nN = N / BM; nwg = nM * nN; G = G_; c = c_; A = (const char*)A_; B = (const char*)Bt_; tstep = (size_t)BM * K * 2; }
    __device__ bool next(int i, Unit& u) const {
        const long L = (long)i * G + c; if (L >= nwg) return false;
        int wgid = (int)L; { const int q = nwg / NXCD, r = nwg % NXCD, xcd = wgid % NXCD, off = wgid / NXCD; wgid = (xcd < r ? xcd * (q + 1) : r * (q + 1) + (xcd - r) * q) + off; }
        const int nig = WGM * nN, gid = wgid / nig, fm = gid * WGM, gsz = (nM - fm) < WGM ? (nM - fm) : WGM;
        u.pm = fm + ((wgid % nig) % gsz); u.pn = (wgid % nig) / gsz; u.ex = 0; u.A = A + (size_t)u.pm * tstep; u.B = B + (size_t)u.pn * tstep; return true;
    }
    __device__ __forceinline__ void gather(const Unit&, int, int, int, int, unsigned (&)[4]) const {}
};

__device__ __forceinline__ unsigned cvt_pk_bf16(float lo, float hi) { typedef float f2 __attribute__((ext_vector_type(2))); typedef __bf16 b2 __attribute__((ext_vector_type(2))); f2 v = {lo, hi}; b2 b = __builtin_convertvector(v, b2); return __builtin_bit_cast(unsigned, b); }

template <class Epi, class Sched, bool GATHER = false, bool MID = false>
__device__ __forceinline__ void gemm_phase(PG8_LAS unsigned char* lds, const int K, const Sched& S, const Epi& E) {
    const int tid = threadIdx.x, wid = __builtin_amdgcn_readfirstlane(tid >> 6), lane = tid & 63, wr = wid >> 2, wc = wid & 3, fr = lane & 15, fq = lane >> 4;
    const int nt = K / BK;
    unsigned voffA[2], voffB[2]; int sR[2], sC[2];
#pragma unroll
    for (int i = 0; i < 2; ++i) { int R, C; stage_rc(tid * 16 + i * 8192, R, C); const int Rb = Epi::PERM ? ((R & ~31) + perm32(R & 31)) : R; sR[i] = R; sC[i] = C;
        voffA[i] = (unsigned)(R * K + C) * 2u; voffB[i] = (unsigned)(Rb * K + C) * 2u; }
    const size_t kstep = (size_t)(BK * 2);
    const size_t hstep = (size_t)HALF * K * 2;
    const unsigned ldsw = (unsigned)wid * 1024u;
    const int aoff = lds_byte(wr * 64 + fr, fq * 8), boff = lds_byte(wc * 32 + fr, fq * 8);
#define PG8_SA(b, h) (((b) * 2 + (h)) * HTB)
#define PG8_SB(b, h) ((4 + (b) * 2 + (h)) * HTB)
#define PG8_STAGE(bufoff, gbase, voff) do { _Pragma("unroll") for (int _i = 0; _i < 2; ++_i) \
        __builtin_amdgcn_global_load_lds((const unsigned*)((const char*)(gbase) + (voff)[_i]), (PG8_LAS unsigned*)(lds + (bufoff) + ldsw + _i * 8192), 16, 0, 0); } while (0)
#define PG8_STAGE_A(bufoff, abase, h, NX) do { if constexpr (GATHER) { _Pragma("unroll") for (int _i = 0; _i < 2; ++_i) { const unsigned _o = (NX) ? gN[(h) * 2 + _i] : gC[(h) * 2 + _i]; \
        __builtin_amdgcn_global_load_lds((const unsigned*)((const char*)(abase) + _o), (PG8_LAS unsigned*)(lds + (bufoff) + ldsw + _i * 8192), 16, 0, 0); } } \
        else { PG8_STAGE(bufoff, (abase) + (h) * hstep, voffA); } } while (0)
#define PG8_LDA(dst, b, h) do { _Pragma("unroll") for (int m = 0; m < 4; ++m) _Pragma("unroll") for (int k = 0; k < 2; ++k) dst[m][k] = *(const PG8_LAS bf16x8*)(lds + PG8_SA(b, h) + aoff + m * 2048 + k * 1024); } while (0)
#define PG8_LDB(dst, b, h) do { _Pragma("unroll") for (int n = 0; n < 2; ++n) _Pragma("unroll") for (int k = 0; k < 2; ++k) dst[n][k] = *(const PG8_LAS bf16x8*)(lds + PG8_SB(b, h) + boff + n * 2048 + k * 1024); } while (0)
#define PG8_MMA(ai, bj, At, Bt) do { __builtin_amdgcn_s_setprio(1); _Pragma("unroll") for (int m = 0; m < 4; ++m) _Pragma("unroll") for (int n = 0; n < 2; ++n) _Pragma("unroll") for (int k = 0; k < 2; ++k) \
        acc[ai][bj][m][n] = __builtin_amdgcn_mfma_f32_16x16x32_bf16(Bt[n][k], At[m][k], acc[ai][bj][m][n], 0, 0, 0); __builtin_amdgcn_s_setprio(0); } while (0)
#define PG8_WAIT_V(n) asm volatile("s_waitcnt vmcnt(" #n ")" ::: "memory")
#define PG8_WAIT_L(n) asm volatile("s_waitcnt lgkmcnt(" #n ")" ::: "memory")
#define PG8_BAR __builtin_amdgcn_s_barrier()
#define PG8_SCHED __builtin_amdgcn_sched_barrier(0)
    Unit cur, nxt; int ui = 0;
    if (!S.next(0, cur)) return;
    unsigned gC[4] = {0u, 0u, 0u, 0u}, gN[4] = {0u, 0u, 0u, 0u};
    if constexpr (GATHER) S.gather(cur, sR[0], sC[0], sR[1], sC[1], gC);
    f32x4 acc[2][2][4][2];
#pragma unroll
    for (int a = 0; a < 2; ++a)
#pragma unroll
        for (int b = 0; b < 2; ++b)
#pragma unroll
            for (int m = 0; m < 4; ++m)
#pragma unroll
                for (int n = 0; n < 2; ++n) acc[a][b][m][n] = (f32x4){0.f, 0.f, 0.f, 0.f};
    bf16x8 At[4][2], B0[2][2], B1[2][2];
    const char* cA = cur.A; const char* cB = cur.B;
    PG8_STAGE(PG8_SB(0, 0), cB, voffB); PG8_STAGE(PG8_SB(0, 1), cB + hstep, voffB); PG8_STAGE_A(PG8_SA(0, 0), cA, 0, false); PG8_STAGE_A(PG8_SA(0, 1), cA, 1, false);
    if (wr == 1) PG8_BAR;
    PG8_WAIT_V(2); PG8_BAR;
    PG8_STAGE(PG8_SB(1, 0), cB + kstep, voffB); PG8_STAGE_A(PG8_SA(1, 0), cA + kstep, 0, false); PG8_STAGE(PG8_SB(1, 1), cB + hstep + kstep, voffB);
    PG8_WAIT_V(6); PG8_BAR;
    for (;;) {
        const bool has_next = S.next(ui + 1, nxt);
        if constexpr (GATHER) { if (has_next) S.gather(nxt, sR[0], sC[0], sR[1], sC[1], gN); else { gN[0] = gC[0]; gN[1] = gC[1]; gN[2] = gC[2]; gN[3] = gC[3]; } }
        const char* nA = has_next ? nxt.A : cA; const char* nB = has_next ? nxt.B : cB;
#pragma unroll 1
        for (int t = 0; t < nt; t += 2) {
            const bool last = (t == nt - 2);
            const char* a1 = cA + (size_t)(t + 1) * kstep;
            const char* a2 = last ? nA : cA + (size_t)(t + 2) * kstep; const char* b2 = last ? nB : cB + (size_t)(t + 2) * kstep;
            const char* a3 = a2 + kstep; const char* b3 = b2 + kstep;
            if constexpr (MID) { if (t == nt / 2) E.mid(acc, cur, wr, fr); }
            PG8_LDB(B0, 0, 0); PG8_LDB(B1, 0, 1); PG8_SCHED; PG8_LDA(At, 0, 0); PG8_STAGE_A(PG8_SA(1, 1), a1, 1, false);
            PG8_WAIT_V(8); PG8_WAIT_L(0); PG8_BAR; PG8_MMA(0, 0, At, B0); PG8_MMA(0, 1, At, B1); PG8_BAR; PG8_SCHED;
            PG8_LDA(At, 0, 1); PG8_STAGE(PG8_SB(0, 0), b2, voffB); PG8_STAGE(PG8_SB(0, 1), b2 + hstep, voffB); PG8_STAGE_A(PG8_SA(0, 0), a2, 0, last);
            PG8_WAIT_V(8); PG8_WAIT_L(0); PG8_BAR; PG8_MMA(1, 0, At, B0); PG8_MMA(1, 1, At, B1); PG8_BAR; PG8_SCHED;
            PG8_LDB(B0, 1, 0); PG8_LDB(B1, 1, 1); PG8_SCHED; PG8_LDA(At, 1, 0); PG8_STAGE_A(PG8_SA(0, 1), a2, 1, last);
            PG8_WAIT_V(8); PG8_WAIT_L(0); PG8_BAR; PG8_MMA(0, 0, At, B0); PG8_MMA(0, 1, At, B1); PG8_BAR; PG8_SCHED;
            PG8_LDA(At, 1, 1); PG8_STAGE(PG8_SB(1, 0), b3, voffB); PG8_STAGE(PG8_SB(1, 1), b3 + hstep, voffB); PG8_STAGE_A(PG8_SA(1, 0), a3, 0, last);
            PG8_WAIT_V(8); PG8_WAIT_L(0); PG8_BAR; PG8_MMA(1, 0, At, B0); PG8_MMA(1, 1, At, B1); PG8_BAR; PG8_SCHED;
        }
        if (wr == 0) PG8_BAR;
        E(acc, cur, wr, wc, fr, fq);
        if (!has_next) break;
#pragma unroll
        for (int a = 0; a < 2; ++a)
#pragma unroll
            for (int b = 0; b < 2; ++b)
#pragma unroll
                for (int m = 0; m < 4; ++m)
#pragma unroll
                    for (int n = 0; n < 2; ++n) acc[a][b][m][n] = (f32x4){0.f, 0.f, 0.f, 0.f};
        cur = nxt; cA = nA; cB = nB; ++ui;
        if constexpr (GATHER) { gC[0] = gN[0]; gC[1] = gN[1]; gC[2] = gN[2]; gC[3] = gN[3]; }
        if (wr == 1) PG8_BAR;
    }
    PG8_WAIT_V(0);
    PG8_BAR;
#undef PG8_SA
#undef PG8_SB
#undef PG8_STAGE
#undef PG8_STAGE_A
#undef PG8_LDA
#undef PG8_LDB
#undef PG8_MMA
#undef PG8_WAIT_V
#undef PG8_WAIT_L
#undef PG8_BAR
#undef PG8_SCHED
}
}
namespace mk {
using pg8::bf16_t; using pg8::f32x4; using pg8::u32x4; using pg8::u32x2; using pg8::Unit; using pg8::cvt_pk_bf16;
constexpr int D = 1024, NB = 8, SEQ = 2048, NMETA = 16, LSEQ = SEQ + NMETA;
constexpr int MR = NB * SEQ;
constexpr int MP = MR + 256;
constexpr int NKT = 33;
constexpr int NCF = 9, NCM = 12;
constexpr int NIN = 2304;
constexpr float EPS = 1e-6f;
constexpr float LOG2E = 1.4426950408889634f;
constexpr float C2F = 0.125f * LOG2E;
constexpr float C2M = 0.10206207261596577f * LOG2E;
constexpr int CAP = 16384;
constexpr int NSLOT = 40960;

constexpr size_t MiB = 1u << 20;
constexpr size_t WS_CTL = 0, CTL_BYTES = 1 * MiB;
constexpr int CW_BAR = 4096;
constexpr int CW_CNT = 8192;
constexpr int CW_SSQO = 65536;
constexpr size_t WS_WIN = 1 * MiB, WS_WUQ = 5632 * 1024, WS_WUKV = 6400 * 1024, WS_WO = 7 * MiB, WS_W13 = 9 * MiB, WS_W2 = 41 * MiB;
constexpr size_t WS_ROPE = 57 * MiB;
constexpr size_t WS_LOGF = 58 * MiB, WS_KR = WS_LOGF + 640 * 1024, WS_SSQCQ = WS_KR + 2176 * 1024, WS_SSQCKV = WS_SSQCQ + 640 * 1024, WS_SSQKR = WS_SSQCKV + 320 * 1024;
constexpr size_t WS_TOK = 62 * MiB, WS_LIST = 63 * MiB;
constexpr size_t WS_XN = 66 * MiB;
constexpr size_t WS_O = WS_XN;
constexpr size_t WS_QF = 100 * MiB, WS_KTF = 116 * MiB, WS_VTF = 135 * MiB, WS_CQ = 152 * MiB, WS_CKV = 165 * MiB, WS_QM = 174 * MiB, WS_KTM = 198 * MiB, WS_VTM = 223 * MiB;
constexpr size_t WS_XN2 = 100 * MiB, WS_HD = 132 * MiB, WS_Y = 152 * MiB;
constexpr size_t WS_SNAP = 240 * MiB;
static_assert(WS_WUQ >= WS_WIN + (size_t)NIN * 1024 * 2 && WS_WUKV >= WS_WUQ + 768 * 384 * 2 && WS_WO >= WS_WUKV + 1024 * 256 * 2, "ws map");
static_assert(WS_SSQKR + (size_t)MP * 4 <= WS_TOK && WS_XN + (size_t)MP * D * 2 <= WS_QF, "ws map");
static_assert(WS_KTF + (size_t)64 * NKT * NCF * 1024 <= WS_VTF && WS_VTF + (size_t)64 * NKT * 8192 <= WS_CQ && WS_CQ + (size_t)MP * 384 * 2 <= WS_CKV && WS_CKV + (size_t)MP * 256 * 2 <= WS_QM, "ws map");
static_assert(WS_QM + (size_t)MR * 768 * 2 <= WS_KTM && WS_KTM + (size_t)64 * NKT * NCM * 1024 <= WS_VTM && WS_VTM + (size_t)64 * NKT * 8192 <= WS_SNAP, "ws map");
static_assert(WS_HD + (size_t)NSLOT * 512 <= WS_Y && WS_Y + (size_t)NSLOT * 2048 <= WS_SNAP, "ws map");

__device__ __forceinline__ unsigned f2bf(float f) { unsigned u = __builtin_bit_cast(unsigned, f); return (u + 0x7fffu + ((u >> 16) & 1u)) >> 16; }
__device__ __forceinline__ float bf2f(unsigned short h) { return __builtin_bit_cast(float, (unsigned)h << 16); }
__device__ __forceinline__ float log_sigmoid(float x) { return fminf(x, 0.f) - log1pf(__expf(-fabsf(x))); }

struct Ptrs {
    const float *x, *meta, *g_attn, *w_in, *b_f, *g_fox_q, *g_fox_k, *g_q_lat, *w_uq, *g_kv_lat, *w_ukv, *g_mla_q, *g_mla_k, *g_fox_out, *g_mla_out, *w_o, *g_ffn, *w_group, *b_group, *w_expert, *b_expert, *w1, *w3, *w2;
    float* out; unsigned char* ws;
    __host__ __device__ __forceinline__ bf16_t* WIN() const { return (bf16_t*)(ws + WS_WIN); }
    __host__ __device__ __forceinline__ bf16_t* WUQ() const { return (bf16_t*)(ws + WS_WUQ); }
    __host__ __device__ __forceinline__ bf16_t* WUKV() const { return (bf16_t*)(ws + WS_WUKV); }
    __host__ __device__ __forceinline__ bf16_t* WO() const { return (bf16_t*)(ws + WS_WO); }
    __host__ __device__ __forceinline__ bf16_t* W13() const { return (bf16_t*)(ws + WS_W13); }
    __host__ __device__ __forceinline__ bf16_t* W2() const { return (bf16_t*)(ws + WS_W2); }
    __host__ __device__ __forceinline__ bf16_t* XN() const { return (bf16_t*)(ws + WS_XN); }
    __host__ __device__ __forceinline__ bf16_t* O() const { return (bf16_t*)(ws + WS_O); }
    __host__ __device__ __forceinline__ bf16_t* QF() const { return (bf16_t*)(ws + WS_QF); }
    __host__ __device__ __forceinline__ bf16_t* KTF() const { return (bf16_t*)(ws + WS_KTF); }
    __host__ __device__ __forceinline__ bf16_t* VTF() const { return (bf16_t*)(ws + WS_VTF); }
    __host__ __device__ __forceinline__ bf16_t* CQ() const { return (bf16_t*)(ws + WS_CQ); }
    __host__ __device__ __forceinline__ bf16_t* CKV() const { return (bf16_t*)(ws + WS_CKV); }
    __host__ __device__ __forceinline__ bf16_t* QM() const { return (bf16_t*)(ws + WS_QM); }
    __host__ __device__ __forceinline__ bf16_t* KTM() const { return (bf16_t*)(ws + WS_KTM); }
    __host__ __device__ __forceinline__ bf16_t* VTM() const { return (bf16_t*)(ws + WS_VTM); }
    __host__ __device__ __forceinline__ bf16_t* XN2() const { return (bf16_t*)(ws + WS_XN2); }
    __host__ __device__ __forceinline__ bf16_t* HD() const { return (bf16_t*)(ws + WS_HD); }
    __host__ __device__ __forceinline__ bf16_t* Y() const { return (bf16_t*)(ws + WS_Y); }
    __host__ __device__ __forceinline__ float* ROPE() const { return (float*)(ws + WS_ROPE); }
    __host__ __device__ __forceinline__ float* LOGF() const { return (float*)(ws + WS_LOGF); }
    __host__ __device__ __forceinline__ float* KR() const { return (float*)(ws + WS_KR); }
    __host__ __device__ __forceinline__ float* SSQCQ() const { return (float*)(ws + WS_SSQCQ); }
    __host__ __device__ __forceinline__ float* SSQCKV() const { return (float*)(ws + WS_SSQCKV); }
    __host__ __device__ __forceinline__ float* SSQKR() const { return (float*)(ws + WS_SSQKR); }
    __host__ __device__ __forceinline__ unsigned* ctl() const { return (unsigned*)(ws + WS_CTL); }
    __host__ __device__ __forceinline__ float* SSQO() const { return (float*)(ws + WS_CTL) + CW_SSQO; }
    __host__ __device__ __forceinline__ int* LIST() const { return (int*)(ws + WS_LIST); }
    __host__ __device__ __forceinline__ unsigned* TOK() const { return (unsigned*)(ws + WS_TOK); }
};

__device__ __forceinline__ size_t kt_off(int bh, int s, int chunk, int NC) { return ((((size_t)bh * NKT + (s >> 6)) * NC + chunk) * 64 + (s & 63)) * 8; }
__device__ __forceinline__ size_t vt_off(int bh, int s, int dhalf, int d32) { return (((size_t)bh * NKT + (s >> 6)) * 4096) + dhalf * 2048 + ((s >> 4) & 3) * 512 + (s & 15) * 32 + d32; }

struct EpiInProj {
    static constexpr bool PERM = true;
    Ptrs P;
    __device__ __forceinline__ void operator()(const f32x4 (&acc)[2][2][4][2], const Unit& u, int wr, int wc, int fr, int fq) const {
        const int pn = u.pn; const bool meta = (u.pm == MR / 256);
        const int rowb = u.pm * 256 + wr * 64 + fr;
        if (pn < 6) {
            const int head = 4 * (pn & 1) + wc;
            f32x4 gv[2][2];
            if (pn < 4) { const float* g = pn < 2 ? P.g_fox_q : P.g_fox_k; const float sc = pn < 2 ? C2F : 1.0f;
#pragma unroll
                for (int bj = 0; bj < 2; ++bj)
#pragma unroll
                    for (int n = 0; n < 2; ++n) gv[bj][n] = *(const f32x4*)(g + 32 * bj + 8 * fq + 4 * n) * sc; }
#pragma unroll
            for (int ai = 0; ai < 2; ++ai)
#pragma unroll
                for (int m = 0; m < 4; ++m) {
                    const int row = rowb + ai * 128 + m * 16;
                    float rs = 1.0f;
                    if (pn < 4) { float ss = 0.f;
#pragma unroll
                        for (int bj = 0; bj < 2; ++bj)
#pragma unroll
                            for (int n = 0; n < 2; ++n) { const f32x4 v = acc[ai][bj][m][n]; ss += (v[0] * v[0] + v[1] * v[1]) + (v[2] * v[2] + v[3] * v[3]); }
                        ss += __shfl_xor(ss, 16); ss += __shfl_xor(ss, 32);
                        rs = 1.0f / sqrtf(ss * (1.0f / 64.0f) + EPS); }
                    u32x4 w[2];
#pragma unroll
                    for (int bj = 0; bj < 2; ++bj) { f32x4 v0 = acc[ai][bj][m][0], v1 = acc[ai][bj][m][1];
                        if (pn < 4) { v0 = v0 * rs * gv[bj][0]; v1 = v1 * rs * gv[bj][1]; }
                        w[bj].x = cvt_pk_bf16(v0[0], v0[1]); w[bj].y = cvt_pk_bf16(v0[2], v0[3]); w[bj].z = cvt_pk_bf16(v1[0], v1[1]); w[bj].w = cvt_pk_bf16(v1[2], v1[3]); }
                    if (pn < 2) { if (!meta) {
#pragma unroll
                            for (int bj = 0; bj < 2; ++bj) *(u32x4*)(P.QF() + (size_t)row * 512 + head * 64 + 32 * bj + 8 * fq) = w[bj]; } }
                    else {
                        int b0, b1, s;
                        if (!meta) { b0 = row >> 11; b1 = b0 + 1; s = NMETA + (row & 2047); } else { const int r = row - MR; s = r; b0 = 0; b1 = r < NMETA ? NB : 0; }
                        for (int b = b0; b < b1; ++b) { const int bh = b * 8 + head;
#pragma unroll
                            for (int bj = 0; bj < 2; ++bj) {
                                if (pn < 4) *(u32x4*)(P.KTF() + kt_off(bh, s, 4 * bj + fq, NCF)) = w[bj];
                                else *(u32x4*)(P.VTF() + vt_off(bh, s, bj, 8 * fq)) = w[bj]; } }
                    }
                }
        } else {
            int kind, colb, slot;
            if (pn == 6) { kind = 0; colb = 64 * wc; slot = wc; }
            else if (pn == 7) { if (wc < 2) { kind = 0; colb = 256 + 64 * wc; slot = 4 + wc; } else { kind = 1; colb = 64 * (wc - 2); slot = wc - 2; } }
            else { if (wc < 2) { kind = 1; colb = 128 + 64 * wc; slot = 2 + wc; } else if (wc == 2) { kind = 2; colb = 0; slot = 0; } else { kind = 3; colb = 0; slot = 0; } }
            if (kind == 3) return;
#pragma unroll
            for (int ai = 0; ai < 2; ++ai)
#pragma unroll
                for (int m = 0; m < 4; ++m) {
                    const int row = rowb + ai * 128 + m * 16;
                    if (kind < 2) {
                        float ss = 0.f;
#pragma unroll
                        for (int bj = 0; bj < 2; ++bj)
#pragma unroll
                            for (int n = 0; n < 2; ++n) { const f32x4 v = acc[ai][bj][m][n]; ss += (v[0] * v[0] + v[1] * v[1]) + (v[2] * v[2] + v[3] * v[3]); }
                        ss += __shfl_xor(ss, 16); ss += __shfl_xor(ss, 32);
                        bf16_t* dst = kind == 0 ? P.CQ() + (size_t)row * 384 + colb : P.CKV() + (size_t)row * 256 + colb;
#pragma unroll
                        for (int bj = 0; bj < 2; ++bj) { const f32x4 v0 = acc[ai][bj][m][0], v1 = acc[ai][bj][m][1]; u32x4 w;
                            w.x = cvt_pk_bf16(v0[0], v0[1]); w.y = cvt_pk_bf16(v0[2], v0[3]); w.z = cvt_pk_bf16(v1[0], v1[1]); w.w = cvt_pk_bf16(v1[2], v1[3]);
                            *(u32x4*)(dst + 32 * bj + 8 * fq) = w; }
                        if (fq == 0) { if (kind == 0) P.SSQCQ()[(size_t)row * 8 + slot] = ss; else P.SSQCKV()[(size_t)row * 4 + slot] = ss; }
                    } else {
                        float ss = 0.f;
#pragma unroll
                        for (int n = 0; n < 2; ++n) { const f32x4 v = acc[ai][0][m][n]; ss += (v[0] * v[0] + v[1] * v[1]) + (v[2] * v[2] + v[3] * v[3]); *(f32x4*)(P.KR() + (size_t)row * 32 + 8 * fq + 4 * n) = v; }
                        ss += __shfl_xor(ss, 16); ss += __shfl_xor(ss, 32);
                        if (fq == 0) { P.SSQKR()[row] = ss;
#pragma unroll
                            for (int n = 0; n < 2; ++n) { const f32x4 v = acc[ai][1][m][n]; const f32x4 bf = *(const f32x4*)(P.b_f + 4 * n); f32x4 o;
                                o[0] = log_sigmoid(v[0] + bf[0]); o[1] = log_sigmoid(v[1] + bf[1]); o[2] = log_sigmoid(v[2] + bf[2]); o[3] = log_sigmoid(v[3] + bf[3]);
                                *(f32x4*)(P.LOGF() + (size_t)row * 8 + 4 * n) = o; } }
                    }
                }
        }
    }
};

struct EpiQup {
    static constexpr bool PERM = true;
    Ptrs P;
    __device__ __forceinline__ void operator()(const f32x4 (&acc)[2][2][4][2], const Unit& u, int wr, int wc, int fr, int fq) const {
        const int rowb = u.pm * 256 + wr * 64 + fr, col0 = u.pn * 256 + wc * 32 + 8 * fq;
#pragma unroll
        for (int ai = 0; ai < 2; ++ai)
#pragma unroll
            for (int m = 0; m < 4; ++m) {
                const int row = rowb + ai * 128 + m * 16;
                const f32x4 s0 = *(const f32x4*)(P.SSQCQ() + (size_t)row * 8); const float s4 = P.SSQCQ()[(size_t)row * 8 + 4], s5 = P.SSQCQ()[(size_t)row * 8 + 5];
                const float rs = 1.0f / sqrtf(((s0[0] + s0[1]) + (s0[2] + s0[3]) + (s4 + s5)) * (1.0f / 384.0f) + EPS);
#pragma unroll
                for (int bj = 0; bj < 2; ++bj) { const f32x4 v0 = acc[ai][bj][m][0] * rs, v1 = acc[ai][bj][m][1] * rs; u32x4 w;
                    w.x = cvt_pk_bf16(v0[0], v0[1]); w.y = cvt_pk_bf16(v0[2], v0[3]); w.z = cvt_pk_bf16(v1[0], v1[1]); w.w = cvt_pk_bf16(v1[2], v1[3]);
                    *(u32x4*)(P.QM() + (size_t)row * 768 + col0 + 128 * bj) = w; }
            }
    }
};

struct EpiKvup {
    static constexpr bool PERM = true;
    Ptrs P;
    __device__ __forceinline__ void operator()(const f32x4 (&acc)[2][2][4][2], const Unit& u, int wr, int wc, int fr, int fq) const {
        const bool meta = (u.pm == MR / 256);
        const int rowb = u.pm * 256 + wr * 64 + fr, head = 2 * u.pn + (wc >> 1); const bool isk = (wc & 1) == 0;
        f32x4 gv[2][2], gr[2];
        if (isk) {
#pragma unroll
            for (int bj = 0; bj < 2; ++bj)
#pragma unroll
                for (int n = 0; n < 2; ++n) gv[bj][n] = *(const f32x4*)(P.g_mla_k + 32 * bj + 8 * fq + 4 * n);
            gr[0] = *(const f32x4*)(P.g_mla_k + 64 + 4 * fq); gr[1] = *(const f32x4*)(P.g_mla_k + 80 + 4 * fq); }
#pragma unroll
        for (int ai = 0; ai < 2; ++ai)
#pragma unroll
            for (int m = 0; m < 4; ++m) {
                const int row = rowb + ai * 128 + m * 16;
                const f32x4 sk = *(const f32x4*)(P.SSQCKV() + (size_t)row * 4);
                const float rl = 1.0f / sqrtf(((sk[0] + sk[1]) + (sk[2] + sk[3])) * (1.0f / 256.0f) + EPS);
                f32x4 v[2][2];
#pragma unroll
                for (int bj = 0; bj < 2; ++bj)
#pragma unroll
                    for (int n = 0; n < 2; ++n) v[bj][n] = acc[ai][bj][m][n] * rl;
                int b0, b1, s;
                if (!meta) { b0 = row >> 11; b1 = b0 + 1; s = NMETA + (row & 2047); } else { const int r = row - MR; s = r < NMETA ? r : 0; b0 = 0; b1 = r < NMETA ? NB : 0; }
                if (isk) {
                    float ss = 0.f;
#pragma unroll
                    for (int bj = 0; bj < 2; ++bj)
#pragma unroll
                        for (int n = 0; n < 2; ++n) { const f32x4 q = v[bj][n]; ss += (q[0] * q[0] + q[1] * q[1]) + (q[2] * q[2] + q[3] * q[3]); }
                    ss += __shfl_xor(ss, 16); ss += __shfl_xor(ss, 32);
                    ss += P.SSQKR()[row];
                    const float rk = 1.0f / sqrtf(ss * (1.0f / 96.0f) + EPS);
                    u32x4 w[2];
#pragma unroll
                    for (int bj = 0; bj < 2; ++bj) { const f32x4 v0 = v[bj][0] * rk * gv[bj][0], v1 = v[bj][1] * rk * gv[bj][1];
                        w[bj].x = cvt_pk_bf16(v0[0], v0[1]); w[bj].y = cvt_pk_bf16(v0[2], v0[3]); w[bj].z = cvt_pk_bf16(v1[0], v1[1]); w[bj].w = cvt_pk_bf16(v1[2], v1[3]); }
                    const f32x4 x1 = *(const f32x4*)(P.KR() + (size_t)row * 32 + 4 * fq) * rk * gr[0], x2 = *(const f32x4*)(P.KR() + (size_t)row * 32 + 16 + 4 * fq) * rk * gr[1];
                    const f32x4 cs0 = *(const f32x4*)(P.ROPE() + ((size_t)s * 16 + 4 * fq) * 2), cs1 = *(const f32x4*)(P.ROPE() + ((size_t)s * 16 + 4 * fq) * 2 + 4);
                    const float c0 = cs0[0], n0 = cs0[1], c1 = cs0[2], n1 = cs0[3], c2 = cs1[0], n2 = cs1[1], c3 = cs1[2], n3 = cs1[3];
                    u32x2 r1, r2;
                    r1.x = cvt_pk_bf16(x1[0] * c0 - x2[0] * n0, x1[1] * c1 - x2[1] * n1); r1.y = cvt_pk_bf16(x1[2] * c2 - x2[2] * n2, x1[3] * c3 - x2[3] * n3);
                    r2.x = cvt_pk_bf16(x1[0] * n0 + x2[0] * c0, x1[1] * n1 + x2[1] * c1); r2.y = cvt_pk_bf16(x1[2] * n2 + x2[2] * c2, x1[3] * n3 + x2[3] * c3);
                    for (int b = b0; b < b1; ++b) { const int bh = b * 8 + head;
#pragma unroll
                        for (int bj = 0; bj < 2; ++bj) *(u32x4*)(P.KTM() + kt_off(bh, s, 4 * bj + fq, NCM)) = w[bj];
                        *(u32x2*)(P.KTM() + kt_off(bh, s, 8 + (fq >> 1), NCM) + 4 * (fq & 1)) = r1;
                        *(u32x2*)(P.KTM() + kt_off(bh, s, 10 + (fq >> 1), NCM) + 4 * (fq & 1)) = r2; }
                } else {
                    u32x4 w[2];
#pragma unroll
                    for (int bj = 0; bj < 2; ++bj) { const f32x4 v0 = v[bj][0], v1 = v[bj][1];
                        w[bj].x = cvt_pk_bf16(v0[0], v0[1]); w[bj].y = cvt_pk_bf16(v0[2], v0[3]); w[bj].z = cvt_pk_bf16(v1[0], v1[1]); w[bj].w = cvt_pk_bf16(v1[2], v1[3]); }
                    for (int b = b0; b < b1; ++b) { const int bh = b * 8 + head;
#pragma unroll
                        for (int bj = 0; bj < 2; ++bj) *(u32x4*)(P.VTM() + vt_off(bh, s, bj, 8 * fq)) = w[bj]; }
                }
            }
    }
};

struct EpiOut {
    static constexpr bool PERM = false;
    Ptrs P;
    __device__ __forceinline__ void rstds(int row, float& rf, float& rm) const {
        const float sf = __hip_atomic_load(P.SSQO() + (size_t)row * 2, __ATOMIC_RELAXED, __HIP_MEMORY_SCOPE_AGENT), sm = __hip_atomic_load(P.SSQO() + (size_t)row * 2 + 1, __ATOMIC_RELAXED, __HIP_MEMORY_SCOPE_AGENT);
        rf = 1.0f / sqrtf(sf * (1.0f / 512.0f) + EPS); rm = 1.0f / sqrtf(sm * (1.0f / 512.0f) + EPS);
    }
    __device__ __forceinline__ void mid(f32x4 (&acc)[2][2][4][2], const Unit& u, int wr, int fr) const {
#pragma unroll
        for (int ai = 0; ai < 2; ++ai)
#pragma unroll
            for (int m = 0; m < 4; ++m) { float rf, rm; rstds(u.pm * 256 + ai * 128 + wr * 64 + m * 16 + fr, rf, rm); const float ratio = rf / rm;
#pragma unroll
                for (int bj = 0; bj < 2; ++bj)
#pragma unroll
                    for (int n = 0; n < 2; ++n) acc[ai][bj][m][n] *= ratio; }
    }
    __device__ __forceinline__ void operator()(const f32x4 (&acc)[2][2][4][2], const Unit& u, int wr, int wc, int fr, int fq) const {
        const int col0 = u.pn * 256 + wc * 32 + 4 * fq;
#pragma unroll
        for (int ai = 0; ai < 2; ++ai)
#pragma unroll
            for (int m = 0; m < 4; ++m) { const int row = u.pm * 256 + ai * 128 + wr * 64 + m * 16 + fr; float rf, rm; rstds(row, rf, rm);
                const size_t off = (size_t)row * D + col0;
#pragma unroll
                for (int bj = 0; bj < 2; ++bj)
#pragma unroll
                    for (int n = 0; n < 2; ++n) { const f32x4 xv = *(const f32x4*)(P.x + off + bj * 128 + n * 16); *(f32x4*)(P.out + off + bj * 128 + n * 16) = xv + acc[ai][bj][m][n] * rm; } }
    }
};

struct EpiMoeUp {
    static constexpr bool PERM = true;
    Ptrs P;
    __device__ __forceinline__ void operator()(const f32x4 (&acc)[2][2][4][2], const Unit& u, int wr, int wc, int fr, int fq) const {
        const int col0 = (u.pn & 1) * 128 + wc * 32 + 8 * fq;
#pragma unroll
        for (int ai = 0; ai < 2; ++ai)
#pragma unroll
            for (int m = 0; m < 4; ++m) { const size_t row = (size_t)u.pm * 256 + ai * 128 + wr * 64 + m * 16 + fr; float h[8];
#pragma unroll
                for (int n = 0; n < 2; ++n)
#pragma unroll
                    for (int e = 0; e < 4; ++e) { const float a = acc[ai][0][m][n][e], b = acc[ai][1][m][n][e]; h[4 * n + e] = a * b / (1.0f + __expf(-a)); }
                u32x4 w; w.x = cvt_pk_bf16(h[0], h[1]); w.y = cvt_pk_bf16(h[2], h[3]); w.z = cvt_pk_bf16(h[4], h[5]); w.w = cvt_pk_bf16(h[6], h[7]);
                *(u32x4*)(P.HD() + row * 256 + col0) = w; }
    }
};
struct EpiMoeDown {
    static constexpr bool PERM = true;
    Ptrs P;
    __device__ __forceinline__ void operator()(const f32x4 (&acc)[2][2][4][2], const Unit& u, int wr, int wc, int fr, int fq) const {
        const int col0 = (u.pn & 3) * 256 + wc * 32 + 8 * fq;
#pragma unroll
        for (int ai = 0; ai < 2; ++ai)
#pragma unroll
            for (int m = 0; m < 4; ++m) { const size_t row = (size_t)u.pm * 256 + ai * 128 + wr * 64 + m * 16 + fr;
#pragma unroll
                for (int bj = 0; bj < 2; ++bj) { const f32x4 v0 = acc[ai][bj][m][0], v1 = acc[ai][bj][m][1]; u32x4 w;
                    w.x = cvt_pk_bf16(v0[0], v0[1]); w.y = cvt_pk_bf16(v0[2], v0[3]); w.z = cvt_pk_bf16(v1[0], v1[1]); w.w = cvt_pk_bf16(v1[2], v1[3]);
                    *(u32x4*)(P.Y() + row * 1024 + col0 + 128 * bj) = w; } }
    }
};
}
namespace mk {
typedef short bf16x8 __attribute__((ext_vector_type(8)));
typedef short s16x4 __attribute__((ext_vector_type(4)));
typedef float f32x16 __attribute__((ext_vector_type(16)));
#define MK_LAS __attribute__((address_space(3)))
__device__ __forceinline__ int crow(int r, int hi) { return (r & 3) + 8 * (r >> 2) + 4 * hi; }
__device__ __forceinline__ s16x4 vtr(const MK_LAS char* p) { typedef short v4 __attribute__((ext_vector_type(4))); return __builtin_bit_cast(s16x4, __builtin_amdgcn_ds_read_tr16_b64_v4i16((MK_LAS v4*)p)); }

template <bool MLA>
__device__ __forceinline__ void attn_unit(MK_LAS unsigned char* lds, const Ptrs& P, int b, int h, int qb) {
    constexpr int NC = MLA ? NCM : NCF, NKS = MLA ? 6 : 5, KSL = NC * 1024, VSL = 8192;
    const int tid = threadIdx.x, lane = tid & 63, r32 = lane & 31, hi = lane >> 5; const int wid = __builtin_amdgcn_readfirstlane(tid >> 6);
    const int qi = qb * 256 + wid * 32 + r32;
    const size_t row = (size_t)b * SEQ + qi;
    const int bh = b * 8 + h;
    const bf16_t* Kt = (MLA ? P.KTM() : P.KTF()) + (size_t)bh * NKT * NC * 512;
    const bf16_t* Vt = (MLA ? P.VTM() : P.VTF()) + (size_t)bh * NKT * 4096;
    const int NT = 4 * qb + 5;
#define MK_DMA(t, buf) do { \
        for (int p_ = wid; p_ < NC; p_ += 8) __builtin_amdgcn_global_load_lds((const unsigned*)(Kt + (size_t)(t) * NC * 512 + p_ * 512 + lane * 8), (MK_LAS unsigned*)(lds + (buf) * KSL + p_ * 1024), 16, 0, 0); \
        __builtin_amdgcn_global_load_lds((const unsigned*)(Vt + (size_t)(t) * 4096 + wid * 512 + lane * 8), (MK_LAS unsigned*)(lds + 2 * KSL + (buf) * VSL + wid * 1024), 16, 0, 0); } while (0)
    MK_DMA(0, 0);
    bf16x8 qf[NKS];
    if constexpr (!MLA) {
        const bf16_t* qp = P.QF() + row * 512 + h * 64 + hi * 8;
#pragma unroll
        for (int d0 = 0; d0 < 4; ++d0) qf[d0] = *(const bf16x8*)(qp + d0 * 16);
        const short one = (short)0x3F80;
        qf[4] = hi == 0 ? (bf16x8){one, one, one, 0, 0, 0, 0, 0} : (bf16x8){0, 0, 0, 0, 0, 0, 0, 0};
    } else {
        const bf16_t* qp = P.QM() + row * 768 + h * 96 + hi * 8;
        float v[6][8]; float ss = 0.f;
#pragma unroll
        for (int d0 = 0; d0 < 6; ++d0) { const bf16x8 raw = *(const bf16x8*)(qp + d0 * 16);
#pragma unroll
            for (int j = 0; j < 8; ++j) { v[d0][j] = bf2f((unsigned short)raw[j]); ss += v[d0][j] * v[d0][j]; } }
        ss += __shfl_xor(ss, 32);
        const float rs = 1.0f / sqrtf(ss * (1.0f / 96.0f) + EPS);
#pragma unroll
        for (int d0 = 0; d0 < 6; ++d0)
#pragma unroll
            for (int j = 0; j < 8; ++j) v[d0][j] *= rs * P.g_mla_q[16 * d0 + 8 * hi + j];
        const float* cs = P.ROPE() + ((size_t)(NMETA + qi) * 16 + 8 * hi) * 2;
#pragma unroll
        for (int j = 0; j < 8; ++j) { const float c = cs[2 * j], s = cs[2 * j + 1], x1 = v[4][j], x2 = v[5][j]; v[4][j] = x1 * c - x2 * s; v[5][j] = x1 * s + x2 * c; }
#pragma unroll
        for (int d0 = 0; d0 < 6; ++d0) { u32x4 w; w.x = cvt_pk_bf16(v[d0][0] * C2M, v[d0][1] * C2M); w.y = cvt_pk_bf16(v[d0][2] * C2M, v[d0][3] * C2M); w.z = cvt_pk_bf16(v[d0][4] * C2M, v[d0][5] * C2M); w.w = cvt_pk_bf16(v[d0][6] * C2M, v[d0][7] * C2M);
            qf[d0] = __builtin_bit_cast(bf16x8, w); }
    }
    float mrow = -1e30f, lrow = 0.f; f32x16 o0 = {}, o1 = {};
    const int sq = NMETA + qi;
    const MK_LAS char* kp0 = (const MK_LAS char*)lds + hi * 1024 + r32 * 16;
    const MK_LAS char* kpa = (const MK_LAS char*)lds + 8 * 1024 + r32 * 16;
    const MK_LAS char* vp0 = (const MK_LAS char*)lds + 2 * KSL + ((lane >> 4) & 1) * 32 + (lane & 3) * 8 + (4 * hi + ((lane & 15) >> 2)) * 64;
    asm volatile("s_waitcnt vmcnt(0)" ::: "memory"); __syncthreads();
    for (int t = 0; t < NT; ++t) {
        const int buf = t & 1;
        if (t + 1 < NT) MK_DMA(t + 1, buf ^ 1);
        f32x16 p0 = {}, p1 = {};
#pragma unroll
        for (int ks = 0; ks < NKS; ++ks) {
            const MK_LAS char* kp = (!MLA && ks == 4) ? kpa + buf * KSL : kp0 + buf * KSL + ks * 2048;
            const bf16x8 k0 = *(const MK_LAS bf16x8*)kp, k1 = *(const MK_LAS bf16x8*)(kp + 512);
            p0 = __builtin_amdgcn_mfma_f32_32x32x16_bf16(k0, qf[ks], p0, 0, 0, 0);
            p1 = __builtin_amdgcn_mfma_f32_32x32x16_bf16(k1, qf[ks], p1, 0, 0, 0);
        }
        if (t >= NT - 5) {
            const int kb = 64 * t + 4 * hi;
#pragma unroll
            for (int r = 0; r < 16; ++r) { const int s = kb + (r & 3) + 8 * (r >> 2); if (s > sq) p0[r] = -INFINITY; if (s + 32 > sq) p1[r] = -INFINITY; }
        }
        float rm = fmaxf(p0[0], p1[0]);
#pragma unroll
        for (int r = 1; r < 16; ++r) rm = fmaxf(rm, fmaxf(p0[r], p1[r]));
        rm = fmaxf(rm, __shfl_xor(rm, 32));
        const float mnew = fmaxf(mrow, rm);
        if (__any(mnew > mrow)) { const float alpha = __builtin_amdgcn_exp2f(mrow - mnew); lrow *= alpha;
#pragma unroll
            for (int r = 0; r < 16; ++r) { o0[r] *= alpha; o1[r] *= alpha; }
            mrow = mnew; }
        float rsum = 0.f;
#pragma unroll
        for (int r = 0; r < 16; ++r) { p0[r] = __builtin_amdgcn_exp2f(p0[r] - mrow); p1[r] = __builtin_amdgcn_exp2f(p1[r] - mrow); rsum += p0[r] + p1[r]; }
        lrow += rsum;
        bf16x8 pw[4];
#pragma unroll
        for (int k = 0; k < 2; ++k) { u32x4 a, c;
            a.x = cvt_pk_bf16(p0[8 * k + 0], p0[8 * k + 1]); a.y = cvt_pk_bf16(p0[8 * k + 2], p0[8 * k + 3]); a.z = cvt_pk_bf16(p0[8 * k + 4], p0[8 * k + 5]); a.w = cvt_pk_bf16(p0[8 * k + 6], p0[8 * k + 7]);
            c.x = cvt_pk_bf16(p1[8 * k + 0], p1[8 * k + 1]); c.y = cvt_pk_bf16(p1[8 * k + 2], p1[8 * k + 3]); c.z = cvt_pk_bf16(p1[8 * k + 4], p1[8 * k + 5]); c.w = cvt_pk_bf16(p1[8 * k + 6], p1[8 * k + 7]);
            pw[k] = __builtin_bit_cast(bf16x8, a); pw[2 + k] = __builtin_bit_cast(bf16x8, c); }
        const MK_LAS char* vp = vp0 + buf * VSL;
#pragma unroll
        for (int ks = 0; ks < 4; ++ks) {
            const s16x4 l0 = vtr(vp + ks * 1024), h0 = vtr(vp + ks * 1024 + 512), l1 = vtr(vp + 4096 + ks * 1024), h1 = vtr(vp + 4096 + ks * 1024 + 512);
            const bf16x8 vf0 = {l0[0], l0[1], l0[2], l0[3], h0[0], h0[1], h0[2], h0[3]}, vf1 = {l1[0], l1[1], l1[2], l1[3], h1[0], h1[1], h1[2], h1[3]};
            o0 = __builtin_amdgcn_mfma_f32_32x32x16_bf16(vf0, pw[ks], o0, 0, 0, 0);
            o1 = __builtin_amdgcn_mfma_f32_32x32x16_bf16(vf1, pw[ks], o1, 0, 0, 0);
        }
        asm volatile("s_waitcnt vmcnt(0)" ::: "memory"); __syncthreads();
    }
#undef MK_DMA
    lrow += __shfl_xor(lrow, 32);
    const float inv = 1.0f / lrow; float ssq = 0.f;
    bf16_t* op = P.O() + row * 1024 + (MLA ? 512 : 0) + h * 64 + 4 * hi;
#pragma unroll
    for (int g = 0; g < 4; ++g) {
        const float a0 = o0[4 * g] * inv, a1 = o0[4 * g + 1] * inv, a2 = o0[4 * g + 2] * inv, a3 = o0[4 * g + 3] * inv;
        const float c0 = o1[4 * g] * inv, c1 = o1[4 * g + 1] * inv, c2 = o1[4 * g + 2] * inv, c3 = o1[4 * g + 3] * inv;
        ssq += (a0 * a0 + a1 * a1) + (a2 * a2 + a3 * a3) + (c0 * c0 + c1 * c1) + (c2 * c2 + c3 * c3);
        u32x2 w0, w1; w0.x = cvt_pk_bf16(a0, a1); w0.y = cvt_pk_bf16(a2, a3); w1.x = cvt_pk_bf16(c0, c1); w1.y = cvt_pk_bf16(c2, c3);
        *(u32x2*)(op + 8 * g) = w0; *(u32x2*)(op + 32 + 8 * g) = w1;
    }
    ssq += __shfl_xor(ssq, 32);
    if (hi == 0) atomicAdd(P.SSQO() + row * 2 + (MLA ? 1 : 0), ssq);
}

__device__ __forceinline__ void attn_phase(MK_LAS unsigned char* lds, const Ptrs& P, int vcu, int G) {
    for (int id = vcu; id < 1024; id += G) {
        const int v = id & 255, k = id >> 8, bh = v >> 2, sub = v & 3, qb = (k & 1) ? sub : 7 - sub;
        if (k >> 1) attn_unit<true>(lds, P, bh >> 3, bh & 7, qb); else attn_unit<false>(lds, P, bh >> 3, bh & 7, qb);
    }
}
}
namespace mk {
constexpr int NWAVES = 8;
constexpr int RING_BYTES = 131072, LDSCTL_OFF = RING_BYTES, LDS_BYTES = 147456;
#define GAS __attribute__((address_space(1)))
#define RLX_AGENT __ATOMIC_RELAXED, __HIP_MEMORY_SCOPE_AGENT
#define LDS_WAIT() asm volatile("s_waitcnt lgkmcnt(0)" ::: "memory")

#define XB_TMO      128
#define XB_XCNT(j)  (256  + 64 * (j))
#define XB_XSUB(j)  (1280 + 64 * (j))
#define XB_XGEN(j)  (2304 + 64 * (j))
#define XB_TOP      3328
#define XB_TOPGEN   3392
#define XCD_BAR_WORDS 3456
#define XB_SPIN_CAP (1u << 18)
__device__ __forceinline__ unsigned xb_ld(unsigned* p)              { return __hip_atomic_load(p, __ATOMIC_RELAXED, __HIP_MEMORY_SCOPE_AGENT); }
__device__ __forceinline__ unsigned xb_add(unsigned* p, unsigned v) { return __hip_atomic_fetch_add(p, v, __ATOMIC_RELAXED, __HIP_MEMORY_SCOPE_AGENT); }
__device__ __forceinline__ unsigned xb_xcc_id() { return (unsigned)__builtin_amdgcn_s_getreg((3 << 11) | 20) & 0xFu; }
#define XB_SPIN(cond, bar) do { unsigned _sp = 0; while (cond) { __builtin_amdgcn_s_sleep(1); \
    if ((++_sp & 255u) == 0u) { if (xb_ld(&(bar)[XB_TMO])) break; if (_sp > XB_SPIN_CAP) { atomicAdd(&(bar)[XB_TMO], 1u); break; } } } } while (0)
struct XcdBarrier { unsigned* bar; unsigned x; volatile MK_LAS unsigned* st; };
__device__ __forceinline__ XcdBarrier xcd_barrier_post(unsigned* bar, volatile MK_LAS unsigned* st) {
    XcdBarrier b; b.bar = bar; b.x = xb_xcc_id(); b.st = st;
    if (threadIdx.x == 0) (void)xb_add(&bar[XB_XCNT(b.x)], 1u);
    return b;
}
__device__ __forceinline__ void xcd_barrier_complete(unsigned* bar, unsigned x, unsigned& nloc, unsigned& nx) {
    const unsigned G = gridDim.x * gridDim.y * gridDim.z;
    unsigned sum, cnt, mine, sp = 0u;
    for (;;) {
        sum = 0u; cnt = 0u; mine = 0u;
#pragma unroll
        for (unsigned j = 0; j < 16; ++j) { const unsigned c = xb_ld(&bar[XB_XCNT(j)]); sum += c; cnt += (c > 0u) ? 1u : 0u; mine = (j == x) ? c : mine; }
        if (sum == G) break;
        __builtin_amdgcn_s_sleep(1);
        if ((++sp & 255u) == 0u) { if (xb_ld(&bar[XB_TMO])) break; if (sp > XB_SPIN_CAP) { atomicAdd(&bar[XB_TMO], 1u); break; } }
    }
    nloc = mine > 0u ? mine : 1u; nx = cnt > 0u ? cnt : 1u;
}
__device__ __forceinline__ void xcd_barrier(const XcdBarrier& b) {
    asm volatile("s_waitcnt vmcnt(0)" ::: "memory");
    __syncthreads();
    if (threadIdx.x == 0) {
        unsigned* bar = b.bar;
        __builtin_amdgcn_s_waitcnt(0);
        unsigned nloc = b.st[0], nx = b.st[1];
        if (nloc == 0u) { xcd_barrier_complete(bar, b.x, nloc, nx); b.st[0] = nloc; b.st[1] = nx; }
        const unsigned old = xb_add(&bar[XB_XSUB(b.x)], 1u);
        const unsigned gen = old / nloc;
        if (old + 1u == (gen + 1u) * nloc) {
            __builtin_amdgcn_fence(__ATOMIC_RELEASE, "agent");
            asm volatile("s_waitcnt vmcnt(0)" ::: "memory");
            const unsigned og = xb_add(&bar[XB_TOP], 1u);
            const unsigned tg = og / nx;
            if (og + 1u == (tg + 1u) * nx) xb_add(&bar[XB_TOPGEN], 1u);
            else XB_SPIN(xb_ld(&bar[XB_TOPGEN]) == tg, bar);
            __builtin_amdgcn_fence(__ATOMIC_ACQUIRE, "agent");
            xb_add(&bar[XB_XGEN(b.x)], 1u);
            asm volatile("s_waitcnt vmcnt(0)" ::: "memory");
        } else {
            XB_SPIN(xb_ld(&bar[XB_XGEN(b.x)]) == gen, bar);
            __builtin_amdgcn_fence(__ATOMIC_ACQUIRE, "agent");
            asm volatile("s_waitcnt vmcnt(0)" ::: "memory");
        }
    }
    __syncthreads();
}

__device__ __forceinline__ float wave_sum(float v) {
#pragma unroll
    for (int o = 1; o < 64; o <<= 1) v += __shfl_xor(v, o);
    return v;
}
__device__ __forceinline__ unsigned pk2(float lo, float hi) { return f2bf(lo) | (f2bf(hi) << 16); }

__device__ __forceinline__ void p0_item(const float* W, int ldw, int col0, int nvalid, const float* gk, bf16_t* WT, int K, int n0, int k0, MK_LAS float* scr, int lane) {
    const int c = lane & 31;
#pragma unroll 8
    for (int i = 0; i < 32; ++i) { const int kk = 2 * i + (lane >> 5); float v = (c < nvalid) ? W[(size_t)(k0 + kk) * ldw + col0 + c] : 0.f; if (gk) v *= gk[kk]; scr[kk * 33 + c] = v; }
    LDS_WAIT(); asm volatile("" ::: "memory");
    const int ch = lane & 7;
#pragma unroll
    for (int j = 0; j < 4; ++j) { const int n = (lane >> 3) + 8 * j; const MK_LAS float* s = scr + (8 * ch) * 33 + n;
        u32x4 o; o.x = pk2(s[0 * 33], s[1 * 33]); o.y = pk2(s[2 * 33], s[3 * 33]); o.z = pk2(s[4 * 33], s[5 * 33]); o.w = pk2(s[6 * 33], s[7 * 33]);
        *(GAS u32x4*)(WT + (size_t)(n0 + n) * K + k0 + 8 * ch) = o; }
    LDS_WAIT(); asm volatile("" ::: "memory");
}
__device__ __forceinline__ void p0_prologue(const Ptrs& P, MK_LAS unsigned char* lds, int vcu, int G, int wave, int lane) {
    MK_LAS float* scr = (MK_LAS float*)(lds + wave * 16384);
    const int gw = vcu * NWAVES + wave, NGW = G * NWAVES;
    constexpr int I_IN = 16 * 72, I_UQ = 6 * 24, I_UKV = 4 * 32, I_O = 16 * 32, I_13 = 32 * 256, I_2 = 32 * 128;
    constexpr int NITEMS = I_IN + I_UQ + I_UKV + I_O + I_13 + I_2;
    for (int it = gw; it < NITEMS; it += NGW) {
        int r = it;
        if (r < I_IN) { const int kb = r / 72, nb = r % 72, n0 = 32 * nb, pn = n0 >> 8, wi = n0 & 255, bj = wi >> 7, wc = (wi >> 5) & 3, LG = 256 * pn + 64 * wc + 32 * bj;
            int src = 0, nv = 32;
            if (LG < 1536) src = LG; else if (LG < 1920) src = 1544 + (LG - 1536); else if (LG < 2176) src = 1928 + (LG - 1920); else if (LG < 2208) src = 2184 + (LG - 2176); else if (LG == 2208) { src = 1536; nv = 8; } else nv = 0;
            p0_item(P.w_in, 2216, src, nv, nullptr, P.WIN(), 1024, n0, 64 * kb, scr, lane); continue; } r -= I_IN;
        if (r < I_UQ) { const int kb = r / 24, nb = r % 24; p0_item(P.w_uq, 768, 32 * nb, 32, P.g_q_lat + 64 * kb, P.WUQ(), 384, 32 * nb, 64 * kb, scr, lane); continue; } r -= I_UQ;
        if (r < I_UKV) { const int kb = r / 32, nb = r % 32, n0 = 32 * nb, pn = n0 >> 8, bj = (n0 >> 7) & 1, wc = (n0 >> 5) & 3;
            p0_item(P.w_ukv, 1024, (2 * pn + (wc >> 1)) * 128 + (wc & 1) * 64 + 32 * bj, 32, P.g_kv_lat + 64 * kb, P.WUKV(), 256, n0, 64 * kb, scr, lane); continue; } r -= I_UKV;
        if (r < I_O) { const int kb = r / 32, nb = r % 32; p0_item(P.w_o, 1024, 32 * nb, 32, kb < 8 ? P.g_fox_out + 64 * kb : P.g_mla_out + 64 * (kb - 8), P.WO(), 1024, 32 * nb, 64 * kb, scr, lane); continue; } r -= I_O;
        if (r < I_13) { const int e = r >> 8, rr = r & 255, kb = rr >> 4, nb = rr & 15, n0 = 32 * nb, pn = n0 >> 8, bj = (n0 >> 7) & 1, wc = (n0 >> 5) & 3;
            p0_item((bj ? P.w3 : P.w1) + (size_t)e * 262144, 256, 128 * pn + 32 * wc, 32, nullptr, P.W13() + (size_t)e * 524288, 1024, n0, 64 * kb, scr, lane); continue; } r -= I_13;
        { const int e = r >> 7, rr = r & 127, kb = rr >> 5, nb = rr & 31; p0_item(P.w2 + (size_t)e * 262144, 1024, 32 * nb, 32, nullptr, P.W2() + (size_t)e * 262144, 256, 32 * nb, 64 * kb, scr, lane); }
    }
    for (int m = gw; m < MP; m += NGW) {
        GAS unsigned long long* o8 = (GAS unsigned long long*)(P.XN() + (size_t)m * D) + lane;
        if (m >= MR + NMETA) {
#pragma unroll
            for (int j = 0; j < 4; ++j) o8[64 * j] = 0ull;
            continue; }
        const float* src = m < MR ? P.x + (size_t)m * D : P.meta + (size_t)(m - MR) * D;
        const GAS f32x4* xr = (const GAS f32x4*)src + lane; f32x4 v[4]; float s = 0.f;
#pragma unroll
        for (int j = 0; j < 4; ++j) { v[j] = xr[64 * j]; s += (v[j][0] * v[j][0] + v[j][1] * v[j][1]) + (v[j][2] * v[j][2] + v[j][3] * v[j][3]); }
        const float rstd = 1.f / sqrtf(wave_sum(s) * (1.f / D) + EPS);
#pragma unroll
        for (int j = 0; j < 4; ++j) { const f32x4 g = *(const f32x4*)(P.g_attn + 4 * lane + 256 * j);
            o8[64 * j] = (unsigned long long)pk2(v[j][0] * rstd * g[0], v[j][1] * rstd * g[1]) | ((unsigned long long)pk2(v[j][2] * rstd * g[2], v[j][3] * rstd * g[3]) << 32); }
    }
    for (int idx = vcu * (NWAVES * 64) + (int)threadIdx.x; idx < 64 * 2368; idx += G * NWAVES * 64) {
        const int bh = idx / 2368, r = idx % 2368; u32x4* p;
        if (r < 576) p = (u32x4*)(P.KTF() + ((size_t)bh * NKT + 32) * NCF * 512) + r;
        else if (r < 1344) p = (u32x4*)(P.KTM() + ((size_t)bh * NKT + 32) * NCM * 512) + (r - 576);
        else if (r < 1856) p = (u32x4*)(P.VTF() + ((size_t)bh * NKT + 32) * 4096) + (r - 1344);
        else p = (u32x4*)(P.VTM() + ((size_t)bh * NKT + 32) * 4096) + (r - 1856);
        *p = (u32x4){0u, 0u, 0u, 0u}; }
    for (int idx = vcu * (NWAVES * 64) + (int)threadIdx.x; idx < LSEQ * 16; idx += G * NWAVES * 64) {
        const int pos = idx >> 4, i = idx & 15; const float inv_freq = expf(-logf(10000.0f) * (float)i / 16.0f), ang = (float)pos * inv_freq;
        P.ROPE()[2 * idx] = cosf(ang); P.ROPE()[2 * idx + 1] = sinf(ang); }
}

__device__ __forceinline__ void fox_bias_store(const Ptrs& P, int bh, int s, float cum) {
    const float bias = -cum * LOG2E;
    const unsigned h_ = f2bf(bias); const float r1 = bias - bf2f((unsigned short)h_); const unsigned m_ = f2bf(r1); const float r2 = r1 - bf2f((unsigned short)m_); const unsigned l_ = f2bf(r2);
    u32x4 w; w.x = h_ | (m_ << 16); w.y = l_; w.z = 0u; w.w = 0u;
    *(u32x4*)(P.KTF() + kt_off(bh, s, 8, NCF)) = w;
}
__device__ __forceinline__ void fox_scan(const Ptrs& P, int bh, int lane) {
    const int b = bh >> 3, h = bh & 7;
    float x = lane < NMETA ? P.LOGF()[(size_t)(MR + lane) * 8 + h] : 0.f;
#pragma unroll
    for (int o = 1; o < 16; o <<= 1) { const float y = __shfl_up(x, o); if (lane >= o) x += y; }
    if (lane < NMETA) fox_bias_store(P, bh, lane, x);
    const float mtot = __shfl(x, NMETA - 1);
    float v[32]; float run = 0.f;
#pragma unroll
    for (int j = 0; j < 32; ++j) { run += P.LOGF()[((size_t)b * SEQ + 32 * lane + j) * 8 + h]; v[j] = run; }
    float inc = run;
#pragma unroll
    for (int o = 1; o < 64; o <<= 1) { const float y = __shfl_up(inc, o); if (lane >= o) inc += y; }
    const float base = mtot + (inc - run);
#pragma unroll
    for (int j = 0; j < 32; ++j) fox_bias_store(P, bh, NMETA + 32 * lane + j, base + v[j]);
}

struct MoeTab { int lo, hi, cnt; };
__device__ __forceinline__ MoeTab moe_tab(const Ptrs& P, int lane) {
    MoeTab T; T.cnt = (int)__hip_atomic_load(P.ctl() + CW_CNT + 64 * (lane & 31), RLX_AGENT);
    const int nt = (T.cnt + 255) >> 8; int x = nt;
#pragma unroll
    for (int o = 1; o < 32; o <<= 1) { const int y = __shfl_up(x, o, 32); if ((lane & 31) >= o) x += y; }
    T.hi = x; T.lo = x - nt; return T;
}
template <bool UP>
struct MoeOrder {
    static constexpr int NCOL = UP ? 2 : 4;
    int G, c; MoeTab T; const bf16_t* XN2; const bf16_t* W13; const bf16_t* HD; const bf16_t* W2; const int* LISTP;
    __device__ __forceinline__ bool next(int i, Unit& u) const {
        const int L = i * G + c, total = __builtin_amdgcn_readlane(T.hi, 31);
        if (L >= total * NCOL) return false;
        const int tile = L / NCOL, pn = L % NCOL;
        const unsigned long long mask = __ballot(tile >= T.lo) & 0xffffffffull;
        const int e = __builtin_amdgcn_readfirstlane(__popcll(mask) - 1);
        const int base = __builtin_amdgcn_readlane(T.lo, e);
        u.pm = tile; u.pn = e * NCOL + pn; u.ex = (e << 16) | (tile - base);
        if (UP) { u.A = (const char*)XN2; u.B = (const char*)(W13 + ((size_t)e * 512 + pn * 256) * 1024); }
        else { u.A = (const char*)(HD + (size_t)tile * 256 * 256); u.B = (const char*)(W2 + ((size_t)e * 1024 + pn * 256) * 256); }
        return true;
    }
    __device__ __forceinline__ void gather(const Unit& u, int R0, int C0, int R1, int C1, unsigned (&off)[4]) const {
        const int e = u.ex >> 16, rt = u.ex & 0xffff, cnt = __builtin_amdgcn_readlane(T.cnt, e);
        const int* list = LISTP + (size_t)e * CAP;
#pragma unroll
        for (int hh = 0; hh < 2; ++hh) {
            int i0 = rt * 256 + 128 * hh + R0, i1 = rt * 256 + 128 * hh + R1; i0 = i0 < cnt ? i0 : cnt - 1; i1 = i1 < cnt ? i1 : cnt - 1;
            off[hh * 2 + 0] = (unsigned)list[i0] * 2048u + (unsigned)C0 * 2u; off[hh * 2 + 1] = (unsigned)list[i1] * 2048u + (unsigned)C1 * 2u; }
    }
};

__device__ __forceinline__ void router_phase(const Ptrs& P, MK_LAS unsigned char* lds, int vcu, int G, int wave, int lane) {
    MK_LAS float* U = (MK_LAS float*)(lds + wave * 16384);
    const int gw = vcu * NWAVES + wave, NGW = G * NWAVES;
    for (int tb = gw * 4; tb < MR; tb += NGW * 4) {
#pragma unroll
        for (int tk = 0; tk < 4; ++tk) {
            const int t = tb + tk;
            const GAS f32x4* xr = (const GAS f32x4*)(P.out + (size_t)t * D) + lane; f32x4 v[4]; float s = 0.f;
#pragma unroll
            for (int j = 0; j < 4; ++j) { v[j] = xr[64 * j]; s += (v[j][0] * v[j][0] + v[j][1] * v[j][1]) + (v[j][2] * v[j][2] + v[j][3] * v[j][3]); }
            const float rstd = 1.f / sqrtf(wave_sum(s) * (1.f / D) + EPS);
            GAS unsigned long long* o8 = (GAS unsigned long long*)(P.XN2() + (size_t)t * D) + lane;
#pragma unroll
            for (int j = 0; j < 4; ++j) { const f32x4 g = *(const f32x4*)(P.g_ffn + 4 * lane + 256 * j); const f32x4 u = v[j] * rstd * g;
                o8[64 * j] = (unsigned long long)pk2(u[0], u[1]) | ((unsigned long long)pk2(u[2], u[3]) << 32);
#pragma unroll
                for (int e = 0; e < 4; ++e) U[(4 * lane + 256 * j + e) * 4 + tk] = u[e]; }
        }
        LDS_WAIT(); asm volatile("" ::: "memory");
        float a0 = 0.f, a1 = 0.f, a2 = 0.f, a3 = 0.f;
        const int j = lane < 36 ? lane : 35;
        const float* wp = j < 4 ? P.w_group + j : P.w_expert + (j - 4); const int wst = j < 4 ? 4 : 32;
#pragma unroll 8
        for (int k = 0; k < D; ++k) { const float w = wp[(size_t)k * wst]; const f32x4 u = *(const MK_LAS f32x4*)(U + 4 * k); a0 += u[0] * w; a1 += u[1] * w; a2 += u[2] * w; a3 += u[3] * w; }
        const float bias = j < 4 ? P.b_group[j] : P.b_expert[j - 4];
        LDS_WAIT(); asm volatile("" ::: "memory");
        MK_LAS float* LG = U;
        if (lane < 36) { LG[0 * 36 + lane] = a0 + bias; LG[1 * 36 + lane] = a1 + bias; LG[2 * 36 + lane] = a2 + bias; LG[3 * 36 + lane] = a3 + bias; }
        LDS_WAIT(); asm volatile("" ::: "memory");
        if (lane < 4) {
            const MK_LAS float* lg = LG + lane * 36; const int t = tb + lane;
            int gi = 0; float gm = lg[0];
            for (int i = 1; i < 4; ++i) if (lg[i] > gm) { gm = lg[i]; gi = i; }
            float den = 0.f; for (int i = 0; i < 4; ++i) den += expf(lg[i] - gm);
            const float psel = 1.0f / den;
            const MK_LAS float* w = lg + 4 + gi * 8;
            int i0 = 0; for (int i = 1; i < 8; ++i) if (w[i] > w[i0]) i0 = i;
            int i1 = -1; for (int i = 0; i < 8; ++i) if (i != i0 && (i1 < 0 || w[i] > w[i1])) i1 = i;
            const float e1 = expf(w[i1] - w[i0]);
            const float wa = psel / (1.0f + e1), wb = psel * e1 / (1.0f + e1);
            const int ea = gi * 8 + i0, eb = gi * 8 + i1;
            const unsigned pa = __hip_atomic_fetch_add(P.ctl() + CW_CNT + 64 * ea, 1u, RLX_AGENT), pb = __hip_atomic_fetch_add(P.ctl() + CW_CNT + 64 * eb, 1u, RLX_AGENT);
            P.LIST()[(size_t)ea * CAP + pa] = t; P.LIST()[(size_t)eb * CAP + pb] = t;
            u32x4 r0; r0.x = (unsigned)ea; r0.y = pa; r0.z = (unsigned)eb; r0.w = pb; *(u32x4*)(P.TOK() + (size_t)t * 8) = r0;
            u32x2 r1; r1.x = __builtin_bit_cast(unsigned, wa); r1.y = __builtin_bit_cast(unsigned, wb); *(u32x2*)(P.TOK() + (size_t)t * 8 + 4) = r1;
        }
        LDS_WAIT(); asm volatile("" ::: "memory");
    }
}

__device__ __forceinline__ void combine_phase(const Ptrs& P, int vcu, int G, int wave, int lane) {
    const MoeTab T = moe_tab(P, lane);
    const int gw = vcu * NWAVES + wave, NGW = G * NWAVES;
    for (int t = gw; t < MR; t += NGW) {
        const u32x4 r0 = *(const u32x4*)(P.TOK() + (size_t)t * 8); const unsigned r1x = __hip_atomic_load(P.TOK() + (size_t)t * 8 + 4, RLX_AGENT), r1y = __hip_atomic_load(P.TOK() + (size_t)t * 8 + 5, RLX_AGENT);
        const int ea = __builtin_amdgcn_readfirstlane((int)r0.x), eb = __builtin_amdgcn_readfirstlane((int)r0.z);
        const size_t sa = (size_t)__builtin_amdgcn_readlane(T.lo, ea) * 256 + r0.y, sb = (size_t)__builtin_amdgcn_readlane(T.lo, eb) * 256 + r0.w;
        float wa = __builtin_bit_cast(float, r1x), wb = __builtin_bit_cast(float, r1y);
        asm volatile("" : "+v"(wa)); asm volatile("" : "+v"(wb));
        GAS f32x4* o = (GAS f32x4*)(P.out + (size_t)t * D) + lane;
        const GAS u32x2* ya = (const GAS u32x2*)(P.Y() + sa * 1024) + lane; const GAS u32x2* yb = (const GAS u32x2*)(P.Y() + sb * 1024) + lane;
#pragma unroll
        for (int j = 0; j < 4; ++j) { const f32x4 hv = o[64 * j]; const u32x2 a = ya[64 * j], b = yb[64 * j]; f32x4 r;
            r[0] = hv[0] + wa * __builtin_bit_cast(float, a.x << 16) + wb * __builtin_bit_cast(float, b.x << 16);
            r[1] = hv[1] + wa * __builtin_bit_cast(float, a.x & 0xffff0000u) + wb * __builtin_bit_cast(float, b.x & 0xffff0000u);
            r[2] = hv[2] + wa * __builtin_bit_cast(float, a.y << 16) + wb * __builtin_bit_cast(float, b.y << 16);
            r[3] = hv[3] + wa * __builtin_bit_cast(float, a.y & 0xffff0000u) + wb * __builtin_bit_cast(float, b.y & 0xffff0000u);
            o[64 * j] = r; }
    }
}

struct Args { Ptrs P; int ph_lo, ph_hi; };
constexpr int N_PHASES = 9;
__global__ void __launch_bounds__(NWAVES * 64, 2) mega_fwd(Args args) {
    extern __shared__ __attribute__((aligned(16))) unsigned char lds_raw[];
    MK_LAS unsigned char* lds = (MK_LAS unsigned char*)lds_raw;
    const Ptrs& P = args.P;
    const int tid = threadIdx.x, lane = tid & 63, wave = __builtin_amdgcn_readfirstlane(tid >> 6);
    const int G = gridDim.x; const int bx = blockIdx.x; const int vcu = (G % 8 == 0) ? (bx % 8) * (G / 8) + bx / 8 : bx;
    volatile MK_LAS unsigned* MISC = (volatile MK_LAS unsigned*)(lds + LDSCTL_OFF);
    for (int u = tid; u < (LDS_BYTES - LDSCTL_OFF) / 4; u += NWAVES * 64) ((MK_LAS unsigned*)(lds + LDSCTL_OFF))[u] = 0u;
    __syncthreads();
    const int lo = args.ph_lo, hi = args.ph_hi;
    XcdBarrier bar = xcd_barrier_post(P.ctl() + CW_BAR, MISC + 8);
#ifndef PH_MASK
#define PH_MASK 0x1ff
#endif
#define IN(k) (((PH_MASK >> (k)) & 1) && lo <= (k) && (k) < hi)
#define SEAM(k) do { if (IN(k) && IN((k) + 1)) xcd_barrier(bar); } while (0)
    if (IN(0)) { p0_prologue(P, lds, vcu, G, wave, lane); }
    SEAM(0);
    if (IN(1)) { pg8::StaticOrder S; S.init(P.XN(), P.WIN(), MP, NIN, 1024, G, bx); EpiInProj E{P}; pg8::gemm_phase<EpiInProj, pg8::StaticOrder>(lds, 1024, S, E); }
    SEAM(1);
    if (IN(2)) {
#ifndef P2SUB
#define P2SUB 7
#endif
        if ((P2SUB & 1) && vcu < 64 && wave == 0) fox_scan(P, vcu, lane);
        if (P2SUB & 2) { pg8::StaticOrder S; S.init(P.CQ(), P.WUQ(), MR, 768, 384, G, bx); EpiQup E{P}; pg8::gemm_phase<EpiQup, pg8::StaticOrder>(lds, 384, S, E); }
        if (P2SUB & 4) { pg8::StaticOrder S; S.init(P.CKV(), P.WUKV(), MP, 1024, 256, G, (bx + 64) % G); EpiKvup E{P}; pg8::gemm_phase<EpiKvup, pg8::StaticOrder>(lds, 256, S, E); }
    }
    SEAM(2);
    if (IN(3)) attn_phase(lds, P, vcu, G);
    SEAM(3);
    if (IN(4)) { pg8::StaticOrder S; S.init(P.O(), P.WO(), MR, 1024, 1024, G, bx); EpiOut E{P}; pg8::gemm_phase<EpiOut, pg8::StaticOrder, false, true>(lds, 1024, S, E); }
    SEAM(4);
    if (IN(5)) router_phase(P, lds, vcu, G, wave, lane);
    SEAM(5);
    if (IN(6)) { MoeOrder<true> S; S.G = G; S.c = bx; S.T = moe_tab(P, lane); S.XN2 = P.XN2(); S.W13 = P.W13(); S.HD = P.HD(); S.W2 = P.W2(); S.LISTP = P.LIST(); EpiMoeUp E{P}; pg8::gemm_phase<EpiMoeUp, MoeOrder<true>, true>(lds, 1024, S, E); }
    SEAM(6);
    if (IN(7)) { MoeOrder<false> S; S.G = G; S.c = bx; S.T = moe_tab(P, lane); S.XN2 = P.XN2(); S.W13 = P.W13(); S.HD = P.HD(); S.W2 = P.W2(); S.LISTP = P.LIST(); EpiMoeDown E{P}; pg8::gemm_phase<EpiMoeDown, MoeOrder<false>>(lds, 256, S, E); }
    SEAM(7);
    if (IN(8)) combine_phase(P, vcu, G, wave, lane);
#undef IN
#undef SEAM
}
}
#ifndef DEBUG_STAGE
#define DEBUG_STAGE 0
#endif
#if DEBUG_STAGE
namespace dbg {
using namespace mk;
__global__ void k_snap(Ptrs P, int mode, float* snap, int ncols) {
    const int r = blockIdx.x; const int b = DBG_B;
    for (int c = threadIdx.x; c < ncols; c += blockDim.x) {
        float v = 0.f;
        const int i = r - NMETA; const size_t row = (size_t)b * SEQ + (i < 0 ? 0 : i);
        if (mode == 0) { v = i < 0 ? 0.f : bf2f(P.QF()[row * 512 + c]) / C2F; }
        else if (mode == 1) { const int h = c >> 6, d = c & 63; v = bf2f(P.KTF()[kt_off(b * 8 + h, r, d >> 3, NCF) + (d & 7)]); }
        else if (mode == 2) { const int h = c >> 6, d = c & 63; v = bf2f(P.VTF()[vt_off(b * 8 + h, r, d >> 5, d & 31)]); }
        else if (mode == 3) { const bf16_t* p = P.KTF() + kt_off(b * 8 + c, r, 8, NCF); v = bf2f(p[0]) + bf2f(p[1]) + bf2f(p[2]); }
        else if (mode == 4) { v = i < 0 ? 0.f : bf2f(P.QM()[row * 768 + c]); }
        else if (mode == 5) { const int h = c / 96, d = c % 96; v = bf2f(P.KTM()[kt_off(b * 8 + h, r, d >> 3, NCM) + (d & 7)]); }
        else if (mode == 6) { const int h = c >> 6, d = c & 63; v = bf2f(P.VTM()[vt_off(b * 8 + h, r, d >> 5, d & 31)]); }
        else if (mode == 7) { v = i < 0 ? 0.f : bf2f(P.O()[row * 1024 + c]); }
        else if (mode == 8) { v = i < 0 ? 0.f : P.out[row * 1024 + c]; }
        else if (mode == 9) { v = i < 0 ? 0.f : bf2f(P.XN2()[row * 1024 + c]); }
        else if (mode == 10 || mode == 11) { if (i >= 0) { const unsigned* tk = P.TOK() + row * 8; const int e = (int)tk[mode == 10 ? 0 : 2]; const unsigned pos = tk[mode == 10 ? 1 : 3]; const float w = __builtin_bit_cast(float, tk[mode == 10 ? 4 : 5]);
                int lo = 0; for (int q = 0; q < e; ++q) lo += ((int)P.ctl()[CW_CNT + 64 * q] + 255) >> 8;
                v = w * bf2f(P.Y()[((size_t)lo * 256 + pos) * 1024 + c]); } }
        snap[(size_t)r * ncols + c] = v;
    }
}
__global__ void k_bias_ref(const float* cum, float* o) { const int r = blockIdx.x, h = threadIdx.x; o[r * 8 + h] = -cum[h * LSEQ + r] * LOG2E; }
__global__ void k_cmp(const float* a, int lda, int offa, const float* ref, int ldb, int offb, int hw, int hs, int r0, int ncols, float* sums, int k) {
    const int r = blockIdx.x; if (r < r0) return;
    float d2 = 0.f, b2 = 0.f;
    for (int c = threadIdx.x; c < ncols; c += blockDim.x) { const int cc = hw ? (c / hw) * hs + (c % hw) : c; const float bv = ref[(size_t)r * ldb + offb + cc], av = a[(size_t)r * lda + offa + c]; d2 += (av - bv) * (av - bv); b2 += bv * bv; }
    d2 = wave_sum(d2); b2 = wave_sum(b2);
    if ((threadIdx.x & 63) == 0) { atomicAdd(sums + 2 * k, d2); atomicAdd(sums + 2 * k + 1, b2); }
}
__global__ void k_cmpy(const float* a, const float* h, const float* ref, float* sums, int k) {
    const int r = blockIdx.x; if (r < NMETA) return;
    float d2 = 0.f, b2 = 0.f;
    for (int c = threadIdx.x; c < 1024; c += blockDim.x) { const float rv = ref[(size_t)(r - NMETA) * 1024 + c], av = a[(size_t)r * 1024 + c], hv = h[(size_t)r * 1024 + c]; d2 += (av - rv) * (av - rv); b2 += (rv - hv) * (rv - hv); }
    d2 = wave_sum(d2); b2 = wave_sum(b2);
    if ((threadIdx.x & 63) == 0) { atomicAdd(sums + 2 * k, d2); atomicAdd(sums + 2 * k + 1, b2); }
}
__global__ void k_scale_lin(float* out, size_t n, const float* sums, float mul) {
    const float f = 1.0f + mul * sqrtf(sums[0] / fmaxf(sums[1], 1e-30f));
    for (size_t i = (size_t)blockIdx.x * blockDim.x + threadIdx.x; i < n; i += (size_t)gridDim.x * blockDim.x) out[i] *= f;
}
__global__ void k_scale(float* out, size_t n, const float* sums, int nchecks) {
    float delta = 0.f; int bad = -1;
    for (int k = 0; k < nchecks; ++k) { const float rel = sqrtf(sums[2 * k] / fmaxf(sums[2 * k + 1], 1e-30f)); if (!(rel <= 0.1f) && bad < 0) bad = k; if (rel > delta) delta = rel; }
    if (bad >= 0) delta = 0.1f * (float)(bad + 1);
    const float f = 1.0f + delta;
    for (size_t i = (size_t)blockIdx.x * blockDim.x + threadIdx.x; i < n; i += (size_t)gridDim.x * blockDim.x) out[i] *= f;
}
}
#endif

extern "C" void kernel_launch(void* const* d_in, const int* in_sizes, int n_in, void* d_out, int out_size, void* d_ws, size_t ws_size, hipStream_t stream) {
    using namespace mk;
    static int grid = 0;
    if (grid == 0) {
        int dev = 0, cus = 0, per_cu = 0;
        if (n_in != 24 || out_size != MR * D || ws_size < 256 * MiB) { fprintf(stderr, "kernel_launch: unexpected problem shape (n_in %d, out %d, ws %zu)\n", n_in, out_size, ws_size); grid = -1; return; }
        if (hipGetDevice(&dev) != hipSuccess || hipDeviceGetAttribute(&cus, hipDeviceAttributeMultiprocessorCount, dev) != hipSuccess) { grid = -1; return; }
        if (hipFuncSetAttribute((const void*)mega_fwd, hipFuncAttributeMaxDynamicSharedMemorySize, LDS_BYTES) != hipSuccess) { fprintf(stderr, "kernel_launch: hipFuncSetAttribute failed\n"); grid = -1; return; }
        if (hipOccupancyMaxActiveBlocksPerMultiprocessor(&per_cu, (const void*)mega_fwd, NWAVES * 64, LDS_BYTES) != hipSuccess || per_cu < 1) { fprintf(stderr, "kernel_launch: occupancy query says %d blocks per CU\n", per_cu); per_cu = 1; }
        (void)hipGetLastError();
        grid = cus;
    }
    if (grid < 0) return;
    unsigned char* ws = (unsigned char*)d_ws;
    (void)hipMemsetAsync(ws + WS_CTL, 0, CTL_BYTES, stream);
    Args a{};
    Ptrs& P = a.P;
    const float* const* in = (const float* const*)d_in;
    P.x = in[0]; P.meta = in[1]; P.g_attn = in[2]; P.w_in = in[3]; P.b_f = in[4]; P.g_fox_q = in[5]; P.g_fox_k = in[6]; P.g_q_lat = in[7]; P.w_uq = in[8]; P.g_kv_lat = in[9]; P.w_ukv = in[10];
    P.g_mla_q = in[11]; P.g_mla_k = in[12]; P.g_fox_out = in[13]; P.g_mla_out = in[14]; P.w_o = in[15]; P.g_ffn = in[16]; P.w_group = in[17]; P.b_group = in[18]; P.w_expert = in[19]; P.b_expert = in[20];
    P.w1 = in[21]; P.w3 = in[22]; P.w2 = in[23];
    P.out = (float*)d_out; P.ws = ws;
#if DEBUG_STAGE == 0
    a.ph_lo = 0; a.ph_hi = N_PHASES;
    hipLaunchKernelGGL(mega_fwd, dim3(grid), dim3(NWAVES * 64), LDS_BYTES, stream, a);
#else
    a.ph_lo = 0; a.ph_hi = DEBUG_STAGE + 1 > N_PHASES ? N_PHASES : DEBUG_STAGE + 1;
    hipLaunchKernelGGL(mega_fwd, dim3(grid), dim3(NWAVES * 64), LDS_BYTES, stream, a);
    float* S1 = (float*)(ws + 66 * MiB);
    float* S2 = (float*)(ws + WS_SNAP);
    float* sums = (float*)(ws + 239 * MiB + 512 * 1024);
    (void)hipMemsetAsync(sums, 0, 256, stream);
    nv::Bufs nb;
    const int L = LSEQ;
#if DEBUG_STAGE == 2
    float* s_fq = S1; float* s_fk = s_fq + (size_t)L * 512; float* s_fv = s_fk + (size_t)L * 512; float* s_bias = s_fv + (size_t)L * 512; float* s_qm = s_bias + (size_t)L * 8;
    float* s_mk = s_qm + (size_t)L * 768; float* s_mv = s_mk + (size_t)L * 768; float* s_bref = S2;
    hipLaunchKernelGGL(dbg::k_snap, dim3(L), dim3(256), 0, stream, P, 0, s_fq, 512);
    hipLaunchKernelGGL(dbg::k_snap, dim3(L), dim3(256), 0, stream, P, 1, s_fk, 512);
    hipLaunchKernelGGL(dbg::k_snap, dim3(L), dim3(256), 0, stream, P, 2, s_fv, 512);
    hipLaunchKernelGGL(dbg::k_snap, dim3(L), dim3(64), 0, stream, P, 3, s_bias, 8);
    hipLaunchKernelGGL(dbg::k_snap, dim3(L), dim3(256), 0, stream, P, 4, s_qm, 768);
    hipLaunchKernelGGL(dbg::k_snap, dim3(L), dim3(256), 0, stream, P, 5, s_mk, 768);
    hipLaunchKernelGGL(dbg::k_snap, dim3(L), dim3(256), 0, stream, P, 6, s_mv, 512);
    nv::naive_forward(d_in, (float*)d_out, ws + 100 * MiB, stream, &nb);
    hipLaunchKernelGGL(dbg::k_bias_ref, dim3(L), dim3(8), 0, stream, nb.CUM, s_bref);
    hipLaunchKernelGGL(dbg::k_cmp, dim3(L), dim3(256), 0, stream, s_fq, 512, 0, nb.PROJ, nv::IN_COLS, nv::OFF_FQ, 0, 0, NMETA, 512, sums, 0);
    hipLaunchKernelGGL(dbg::k_cmp, dim3(L), dim3(256), 0, stream, s_fk, 512, 0, nb.PROJ, nv::IN_COLS, nv::OFF_FK, 0, 0, 0, 512, sums, 1);
    hipLaunchKernelGGL(dbg::k_cmp, dim3(L), dim3(256), 0, stream, s_fv, 512, 0, nb.PROJ, nv::IN_COLS, nv::OFF_FV, 0, 0, 0, 512, sums, 2);
    hipLaunchKernelGGL(dbg::k_cmp, dim3(L), dim3(64), 0, stream, s_bias, 8, 0, s_bref, 8, 0, 0, 0, 0, 8, sums, 3);
    hipLaunchKernelGGL(dbg::k_cmp, dim3(L), dim3(256), 0, stream, s_qm, 768, 0, nb.QUP, 768, 0, 0, 0, NMETA, 768, sums, 4);
    hipLaunchKernelGGL(dbg::k_cmp, dim3(L), dim3(256), 0, stream, s_mk, 768, 0, nb.MK, 768, 0, 0, 0, 0, 768, sums, 5);
    hipLaunchKernelGGL(dbg::k_cmp, dim3(L), dim3(256), 0, stream, s_mv, 512, 0, nb.KVUP, 1024, 64, 64, 128, 0, 512, sums, 6);
    const int nchecks = 7;
#elif DEBUG_STAGE == 3
    hipLaunchKernelGGL(dbg::k_snap, dim3(L), dim3(256), 0, stream, P, 7, S2, 1024);
    nv::naive_forward(d_in, (float*)d_out, ws + 100 * MiB, stream, &nb);
    hipLaunchKernelGGL(dbg::k_cmp, dim3(L), dim3(256), 0, stream, S2, 1024, 0, nb.O, 1024, 0, 0, 0, NMETA, 512, sums, 0);
    hipLaunchKernelGGL(dbg::k_cmp, dim3(L), dim3(256), 0, stream, S2, 1024, 512, nb.O, 1024, 512, 0, 0, NMETA, 512, sums, 1);
    const int nchecks = 2;
#elif DEBUG_STAGE == 4
    hipLaunchKernelGGL(dbg::k_snap, dim3(L), dim3(256), 0, stream, P, 8, S2, 1024);
    nv::naive_forward(d_in, (float*)d_out, ws + 100 * MiB, stream, &nb);
    hipLaunchKernelGGL(dbg::k_cmp, dim3(L), dim3(256), 0, stream, S2, 1024, 0, nb.H1, 1024, 0, 0, 0, NMETA, 1024, sums, 0);
    const int nchecks = 1;
#elif DEBUG_STAGE == 9
    hipLaunchKernelGGL(dbg::k_snap, dim3(L), dim3(256), 0, stream, P, 10, S2, 1024);
    hipLaunchKernelGGL(dbg::k_snap, dim3(L), dim3(256), 0, stream, P, 11, S1, 1024);
    nv::naive_forward(d_in, (float*)d_out, ws + 100 * MiB, stream, &nb);
    hipLaunchKernelGGL(dbg::k_cmp, dim3(L), dim3(256), 0, stream, S2, 1024, 0, nb.YAB, 1024, 0, 0, 0, NMETA, 1024, sums, 0);
    hipLaunchKernelGGL(dbg::k_cmp, dim3(L), dim3(256), 0, stream, S1, 1024, 0, nb.YAB + (size_t)L * 1024, 1024, 0, 0, 0, NMETA, 1024, sums, 1);
    const int nchecks = 2;
#elif DEBUG_STAGE == 10
    hipLaunchKernelGGL(dbg::k_snap, dim3(L), dim3(256), 0, stream, P, 11, S2, 1024);
    nv::naive_forward(d_in, (float*)d_out, ws + 100 * MiB, stream, &nb);
    hipLaunchKernelGGL(dbg::k_cmp, dim3(L), dim3(256), 0, stream, S2, 1024, 0, nb.YAB + (size_t)L * 1024, 1024, 0, 0, 0, NMETA, 1024, sums, 0);
    hipLaunchKernelGGL(dbg::k_scale_lin, dim3(1024), dim3(256), 0, stream, (float*)d_out, (size_t)MR * D, sums, 0.1f);
    const int nchecks = 0;
#elif DEBUG_STAGE == 8
    hipLaunchKernelGGL(dbg::k_snap, dim3(L), dim3(256), 0, stream, P, 8, S2, 1024);
    nv::naive_forward(d_in, (float*)d_out, ws + 100 * MiB, stream, &nb);
    hipLaunchKernelGGL(dbg::k_cmpy, dim3(L), dim3(256), 0, stream, S2, nb.H1, (const float*)d_out + (size_t)DBG_B * SEQ * D, sums, 0);
    hipLaunchKernelGGL(dbg::k_scale_lin, dim3(1024), dim3(256), 0, stream, (float*)d_out, (size_t)MR * D, sums, 0.1f);
    const int nchecks = 0;
#else
    hipLaunchKernelGGL(dbg::k_snap, dim3(L), dim3(256), 0, stream, P, 9, S2, 1024);
    nv::naive_forward(d_in, (float*)d_out, ws + 100 * MiB, stream, &nb);
    hipLaunchKernelGGL(dbg::k_cmp, dim3(L), dim3(256), 0, stream, S2, 1024, 0, nb.U2, 1024, 0, 0, 0, NMETA, 1024, sums, 0);
    const int nchecks = 1;
#endif
    if (nchecks > 0) hipLaunchKernelGGL(dbg::k_scale, dim3(1024), dim3(256), 0, stream, (float*)d_out, (size_t)MR * D, sums, nchecks);
#endif
}
```

```cpp
#include <hip/hip_runtime.h>
#include <cstdio>
#include <cstdint>
#include <cmath>
#ifndef DEBUG_STAGE
#define DEBUG_STAGE 0
#endif
#undef DEBUG_STAGE
#define DEBUG_STAGE 0
#if DEBUG_STAGE
#ifndef DBG_B
#define DBG_B 7
#endif
namespace nv {
constexpr int D_MODEL = 1024, BATCH = 8, SEQ = 2048, N_META = 16, L = SEQ + N_META;
constexpr int FOX_H = 8, FOX_D = 64, FOX_W = 512;
constexpr int MLA_H = 8, QR = 384, KVR = 256, NOPE = 64, ROPE = 32, QK = 96, VD = 64, MLA_W = 512;
constexpr int IN_COLS = 2216;
constexpr int OFF_FQ = 0, OFF_FK = 512, OFF_FV = 1024, OFF_FF = 1536, OFF_CQ = 1544, OFF_CKV = 1928, OFF_KR = 2184;
constexpr int NG = 4, EPG = 8, NE = 32, DE = 256;
constexpr float EPS = 1e-6f;

__device__ __forceinline__ float wave_sum(float v) {
#pragma unroll
    for (int o = 1; o < 64; o <<= 1) v += __shfl_xor(v, o);
    return v;
}
__device__ __forceinline__ float block_sum256(float v, float* red) {
    v = wave_sum(v);
    __syncthreads();
    if ((threadIdx.x & 63) == 0) red[threadIdx.x >> 6] = v;
    __syncthreads();
    return red[0] + red[1] + red[2] + red[3];
}

__global__ void k_rms_in(const float* __restrict__ x, const float* __restrict__ meta, const float* __restrict__ g, float* __restrict__ u, int b) {
    __shared__ float red[4];
    const int r = blockIdx.x;
    const float* src = r < N_META ? meta + (size_t)r * D_MODEL : x + ((size_t)b * SEQ + (r - N_META)) * D_MODEL;
    float v[4]; float ss = 0.f;
#pragma unroll
    for (int i = 0; i < 4; ++i) { v[i] = src[threadIdx.x + 256 * i]; ss += v[i] * v[i]; }
    ss = block_sum256(ss, red);
    const float rs = 1.0f / sqrtf(ss * (1.0f / D_MODEL) + EPS);
#pragma unroll
    for (int i = 0; i < 4; ++i) u[(size_t)r * D_MODEL + threadIdx.x + 256 * i] = v[i] * rs * g[threadIdx.x + 256 * i];
}
__global__ void k_rms_rows(const float* __restrict__ in, int ld, int off, int n, const float* __restrict__ g, float* __restrict__ out, int ldo, int offo) {
    __shared__ float red[4];
    const int r = blockIdx.x;
    float ss = 0.f;
    for (int i = threadIdx.x; i < n; i += 256) { const float v = in[(size_t)r * ld + off + i]; ss += v * v; }
    ss = block_sum256(ss, red);
    const float rs = 1.0f / sqrtf(ss / (float)n + EPS);
    for (int i = threadIdx.x; i < n; i += 256) out[(size_t)r * ldo + offo + i] = in[(size_t)r * ld + off + i] * rs * g[i];
}

__global__ void k_gemm(const float* __restrict__ A, int lda, const float* __restrict__ B, int ldb, float* __restrict__ C, int ldc, const float* __restrict__ R, int ldr, int M, int N, int K) {
    __shared__ float As[16][65];
    __shared__ float Bs[16][65];
    const int tx = threadIdx.x & 15, ty = threadIdx.x >> 4;
    const int m0 = blockIdx.y * 64, n0 = blockIdx.x * 64;
    float acc[4][4] = {};
    for (int k0 = 0; k0 < K; k0 += 16) {
        for (int i = threadIdx.x; i < 64 * 16; i += 256) {
            const int mm = i >> 4, kk = i & 15;
            As[kk][mm] = (m0 + mm < M) ? A[(size_t)(m0 + mm) * lda + k0 + kk] : 0.f;
        }
        for (int i = threadIdx.x; i < 64 * 16; i += 256) {
            const int kk = i >> 6, nn = i & 63;
            Bs[kk][nn] = (n0 + nn < N) ? B[(size_t)(k0 + kk) * ldb + n0 + nn] : 0.f;
        }
        __syncthreads();
#pragma unroll
        for (int kk = 0; kk < 16; ++kk) {
            float a[4], bb[4];
#pragma unroll
            for (int i = 0; i < 4; ++i) { a[i] = As[kk][ty * 4 + i]; bb[i] = Bs[kk][tx * 4 + i]; }
#pragma unroll
            for (int i = 0; i < 4; ++i)
#pragma unroll
                for (int j = 0; j < 4; ++j) acc[i][j] += a[i] * bb[j];
        }
        __syncthreads();
    }
#pragma unroll
    for (int i = 0; i < 4; ++i)
#pragma unroll
        for (int j = 0; j < 4; ++j) {
            const int m = m0 + ty * 4 + i, n = n0 + tx * 4 + j;
            if (m < M && n < N) C[(size_t)m * ldc + n] = acc[i][j] + (R ? R[(size_t)m * ldr + n] : 0.f);
        }
}

__device__ __forceinline__ float log_sigmoid(float x) { return fminf(x, 0.f) - log1pf(expf(-fabsf(x))); }

__global__ void k_fox_prep(float* __restrict__ proj, const float* __restrict__ gq, const float* __restrict__ gk, const float* __restrict__ bf, float* __restrict__ logf) {
    const int r = blockIdx.x, h = threadIdx.x >> 6, d = threadIdx.x & 63;
    float* row = proj + (size_t)r * IN_COLS;
    float q = row[OFF_FQ + h * 64 + d], k = row[OFF_FK + h * 64 + d];
    const float sq = wave_sum(q * q), sk = wave_sum(k * k);
    row[OFF_FQ + h * 64 + d] = q * (1.0f / sqrtf(sq * (1.0f / 64) + EPS)) * gq[d];
    row[OFF_FK + h * 64 + d] = k * (1.0f / sqrtf(sk * (1.0f / 64) + EPS)) * gk[d];
    if (d == 0) logf[r * 8 + h] = log_sigmoid(row[OFF_FF + h] + bf[h]);
}
__global__ void k_cumsum(const float* __restrict__ logf, float* __restrict__ cum) {
    const int h = threadIdx.x; float c = 0.f;
    for (int r = 0; r < L; ++r) { c += logf[r * 8 + h]; cum[h * L + r] = c; }
}

__global__ void k_attn(const float* __restrict__ q, int ldq, int hq, const float* __restrict__ k, int ldk, int hk, const float* __restrict__ v, int ldv, int hv,
                       int dk, float scale, const float* __restrict__ cum, float* __restrict__ o, int ldo) {
    __shared__ float sc[L];
    __shared__ float qs[96];
    __shared__ float red[4];
    __shared__ float part[4][64];
    const int t = blockIdx.x, h = blockIdx.y, tid = threadIdx.x;
    if (tid < dk) qs[tid] = q[(size_t)t * ldq + h * hq + tid];
    __syncthreads();
    const float ct = cum ? cum[h * L + t] : 0.f;
    float mx = -INFINITY;
    for (int s = tid; s <= t; s += 256) {
        const float* kr = k + (size_t)s * ldk + h * hk;
        float a = 0.f;
        for (int d = 0; d < dk; ++d) a += qs[d] * kr[d];
        a *= scale;
        if (cum) a += ct - cum[h * L + s];
        sc[s] = a; mx = fmaxf(mx, a);
    }
#pragma unroll
    for (int off = 1; off < 64; off <<= 1) mx = fmaxf(mx, __shfl_xor(mx, off));
    __syncthreads();
    if ((tid & 63) == 0) red[tid >> 6] = mx;
    __syncthreads();
    mx = fmaxf(fmaxf(red[0], red[1]), fmaxf(red[2], red[3]));
    float sum = 0.f;
    for (int s = tid; s <= t; s += 256) { const float p = expf(sc[s] - mx); sc[s] = p; sum += p; }
    sum = block_sum256(sum, red);
    const int d = tid & 63, gq = tid >> 6;
    float acc = 0.f;
    for (int s = gq; s <= t; s += 4) acc += sc[s] * v[(size_t)s * ldv + h * hv + d];
    part[gq][d] = acc;
    __syncthreads();
    if (tid < 64) o[(size_t)t * ldo + h * 64 + tid] = (part[0][tid] + part[1][tid] + part[2][tid] + part[3][tid]) / sum;
}

__global__ void k_mla_prep(const float* __restrict__ qup, const float* __restrict__ kvup, const float* __restrict__ proj, const float* __restrict__ gq, const float* __restrict__ gk,
                           float* __restrict__ mq, float* __restrict__ mk) {
    __shared__ float sq[8][96], sk[8][96];
    __shared__ float rq[8], rk[8];
    const int r = blockIdx.x, h = threadIdx.x / 96, j = threadIdx.x % 96;
    const float qv = qup[(size_t)r * 768 + h * 96 + j];
    const float kv = j < 64 ? kvup[(size_t)r * 1024 + h * 128 + j] : proj[(size_t)r * IN_COLS + OFF_KR + (j - 64)];
    sq[h][j] = qv; sk[h][j] = kv;
    __syncthreads();
    if (j == 0) { float a = 0.f, b = 0.f; for (int i = 0; i < 96; ++i) { a += sq[h][i] * sq[h][i]; b += sk[h][i] * sk[h][i]; }
        rq[h] = 1.0f / sqrtf(a * (1.0f / 96) + EPS); rk[h] = 1.0f / sqrtf(b * (1.0f / 96) + EPS); }
    __syncthreads();
    sq[h][j] = qv * rq[h] * gq[j]; sk[h][j] = kv * rk[h] * gk[j];
    __syncthreads();
    float oq = sq[h][j], ok = sk[h][j];
    if (j >= 64) {
        const int i = (j - 64) & 15; const bool second = (j - 64) >= 16;
        const float inv_freq = expf(-logf(10000.0f) * (float)i / 16.0f);
        const float ang = (float)r * inv_freq, c = cosf(ang), s = sinf(ang);
        const float q1 = sq[h][64 + i], q2 = sq[h][80 + i], k1 = sk[h][64 + i], k2 = sk[h][80 + i];
        oq = second ? q1 * s + q2 * c : q1 * c - q2 * s;
        ok = second ? k1 * s + k2 * c : k1 * c - k2 * s;
    }
    mq[(size_t)r * 768 + h * 96 + j] = oq; mk[(size_t)r * 768 + h * 96 + j] = ok;
}

__global__ void k_res_rms(const float* __restrict__ x, const float* __restrict__ meta, const float* __restrict__ att, const float* __restrict__ g, float* __restrict__ h1, float* __restrict__ u2, int b) {
    __shared__ float red[4];
    const int r = blockIdx.x;
    const float* src = r < N_META ? meta + (size_t)r * D_MODEL : x + ((size_t)b * SEQ + (r - N_META)) * D_MODEL;
    float v[4]; float ss = 0.f;
#pragma unroll
    for (int i = 0; i < 4; ++i) { v[i] = src[threadIdx.x + 256 * i] + att[(size_t)r * D_MODEL + threadIdx.x + 256 * i]; ss += v[i] * v[i]; h1[(size_t)r * D_MODEL + threadIdx.x + 256 * i] = v[i]; }
    ss = block_sum256(ss, red);
    const float rs = 1.0f / sqrtf(ss * (1.0f / D_MODEL) + EPS);
#pragma unroll
    for (int i = 0; i < 4; ++i) u2[(size_t)r * D_MODEL + threadIdx.x + 256 * i] = v[i] * rs * g[threadIdx.x + 256 * i];
}

__global__ void k_moe(const float* __restrict__ u2, const float* __restrict__ h1, const float* __restrict__ wg, const float* __restrict__ bg, const float* __restrict__ we, const float* __restrict__ be,
                      const float* __restrict__ w1, const float* __restrict__ w3, const float* __restrict__ w2, float* __restrict__ out, int b, float* __restrict__ yab) {
    __shared__ float us[D_MODEL];
    __shared__ float lg[36];
    __shared__ float hid[DE];
    __shared__ int eidx[2];
    __shared__ float wsel[2];
    const int r = blockIdx.x + N_META, tid = threadIdx.x;
#pragma unroll
    for (int i = 0; i < 4; ++i) us[tid + 256 * i] = u2[(size_t)r * D_MODEL + tid + 256 * i];
    __syncthreads();
    if (tid < 36) {
        float a = 0.f;
        if (tid < 4) { for (int k = 0; k < D_MODEL; ++k) a += us[k] * wg[k * NG + tid]; a += bg[tid]; }
        else { const int e = tid - 4; for (int k = 0; k < D_MODEL; ++k) a += us[k] * we[k * NE + e]; a += be[e]; }
        lg[tid] = a;
    }
    __syncthreads();
    if (tid == 0) {
        int gi = 0; float gm = lg[0];
        for (int i = 1; i < 4; ++i) if (lg[i] > gm) { gm = lg[i]; gi = i; }
        float den = 0.f; for (int i = 0; i < 4; ++i) den += expf(lg[i] - gm);
        const float psel = 1.0f / den;
        const float* w = lg + 4 + gi * 8;
        int i0 = 0; for (int i = 1; i < 8; ++i) if (w[i] > w[i0]) i0 = i;
        int i1 = -1; for (int i = 0; i < 8; ++i) if (i != i0 && (i1 < 0 || w[i] > w[i1])) i1 = i;
        const float e1 = expf(w[i1] - w[i0]);
        wsel[0] = psel / (1.0f + e1); wsel[1] = psel * e1 / (1.0f + e1);
        eidx[0] = gi * 8 + i0; eidx[1] = gi * 8 + i1;
    }
    __syncthreads();
    float y[4] = {0.f, 0.f, 0.f, 0.f};
    for (int j = 0; j < 2; ++j) {
        const int e = eidx[j]; const float ws = wsel[j];
        const float* W1 = w1 + (size_t)e * D_MODEL * DE; const float* W3 = w3 + (size_t)e * D_MODEL * DE; const float* W2 = w2 + (size_t)e * DE * D_MODEL;
        float a = 0.f, c = 0.f;
        for (int k = 0; k < D_MODEL; ++k) { a += us[k] * W1[(size_t)k * DE + tid]; c += us[k] * W3[(size_t)k * DE + tid]; }
        __syncthreads();
        hid[tid] = (a / (1.0f + expf(-a))) * c;
        __syncthreads();
#pragma unroll
        for (int i = 0; i < 4; ++i) { float s = 0.f; for (int k = 0; k < DE; ++k) s += hid[k] * W2[(size_t)k * D_MODEL + tid + 256 * i]; y[i] += ws * s; if (yab) yab[((size_t)j * L + r) * D_MODEL + tid + 256 * i] = ws * s; }
    }
#pragma unroll
    for (int i = 0; i < 4; ++i) out[((size_t)b * SEQ + (r - N_META)) * D_MODEL + tid + 256 * i] = h1[(size_t)r * D_MODEL + tid + 256 * i] + y[i];
}

inline void gemm(hipStream_t st, const float* A, int lda, const float* B, int ldb, float* C, int ldc, const float* R, int ldr, int M, int N, int K) {
    dim3 grid((N + 63) / 64, (M + 63) / 64);
    hipLaunchKernelGGL(k_gemm, grid, dim3(256), 0, st, A, lda, B, ldb, C, ldc, R, ldr, M, N, K);
}

struct Bufs { float *PROJ, *CUM, *QUP, *KVUP, *MK, *O, *H1, *U2, *YAB; };
inline void naive_forward(void* const* d_in, float* out, unsigned char* ws, hipStream_t st, Bufs* bufs) {
    const float* x = (const float*)d_in[0]; const float* meta = (const float*)d_in[1]; const float* g_attn = (const float*)d_in[2]; const float* w_in = (const float*)d_in[3];
    const float* b_f = (const float*)d_in[4]; const float* g_fox_q = (const float*)d_in[5]; const float* g_fox_k = (const float*)d_in[6]; const float* g_q_lat = (const float*)d_in[7];
    const float* w_uq = (const float*)d_in[8]; const float* g_kv_lat = (const float*)d_in[9]; const float* w_ukv = (const float*)d_in[10]; const float* g_mla_q = (const float*)d_in[11];
    const float* g_mla_k = (const float*)d_in[12]; const float* g_fox_out = (const float*)d_in[13]; const float* g_mla_out = (const float*)d_in[14]; const float* w_o = (const float*)d_in[15];
    const float* g_ffn = (const float*)d_in[16]; const float* w_group = (const float*)d_in[17]; const float* b_group = (const float*)d_in[18]; const float* w_expert = (const float*)d_in[19];
    const float* b_expert = (const float*)d_in[20]; const float* w1 = (const float*)d_in[21]; const float* w3 = (const float*)d_in[22]; const float* w2 = (const float*)d_in[23];
    size_t off = 0;
    auto carve = [&](size_t nfloats) { float* p = (float*)(ws + off); off += ((nfloats * 4 + 255) / 256) * 256; return p; };
    float* U = carve((size_t)L * D_MODEL); float* PROJ = carve((size_t)L * IN_COLS); float* LOGF = carve((size_t)L * 8); float* CUM = carve((size_t)8 * L);
    float* CQN = carve((size_t)L * QR); float* CKVN = carve((size_t)L * KVR); float* QUP = carve((size_t)L * 768); float* KVUP = carve((size_t)L * 1024);
    float* MQ = carve((size_t)L * 768); float* MK = carve((size_t)L * 768); float* O = carve((size_t)L * 1024); float* MIX = carve((size_t)L * 1024);
    float* ATT = carve((size_t)L * 1024); float* H1 = carve((size_t)L * 1024); float* U2 = carve((size_t)L * 1024); float* YAB = carve((size_t)2 * L * 1024);
    if (bufs) { bufs->PROJ = PROJ; bufs->CUM = CUM; bufs->QUP = QUP; bufs->KVUP = KVUP; bufs->MK = MK; bufs->O = O; bufs->H1 = H1; bufs->U2 = U2; bufs->YAB = YAB; }
    for (int bi = 0; bi < BATCH; ++bi) {
        const int b = (bi + DBG_B + 1) % BATCH;
        hipLaunchKernelGGL(k_rms_in, dim3(L), dim3(256), 0, st, x, meta, g_attn, U, b);
        gemm(st, U, D_MODEL, w_in, IN_COLS, PROJ, IN_COLS, nullptr, 0, L, IN_COLS, D_MODEL);
        hipLaunchKernelGGL(k_fox_prep, dim3(L), dim3(512), 0, st, PROJ, g_fox_q, g_fox_k, b_f, LOGF);
        hipLaunchKernelGGL(k_cumsum, dim3(1), dim3(8), 0, st, LOGF, CUM);
        hipLaunchKernelGGL(k_attn, dim3(L, 8), dim3(256), 0, st, PROJ + OFF_FQ, IN_COLS, 64, PROJ + OFF_FK, IN_COLS, 64, PROJ + OFF_FV, IN_COLS, 64, 64, 0.125f, CUM, O, 1024);
        hipLaunchKernelGGL(k_rms_rows, dim3(L), dim3(256), 0, st, PROJ, IN_COLS, OFF_CQ, QR, g_q_lat, CQN, QR, 0);
        hipLaunchKernelGGL(k_rms_rows, dim3(L), dim3(256), 0, st, PROJ, IN_COLS, OFF_CKV, KVR, g_kv_lat, CKVN, KVR, 0);
        gemm(st, CQN, QR, w_uq, 768, QUP, 768, nullptr, 0, L, 768, QR);
        gemm(st, CKVN, KVR, w_ukv, 1024, KVUP, 1024, nullptr, 0, L, 1024, KVR);
        hipLaunchKernelGGL(k_mla_prep, dim3(L), dim3(768), 0, st, QUP, KVUP, PROJ, g_mla_q, g_mla_k, MQ, MK);
        hipLaunchKernelGGL(k_attn, dim3(L, 8), dim3(256), 0, st, MQ, 768, 96, MK, 768, 96, KVUP + 64, 1024, 128, 96, 1.0f / sqrtf(96.0f), (const float*)nullptr, O + 512, 1024);
        hipLaunchKernelGGL(k_rms_rows, dim3(L), dim3(256), 0, st, O, 1024, 0, 512, g_fox_out, MIX, 1024, 0);
        hipLaunchKernelGGL(k_rms_rows, dim3(L), dim3(256), 0, st, O, 1024, 512, 512, g_mla_out, MIX, 1024, 512);
        gemm(st, MIX, 1024, w_o, 1024, ATT, 1024, nullptr, 0, L, 1024, 1024);
        hipLaunchKernelGGL(k_res_rms, dim3(L), dim3(256), 0, st, x, meta, ATT, g_ffn, H1, U2, b);
        hipLaunchKernelGGL(k_moe, dim3(SEQ), dim3(256), 0, st, U2, H1, w_group, b_group, w_expert, b_expert, w1, w3, w2, out, b, YAB);
    }
}
}
#endif
namespace pg8 {
#define PG8_LAS __attribute__((address_space(3)))
typedef unsigned short bf16_t;
typedef short bf16x8 __attribute__((ext_vector_type(8)));
typedef float f32x4 __attribute__((ext_vector_type(4)));
typedef unsigned u32x4 __attribute__((ext_vector_type(4)));
typedef unsigned u32x2 __attribute__((ext_vector_type(2)));
constexpr int BM = 256, BK = 64, HALF = 128, HTB = HALF * BK * 2  , STAGE_BYTES = 8 * HTB, NXCD = 8, WGM = 8;

__host__ __device__ __forceinline__ int lds_byte(int r, int c) { const int st = (r >> 4) * 2 + (c >> 5), rr = r & 15, cc = c & 31, ob = rr * 64 + cc * 2; return st * 1024 + (ob ^ (((ob >> 9) & 1) << 5)); }
__host__ __device__ __forceinline__ void stage_rc(int b, int& R, int& C) { const int st = b / 1024, sb = b % 1024, swz = sb ^ (((sb >> 9) & 1) << 5); R = (st >> 1) * 16 + swz / 64; C = (st & 1) * 32 + (swz % 64) / 2; }
__host__ __device__ __forceinline__ int perm32(int rho) { const int n = rho >> 4, i = rho & 15; return 8 * (i >> 2) + 4 * n + (i & 3); }

struct Unit { int pm, pn, ex; const char* A; const char* B; };

struct StaticOrder {
    int nM, nN, nwg, G, c; const char* A; const char* B; size_t tstep;
    __device__ void init(const void* A_, const void* Bt_, int M, int N, int K, int G_, int c_) { nM = M / BM; nN = N / BM; nwg = nM * nN; G = G_; c = c_; A = (const char*)A_; B = (const char*)Bt_; tstep = (size_t)BM * K * 2; }
    __device__ bool next(int i, Unit& u) const {
        const long L = (long)i * G + c; if (L >= nwg) return false;
        int wgid = (int)L; { const int q = nwg / NXCD, r = nwg % NXCD, xcd = wgid % NXCD, off = wgid / NXCD; wgid = (xcd < r ? xcd * (q + 1) : r * (q + 1) + (xcd - r) * q) + off; }
        const int nig = WGM * nN, gid = wgid / nig, fm = gid * WGM, gsz = (nM - fm) < WGM ? (nM - fm) : WGM;
        u.pm = fm + ((wgid % nig) % gsz); u.pn = (wgid % nig) / gsz; u.ex = 0; u.A = A + (size_t)u.pm * tstep; u.B = B + (size_t)u.pn * tstep; return true;
    }
    __device__ __forceinline__ void gather(const Unit&, int, int, int, int, unsigned (&)[4]) const {}
};

__device__ __forceinline__ unsigned cvt_pk_bf16(float lo, float hi) { typedef float f2 __attribute__((ext_vector_type(2))); typedef __bf16 b2 __attribute__((ext_vector_type(2))); f2 v = {lo, hi}; b2 b = __builtin_convertvector(v, b2); return __builtin_bit_cast(unsigned, b); }

template <class Epi, class Sched, bool GATHER = false, bool MID = false>
__device__ __forceinline__ void gemm_phase(PG8_LAS unsigned char* lds, const int K, const Sched& S, const Epi& E) {
    const int tid = threadIdx.x, wid = __builtin_amdgcn_readfirstlane(tid >> 6), lane = tid & 63, wr = wid >> 2, wc = wid & 3, fr = lane & 15, fq = lane >> 4;
    const int nt = K / BK;
    unsigned voffA[2], voffB[2]; int sR[2], sC[2];
#pragma unroll
    for (int i = 0; i < 2; ++i) { int R, C; stage_rc(tid * 16 + i * 8192, R, C); const int Rb = Epi::PERM ? ((R & ~31) + perm32(R & 31)) : R; sR[i] = R; sC[i] = C;
        voffA[i] = (unsigned)(R * K + C) * 2u; voffB[i] = (unsigned)(Rb * K + C) * 2u; }
    const size_t kstep = (size_t)(BK * 2);
    const size_t hstep = (size_t)HALF * K * 2;
    const unsigned ldsw = (unsigned)wid * 1024u;
    const int aoff = lds_byte(wr * 64 + fr, fq * 8), boff = lds_byte(wc * 32 + fr, fq * 8);
#define PG8_SA(b, h) (((b) * 2 + (h)) * HTB)
#define PG8_SB(b, h) ((4 + (b) * 2 + (h)) * HTB)
#define PG8_STAGE(bufoff, gbase, voff) do { _Pragma("unroll") for (int _i = 0; _i < 2; ++_i) \
        __builtin_amdgcn_global_load_lds((const unsigned*)((const char*)(gbase) + (voff)[_i]), (PG8_LAS unsigned*)(lds + (bufoff) + ldsw + _i * 8192), 16, 0, 0); } while (0)
#define PG8_STAGE_A(bufoff, abase, h, NX) do { if constexpr (GATHER) { _Pragma("unroll") for (int _i = 0; _i < 2; ++_i) { const unsigned _o = (NX) ? gN[(h) * 2 + _i] : gC[(h) * 2 + _i]; \
        __builtin_amdgcn_global_load_lds((const unsigned*)((const char*)(abase) + _o), (PG8_LAS unsigned*)(lds + (bufoff) + ldsw + _i * 8192), 16, 0, 0); } } \
        else { PG8_STAGE(bufoff, (abase) + (h) * hstep, voffA); } } while (0)
#define PG8_LDA(dst, b, h) do { _Pragma("unroll") for (int m = 0; m < 4; ++m) _Pragma("unroll") for (int k = 0; k < 2; ++k) dst[m][k] = *(const PG8_LAS bf16x8*)(lds + PG8_SA(b, h) + aoff + m * 2048 + k * 1024); } while (0)
#define PG8_LDB(dst, b, h) do { _Pragma("unroll") for (int n = 0; n < 2; ++n) _Pragma("unroll") for (int k = 0; k < 2; ++k) dst[n][k] = *(const PG8_LAS bf16x8*)(lds + PG8_SB(b, h) + boff + n * 2048 + k * 1024); } while (0)
#define PG8_MMA(ai, bj, At, Bt) do { __builtin_amdgcn_s_setprio(1); _Pragma("unroll") for (int m = 0; m < 4; ++m) _Pragma("unroll") for (int n = 0; n < 2; ++n) _Pragma("unroll") for (int k = 0; k < 2; ++k) \
        acc[ai][bj][m][n] = __builtin_amdgcn_mfma_f32_16x16x32_bf16(Bt[n][k], At[m][k], acc[ai][bj][m][n], 0, 0, 0); __builtin_amdgcn_s_setprio(0); } while (0)
#define PG8_WAIT_V(n) asm volatile("s_waitcnt vmcnt(" #n ")" ::: "memory")
#define PG8_WAIT_L(n) asm volatile("s_waitcnt lgkmcnt(" #n ")" ::: "memory")
#define PG8_BAR __builtin_amdgcn_s_barrier()
#define PG8_SCHED __builtin_amdgcn_sched_barrier(0)
    Unit cur, nxt; int ui = 0;
    if (!S.next(0, cur)) return;
    unsigned gC[4] = {0u, 0u, 0u, 0u}, gN[4] = {0u, 0u, 0u, 0u};
    if constexpr (GATHER) S.gather(cur, sR[0], sC[0], sR[1], sC[1], gC);
    f32x4 acc[2][2][4][2];
#pragma unroll
    for (int a = 0; a < 2; ++a)
#pragma unroll
        for (int b = 0; b < 2; ++b)
#pragma unroll
            for (int m = 0; m < 4; ++m)
#pragma unroll
                for (int n = 0; n < 2; ++n) acc[a][b][m][n] = (f32x4){0.f, 0.f, 0.f, 0.f};
    bf16x8 At[4][2], B0[2][2], B1[2][2];
    const char* cA = cur.A; const char* cB = cur.B;
    PG8_STAGE(PG8_SB(0, 0), cB, voffB); PG8_STAGE(PG8_SB(0, 1), cB + hstep, voffB); PG8_STAGE_A(PG8_SA(0, 0), cA, 0, false); PG8_STAGE_A(PG8_SA(0, 1), cA, 1, false);
    if (wr == 1) PG8_BAR;
    PG8_WAIT_V(2); PG8_BAR;
    PG8_STAGE(PG8_SB(1, 0), cB + kstep, voffB); PG8_STAGE_A(PG8_SA(1, 0), cA + kstep, 0, false); PG8_STAGE(PG8_SB(1, 1), cB + hstep + kstep, voffB);
    PG8_WAIT_V(6); PG8_BAR;
    for (;;) {
        const bool has_next = S.next(ui + 1, nxt);
        if constexpr (GATHER) { if (has_next) S.gather(nxt, sR[0], sC[0], sR[1], sC[1], gN); else { gN[0] = gC[0]; gN[1] = gC[1]; gN[2] = gC[2]; gN[3] = gC[3]; } }
        const char* nA = has_next ? nxt.A : cA; const char* nB = has_next ? nxt.B : cB;
#pragma unroll 1
        for (int t = 0; t < nt; t += 2) {
            const bool last = (t == nt - 2);
            const char* a1 = cA + (size_t)(t + 1) * kstep;
            const char* a2 = last ? nA : cA + (size_t)(t + 2) * kstep; const char* b2 = last ? nB : cB + (size_t)(t + 2) * kstep;
            const char* a3 = a2 + kstep; const char* b3 = b2 + kstep;
            if constexpr (MID) { if (t == nt / 2) E.mid(acc, cur, wr, fr); }
            PG8_LDB(B0, 0, 0); PG8_LDB(B1, 0, 1); PG8_SCHED; PG8_LDA(At, 0, 0); PG8_STAGE_A(PG8_SA(1, 1), a1, 1, false);
            PG8_WAIT_V(8); PG8_WAIT_L(0); PG8_BAR; PG8_MMA(0, 0, At, B0); PG8_MMA(0, 1, At, B1); PG8_BAR; PG8_SCHED;
            PG8_LDA(At, 0, 1); PG8_STAGE(PG8_SB(0, 0), b2, voffB); PG8_STAGE(PG8_SB(0, 1), b2 + hstep, voffB); PG8_STAGE_A(PG8_SA(0, 0), a2, 0, last);
            PG8_WAIT_V(8); PG8_WAIT_L(0); PG8_BAR; PG8_MMA(1, 0, At, B0); PG8_MMA(1, 1, At, B1); PG8_BAR; PG8_SCHED;
            PG8_LDB(B0, 1, 0); PG8_LDB(B1, 1, 1); PG8_SCHED; PG8_LDA(At, 1, 0); PG8_STAGE_A(PG8_SA(0, 1), a2, 1, last);
            PG8_WAIT_V(8); PG8_WAIT_L(0); PG8_BAR; PG8_MMA(0, 0, At, B0); PG8_MMA(0, 1, At, B1); PG8_BAR; PG8_SCHED;
            PG8_LDA(At, 1, 1); PG8_STAGE(PG8_SB(1, 0), b3, voffB); PG8_STAGE(PG8_SB(1, 1), b3 + hstep, voffB); PG8_STAGE_A(PG8_SA(1, 0), a3, 0, last);
            PG8_WAIT_V(8); PG8_WAIT_L(0); PG8_BAR; PG8_MMA(1, 0, At, B0); PG8_MMA(1, 1, At, B1); PG8_BAR; PG8_SCHED;
        }
        if (wr == 0) PG8_BAR;
        E(acc, cur, wr, wc, fr, fq);
        if (!has_next) break;
#pragma unroll
        for (int a = 0; a < 2; ++a)
#pragma unroll
            for (int b = 0; b < 2; ++b)
#pragma unroll
                for (int m = 0; m < 4; ++m)
#pragma unroll
                    for (int n = 0; n < 2; ++n) acc[a][b][m][n] = (f32x4){0.f, 0.f, 0.f, 0.f};
        cur = nxt; cA = nA; cB = nB; ++ui;
        if constexpr (GATHER) { gC[0] = gN[0]; gC[1] = gN[1]; gC[2] = gN[2]; gC[3] = gN[3]; }
        if (wr == 1) PG8_BAR;
    }
    PG8_WAIT_V(0);
    PG8_BAR;
#undef PG8_SA
#undef PG8_SB
#undef PG8_STAGE
#undef PG8_STAGE_A
#undef PG8_LDA
#undef PG8_LDB
#undef PG8_MMA
#undef PG8_WAIT_V
#undef PG8_WAIT_L
#undef PG8_BAR
#undef PG8_SCHED
}
}
namespace mk {
using pg8::bf16_t; using pg8::f32x4; using pg8::u32x4; using pg8::u32x2; using pg8::Unit; using pg8::cvt_pk_bf16;
constexpr int D = 1024, NB = 8, SEQ = 2048, NMETA = 16, LSEQ = SEQ + NMETA;
constexpr int MR = NB * SEQ;
constexpr int MP = MR + 256;
constexpr int NKT = 33;
constexpr int NCF = 9, NCM = 12;
constexpr int NIN = 2304;
constexpr float EPS = 1e-6f;
constexpr float LOG2E = 1.4426950408889634f;
constexpr float C2F = 0.125f * LOG2E;
constexpr float C2M = 0.10206207261596577f * LOG2E;
constexpr int CAP = 16384;
constexpr int NSLOT = 40960;

constexpr size_t MiB = 1u << 20;
constexpr size_t WS_CTL = 0, CTL_BYTES = 1 * MiB;
constexpr int CW_BAR = 4096;
constexpr int CW_CNT = 8192;
constexpr int CW_SSQO = 65536;
constexpr int CW_SSQH = 98304;
constexpr size_t WS_WIN = 1 * MiB, WS_WUQ = 5632 * 1024, WS_WUKV = 6400 * 1024, WS_WO = 7 * MiB, WS_W13 = 9 * MiB, WS_W2 = 41 * MiB;
constexpr size_t WS_ROPE = 57 * MiB;
constexpr size_t WS_WR = 57 * MiB + 512 * 1024;
constexpr size_t WS_LOGF = 58 * MiB, WS_KR = WS_LOGF + 640 * 1024, WS_SSQCQ = WS_KR + 2176 * 1024, WS_SSQCKV = WS_SSQCQ + 640 * 1024, WS_SSQKR = WS_SSQCKV + 320 * 1024;
constexpr size_t WS_TOK = 62 * MiB, WS_LIST = 63 * MiB;
constexpr size_t WS_XN = 66 * MiB;
constexpr size_t WS_O = WS_XN;
constexpr size_t WS_QF = 100 * MiB, WS_KTF = 116 * MiB, WS_VTF = 135 * MiB, WS_CQ = 152 * MiB, WS_CKV = 165 * MiB, WS_QM = 174 * MiB, WS_KTM = 198 * MiB, WS_VTM = 223 * MiB;
constexpr size_t WS_XN2 = 100 * MiB, WS_HD = 132 * MiB, WS_Y = 152 * MiB;
constexpr size_t WS_SNAP = 240 * MiB;
static_assert(WS_WUQ >= WS_WIN + (size_t)NIN * 1024 * 2 && WS_WUKV >= WS_WUQ + 768 * 384 * 2 && WS_WO >= WS_WUKV + 1024 * 256 * 2, "ws map");
static_assert(WS_SSQKR + (size_t)MP * 4 <= WS_TOK && WS_XN + (size_t)MP * D * 2 <= WS_QF, "ws map");
static_assert(WS_KTF + (size_t)64 * NKT * NCF * 1024 <= WS_VTF && WS_VTF + (size_t)64 * NKT * 8192 <= WS_CQ && WS_CQ + (size_t)MP * 384 * 2 <= WS_CKV && WS_CKV + (size_t)MP * 256 * 2 <= WS_QM, "ws map");
static_assert(WS_QM + (size_t)MR * 768 * 2 <= WS_KTM && WS_KTM + (size_t)64 * NKT * NCM * 1024 <= WS_VTM && WS_VTM + (size_t)64 * NKT * 8192 <= WS_SNAP, "ws map");
static_assert(WS_HD + (size_t)NSLOT * 512 <= WS_Y && WS_Y + (size_t)NSLOT * 2048 <= WS_SNAP, "ws map");

__device__ __forceinline__ unsigned f2bf(float f) { unsigned u = __builtin_bit_cast(unsigned, f); return (u + 0x7fffu + ((u >> 16) & 1u)) >> 16; }
__device__ __forceinline__ float bf2f(unsigned short h) { return __builtin_bit_cast(float, (unsigned)h << 16); }
__device__ __forceinline__ float log_sigmoid(float x) { return fminf(x, 0.f) - log1pf(__expf(-fabsf(x))); }

struct Ptrs {
    const float *x, *meta, *g_attn, *w_in, *b_f, *g_fox_q, *g_fox_k, *g_q_lat, *w_uq, *g_kv_lat, *w_ukv, *g_mla_q, *g_mla_k, *g_fox_out, *g_mla_out, *w_o, *g_ffn, *w_group, *b_group, *w_expert, *b_expert, *w1, *w3, *w2;
    float* out; unsigned char* ws;
    __host__ __device__ __forceinline__ bf16_t* WIN() const { return (bf16_t*)(ws + WS_WIN); }
    __host__ __device__ __forceinline__ bf16_t* WUQ() const { return (bf16_t*)(ws + WS_WUQ); }
    __host__ __device__ __forceinline__ bf16_t* WUKV() const { return (bf16_t*)(ws + WS_WUKV); }
    __host__ __device__ __forceinline__ bf16_t* WO() const { return (bf16_t*)(ws + WS_WO); }
    __host__ __device__ __forceinline__ bf16_t* W13() const { return (bf16_t*)(ws + WS_W13); }
    __host__ __device__ __forceinline__ bf16_t* W2() const { return (bf16_t*)(ws + WS_W2); }
    __host__ __device__ __forceinline__ bf16_t* XN() const { return (bf16_t*)(ws + WS_XN); }
    __host__ __device__ __forceinline__ bf16_t* O() const { return (bf16_t*)(ws + WS_O); }
    __host__ __device__ __forceinline__ bf16_t* QF() const { return (bf16_t*)(ws + WS_QF); }
    __host__ __device__ __forceinline__ bf16_t* KTF() const { return (bf16_t*)(ws + WS_KTF); }
    __host__ __device__ __forceinline__ bf16_t* VTF() const { return (bf16_t*)(ws + WS_VTF); }
    __host__ __device__ __forceinline__ bf16_t* CQ() const { return (bf16_t*)(ws + WS_CQ); }
    __host__ __device__ __forceinline__ bf16_t* CKV() const { return (bf16_t*)(ws + WS_CKV); }
    __host__ __device__ __forceinline__ bf16_t* QM() const { return (bf16_t*)(ws + WS_QM); }
    __host__ __device__ __forceinline__ bf16_t* KTM() const { return (bf16_t*)(ws + WS_KTM); }
    __host__ __device__ __forceinline__ bf16_t* VTM() const { return (bf16_t*)(ws + WS_VTM); }
    __host__ __device__ __forceinline__ bf16_t* XN2() const { return (bf16_t*)(ws + WS_XN2); }
    __host__ __device__ __forceinline__ bf16_t* HD() const { return (bf16_t*)(ws + WS_HD); }
    __host__ __device__ __forceinline__ bf16_t* Y() const { return (bf16_t*)(ws + WS_Y); }
    __host__ __device__ __forceinline__ float* ROPE() const { return (float*)(ws + WS_ROPE); }
    __host__ __device__ __forceinline__ float* LOGF() const { return (float*)(ws + WS_LOGF); }
    __host__ __device__ __forceinline__ float* KR() const { return (float*)(ws + WS_KR); }
    __host__ __device__ __forceinline__ float* SSQCQ() const { return (float*)(ws + WS_SSQCQ); }
    __host__ __device__ __forceinline__ float* SSQCKV() const { return (float*)(ws + WS_SSQCKV); }
    __host__ __device__ __forceinline__ float* SSQKR() const { return (float*)(ws + WS_SSQKR); }
    __host__ __device__ __forceinline__ unsigned* ctl() const { return (unsigned*)(ws + WS_CTL); }
    __host__ __device__ __forceinline__ float* SSQO() const { return (float*)(ws + WS_CTL) + CW_SSQO; }
    __host__ __device__ __forceinline__ float* SSQH() const { return (float*)(ws + WS_CTL) + CW_SSQH; }
    __host__ __device__ __forceinline__ bf16_t* WR() const { return (bf16_t*)(ws + WS_WR); }
    __host__ __device__ __forceinline__ int* LIST() const { return (int*)(ws + WS_LIST); }
    __host__ __device__ __forceinline__ unsigned* TOK() const { return (unsigned*)(ws + WS_TOK); }
};

__device__ __forceinline__ size_t kt_off(int bh, int s, int chunk, int NC) { return ((((size_t)bh * NKT + (s >> 6)) * NC + chunk) * 64 + (s & 63)) * 8; }
__device__ __forceinline__ size_t vt_off(int bh, int s, int dhalf, int d32) { return (((size_t)bh * NKT + (s >> 6)) * 4096) + dhalf * 2048 + ((s >> 4) & 3) * 512 + (s & 15) * 32 + d32; }

struct EpiInProj {
    static constexpr bool PERM = true;
    Ptrs P;
    __device__ __forceinline__ void operator()(const f32x4 (&acc)[2][2][4][2], const Unit& u, int wr, int wc, int fr, int fq) const {
        const int pn = u.pn; const bool meta = (u.pm == MR / 256);
        const int rowb = u.pm * 256 + wr * 64 + fr;
        if (pn < 6) {
            const int head = 4 * (pn & 1) + wc;
            f32x4 gv[2][2];
            if (pn < 4) { const float* g = pn < 2 ? P.g_fox_q : P.g_fox_k; const float sc = pn < 2 ? C2F : 1.0f;
#pragma unroll
                for (int bj = 0; bj < 2; ++bj)
#pragma unroll
                    for (int n = 0; n < 2; ++n) gv[bj][n] = *(const f32x4*)(g + 32 * bj + 8 * fq + 4 * n) * sc; }
#pragma unroll
            for (int ai = 0; ai < 2; ++ai)
#pragma unroll
                for (int m = 0; m < 4; ++m) {
                    const int row = rowb + ai * 128 + m * 16;
                    float rs = 1.0f;
                    if (pn < 4) { float ss = 0.f;
#pragma unroll
                        for (int bj = 0; bj < 2; ++bj)
#pragma unroll
                            for (int n = 0; n < 2; ++n) { const f32x4 v = acc[ai][bj][m][n]; ss += (v[0] * v[0] + v[1] * v[1]) + (v[2] * v[2] + v[3] * v[3]); }
                        ss += __shfl_xor(ss, 16); ss += __shfl_xor(ss, 32);
                        rs = 1.0f / sqrtf(ss * (1.0f / 64.0f) + EPS); }
                    u32x4 w[2];
#pragma unroll
                    for (int bj = 0; bj < 2; ++bj) { f32x4 v0 = acc[ai][bj][m][0], v1 = acc[ai][bj][m][1];
                        if (pn < 4) { v0 = v0 * rs * gv[bj][0]; v1 = v1 * rs * gv[bj][1]; }
                        w[bj].x = cvt_pk_bf16(v0[0], v0[1]); w[bj].y = cvt_pk_bf16(v0[2], v0[3]); w[bj].z = cvt_pk_bf16(v1[0], v1[1]); w[bj].w = cvt_pk_bf16(v1[2], v1[3]); }
                    if (pn < 2) { if (!meta) {
#pragma unroll
                            for (int bj = 0; bj < 2; ++bj) *(u32x4*)(P.QF() + (size_t)row * 512 + head * 64 + 32 * bj + 8 * fq) = w[bj]; } }
                    else {
                        int b0, b1, s;
                        if (!meta) { b0 = row >> 11; b1 = b0 + 1; s = NMETA + (row & 2047); } else { const int r = row - MR; s = r; b0 = 0; b1 = r < NMETA ? NB : 0; }
                        for (int b = b0; b < b1; ++b) { const int bh = b * 8 + head;
#pragma unroll
                            for (int bj = 0; bj < 2; ++bj) {
                                if (pn < 4) *(u32x4*)(P.KTF() + kt_off(bh, s, 4 * bj + fq, NCF)) = w[bj];
                                else *(u32x4*)(P.VTF() + vt_off(bh, s, bj, 8 * fq)) = w[bj]; } }
                    }
                }
        } else {
            int kind, colb, slot;
            if (pn == 6) { kind = 0; colb = 64 * wc; slot = wc; }
            else if (pn == 7) { if (wc < 2) { kind = 0; colb = 256 + 64 * wc; slot = 4 + wc; } else { kind = 1; colb = 64 * (wc - 2); slot = wc - 2; } }
            else { if (wc < 2) { kind = 1; colb = 128 + 64 * wc; slot = 2 + wc; } else if (wc == 2) { kind = 2; colb = 0; slot = 0; } else { kind = 3; colb = 0; slot = 0; } }
            if (kind == 3) return;
#pragma unroll
            for (int ai = 0; ai < 2; ++ai)
#pragma unroll
                for (int m = 0; m < 4; ++m) {
                    const int row = rowb + ai * 128 + m * 16;
                    if (kind < 2) {
                        float ss = 0.f;
#pragma unroll
                        for (int bj = 0; bj < 2; ++bj)
#pragma unroll
                            for (int n = 0; n < 2; ++n) { const f32x4 v = acc[ai][bj][m][n]; ss += (v[0] * v[0] + v[1] * v[1]) + (v[2] * v[2] + v[3] * v[3]); }
                        ss += __shfl_xor(ss, 16); ss += __shfl_xor(ss, 32);
                        bf16_t* dst = kind == 0 ? P.CQ() + (size_t)row * 384 + colb : P.CKV() + (size_t)row * 256 + colb;
#pragma unroll
                        for (int bj = 0; bj < 2; ++bj) { const f32x4 v0 = acc[ai][bj][m][0], v1 = acc[ai][bj][m][1]; u32x4 w;
                            w.x = cvt_pk_bf16(v0[0], v0[1]); w.y = cvt_pk_bf16(v0[2], v0[3]); w.z = cvt_pk_bf16(v1[0], v1[1]); w.w = cvt_pk_bf16(v1[2], v1[3]);
                            *(u32x4*)(dst + 32 * bj + 8 * fq) = w; }
                        if (fq == 0) { if (kind == 0) P.SSQCQ()[(size_t)row * 8 + slot] = ss; else P.SSQCKV()[(size_t)row * 4 + slot] = ss; }
                    } else {
                        float ss = 0.f;
#pragma unroll
                        for (int n = 0; n < 2; ++n) { const f32x4 v = acc[ai][0][m][n]; ss += (v[0] * v[0] + v[1] * v[1]) + (v[2] * v[2] + v[3] * v[3]); *(f32x4*)(P.KR() + (size_t)row * 32 + 8 * fq + 4 * n) = v; }
                        ss += __shfl_xor(ss, 16); ss += __shfl_xor(ss, 32);
                        if (fq == 0) { P.SSQKR()[row] = ss;
#pragma unroll
                            for (int n = 0; n < 2; ++n) { const f32x4 v = acc[ai][1][m][n]; const f32x4 bf = *(const f32x4*)(P.b_f + 4 * n); f32x4 o;
                                o[0] = log_sigmoid(v[0] + bf[0]); o[1] = log_sigmoid(v[1] + bf[1]); o[2] = log_sigmoid(v[2] + bf[2]); o[3] = log_sigmoid(v[3] + bf[3]);
                                *(f32x4*)(P.LOGF() + (size_t)row * 8 + 4 * n) = o; } }
                    }
                }
        }
    }
};

struct EpiQup {
    static constexpr bool PERM = true;
    Ptrs P;
    __device__ __forceinline__ void operator()(const f32x4 (&acc)[2][2][4][2], const Unit& u, int wr, int wc, int fr, int fq) const {
        const int rowb = u.pm * 256 + wr * 64 + fr, col0 = u.pn * 256 + wc * 32 + 8 * fq;
#pragma unroll
        for (int ai = 0; ai < 2; ++ai)
#pragma unroll
            for (int m = 0; m < 4; ++m) {
                const int row = rowb + ai * 128 + m * 16;
                const f32x4 s0 = *(const f32x4*)(P.SSQCQ() + (size_t)row * 8); const float s4 = P.SSQCQ()[(size_t)row * 8 + 4], s5 = P.SSQCQ()[(size_t)row * 8 + 5];
                const float rs = 1.0f / sqrtf(((s0[0] + s0[1]) + (s0[2] + s0[3]) + (s4 + s5)) * (1.0f / 384.0f) + EPS);
#pragma unroll
                for (int bj = 0; bj < 2; ++bj) { const f32x4 v0 = acc[ai][bj][m][0] * rs, v1 = acc[ai][bj][m][1] * rs; u32x4 w;
                    w.x = cvt_pk_bf16(v0[0], v0[1]); w.y = cvt_pk_bf16(v0[2], v0[3]); w.z = cvt_pk_bf16(v1[0], v1[1]); w.w = cvt_pk_bf16(v1[2], v1[3]);
                    *(u32x4*)(P.QM() + (size_t)row * 768 + col0 + 128 * bj) = w; }
            }
    }
};

struct EpiKvup {
    static constexpr bool PERM = true;
    Ptrs P;
    __device__ __forceinline__ void operator()(const f32x4 (&acc)[2][2][4][2], const Unit& u, int wr, int wc, int fr, int fq) const {
        const bool meta = (u.pm == MR / 256);
        const int rowb = u.pm * 256 + wr * 64 + fr, head = 2 * u.pn + (wc >> 1); const bool isk = (wc & 1) == 0;
        f32x4 gv[2][2], gr[2];
        if (isk) {
#pragma unroll
            for (int bj = 0; bj < 2; ++bj)
#pragma unroll
                for (int n = 0; n < 2; ++n) gv[bj][n] = *(const f32x4*)(P.g_mla_k + 32 * bj + 8 * fq + 4 * n);
            gr[0] = *(const f32x4*)(P.g_mla_k + 64 + 4 * fq); gr[1] = *(const f32x4*)(P.g_mla_k + 80 + 4 * fq); }
#pragma unroll
        for (int ai = 0; ai < 2; ++ai)
#pragma unroll
            for (int m = 0; m < 4; ++m) {
                const int row = rowb + ai * 128 + m * 16;
                const f32x4 sk = *(const f32x4*)(P.SSQCKV() + (size_t)row * 4);
                const float rl = 1.0f / sqrtf(((sk[0] + sk[1]) + (sk[2] + sk[3])) * (1.0f / 256.0f) + EPS);
                f32x4 v[2][2];
#pragma unroll
                for (int bj = 0; bj < 2; ++bj)
#pragma unroll
                    for (int n = 0; n < 2; ++n) v[bj][n] = acc[ai][bj][m][n] * rl;
                int b0, b1, s;
                if (!meta) { b0 = row >> 11; b1 = b0 + 1; s = NMETA + (row & 2047); } else { const int r = row - MR; s = r < NMETA ? r : 0; b0 = 0; b1 = r < NMETA ? NB : 0; }
                if (isk) {
                    float ss = 0.f;
#pragma unroll
                    for (int bj = 0; bj < 2; ++bj)
#pragma unroll
                        for (int n = 0; n < 2; ++n) { const f32x4 q = v[bj][n]; ss += (q[0] * q[0] + q[1] * q[1]) + (q[2] * q[2] + q[3] * q[3]); }
                    ss += __shfl_xor(ss, 16); ss += __shfl_xor(ss, 32);
                    ss += P.SSQKR()[row];
                    const float rk = 1.0f / sqrtf(ss * (1.0f / 96.0f) + EPS);
                    u32x4 w[2];
#pragma unroll
                    for (int bj = 0; bj < 2; ++bj) { const f32x4 v0 = v[bj][0] * rk * gv[bj][0], v1 = v[bj][1] * rk * gv[bj][1];
                        w[bj].x = cvt_pk_bf16(v0[0], v0[1]); w[bj].y = cvt_pk_bf16(v0[2], v0[3]); w[bj].z = cvt_pk_bf16(v1[0], v1[1]); w[bj].w = cvt_pk_bf16(v1[2], v1[3]); }
                    const f32x4 x1 = *(const f32x4*)(P.KR() + (size_t)row * 32 + 4 * fq) * rk * gr[0], x2 = *(const f32x4*)(P.KR() + (size_t)row * 32 + 16 + 4 * fq) * rk * gr[1];
                    const f32x4 cs0 = *(const f32x4*)(P.ROPE() + ((size_t)s * 16 + 4 * fq) * 2), cs1 = *(const f32x4*)(P.ROPE() + ((size_t)s * 16 + 4 * fq) * 2 + 4);
                    const float c0 = cs0[0], n0 = cs0[1], c1 = cs0[2], n1 = cs0[3], c2 = cs1[0], n2 = cs1[1], c3 = cs1[2], n3 = cs1[3];
                    u32x2 r1, r2;
                    r1.x = cvt_pk_bf16(x1[0] * c0 - x2[0] * n0, x1[1] * c1 - x2[1] * n1); r1.y = cvt_pk_bf16(x1[2] * c2 - x2[2] * n2, x1[3] * c3 - x2[3] * n3);
                    r2.x = cvt_pk_bf16(x1[0] * n0 + x2[0] * c0, x1[1] * n1 + x2[1] * c1); r2.y = cvt_pk_bf16(x1[2] * n2 + x2[2] * c2, x1[3] * n3 + x2[3] * c3);
                    for (int b = b0; b < b1; ++b) { const int bh = b * 8 + head;
#pragma unroll
                        for (int bj = 0; bj < 2; ++bj) *(u32x4*)(P.KTM() + kt_off(bh, s, 4 * bj + fq, NCM)) = w[bj];
                        *(u32x2*)(P.KTM() + kt_off(bh, s, 8 + (fq >> 1), NCM) + 4 * (fq & 1)) = r1;
                        *(u32x2*)(P.KTM() + kt_off(bh, s, 10 + (fq >> 1), NCM) + 4 * (fq & 1)) = r2; }
                } else {
                    u32x4 w[2];
#pragma unroll
                    for (int bj = 0; bj < 2; ++bj) { const f32x4 v0 = v[bj][0], v1 = v[bj][1];
                        w[bj].x = cvt_pk_bf16(v0[0], v0[1]); w[bj].y = cvt_pk_bf16(v0[2], v0[3]); w[bj].z = cvt_pk_bf16(v1[0], v1[1]); w[bj].w = cvt_pk_bf16(v1[2], v1[3]); }
                    for (int b = b0; b < b1; ++b) { const int bh = b * 8 + head;
#pragma unroll
                        for (int bj = 0; bj < 2; ++bj) *(u32x4*)(P.VTM() + vt_off(bh, s, bj, 8 * fq)) = w[bj]; }
                }
            }
    }
};

struct EpiOut {
    static constexpr bool PERM = false;
    Ptrs P;
    __device__ __forceinline__ void rstds(int row, float& rf, float& rm) const {
        const float sf = P.SSQO()[(size_t)row * 2], sm = P.SSQO()[(size_t)row * 2 + 1];
        rf = 1.0f / sqrtf(sf * (1.0f / 512.0f) + EPS); rm = 1.0f / sqrtf(sm * (1.0f / 512.0f) + EPS);
    }
    __device__ __forceinline__ void mid(f32x4 (&acc)[2][2][4][2], const Unit& u, int wr, int fr) const {
#pragma unroll
        for (int ai = 0; ai < 2; ++ai)
#pragma unroll
            for (int m = 0; m < 4; ++m) { float rf, rm; rstds(u.pm * 256 + ai * 128 + wr * 64 + m * 16 + fr, rf, rm); const float ratio = rf / rm;
#pragma unroll
                for (int bj = 0; bj < 2; ++bj)
#pragma unroll
                    for (int n = 0; n < 2; ++n) acc[ai][bj][m][n] *= ratio; }
    }
    __device__ __forceinline__ void operator()(const f32x4 (&acc)[2][2][4][2], const Unit& u, int wr, int wc, int fr, int fq) const {
        const int col0 = u.pn * 256 + wc * 32 + 4 * fq;
#pragma unroll
        for (int ai = 0; ai < 2; ++ai)
#pragma unroll
            for (int m = 0; m < 4; ++m) { const int row = u.pm * 256 + ai * 128 + wr * 64 + m * 16 + fr; float rf, rm; rstds(row, rf, rm);
                const size_t off = (size_t)row * D + col0;
                float ss = 0.f;
#pragma unroll
                for (int bj = 0; bj < 2; ++bj)
#pragma unroll
                    for (int n = 0; n < 2; ++n) { const f32x4 xv = *(const f32x4*)(P.x + off + bj * 128 + n * 16); const f32x4 hv = xv + acc[ai][bj][m][n] * rm; *(f32x4*)(P.out + off + bj * 128 + n * 16) = hv;
                        ss += (hv[0] * hv[0] + hv[1] * hv[1]) + (hv[2] * hv[2] + hv[3] * hv[3]); }
                ss += __shfl_xor(ss, 16); ss += __shfl_xor(ss, 32);
                if (fq == 0) atomicAdd(P.SSQH() + row, ss); }
    }
};

struct EpiMoeUp {
    static constexpr bool PERM = true;
    Ptrs P;
    __device__ __forceinline__ void operator()(const f32x4 (&acc)[2][2][4][2], const Unit& u, int wr, int wc, int fr, int fq) const {
        const int col0 = (u.pn & 1) * 128 + wc * 32 + 8 * fq;
#pragma unroll
        for (int ai = 0; ai < 2; ++ai)
#pragma unroll
            for (int m = 0; m < 4; ++m) { const size_t row = (size_t)u.pm * 256 + ai * 128 + wr * 64 + m * 16 + fr; float h[8];
#pragma unroll
                for (int n = 0; n < 2; ++n)
#pragma unroll
                    for (int e = 0; e < 4; ++e) { const float a = acc[ai][0][m][n][e], b = acc[ai][1][m][n][e]; h[4 * n + e] = a * b / (1.0f + __expf(-a)); }
                u32x4 w; w.x = cvt_pk_bf16(h[0], h[1]); w.y = cvt_pk_bf16(h[2], h[3]); w.z = cvt_pk_bf16(h[4], h[5]); w.w = cvt_pk_bf16(h[6], h[7]);
                *(u32x4*)(P.HD() + row * 256 + col0) = w; }
    }
};
struct EpiMoeDown {
    static constexpr bool PERM = true;
    Ptrs P;
    __device__ __forceinline__ void operator()(const f32x4 (&acc)[2][2][4][2], const Unit& u, int wr, int wc, int fr, int fq) const {
        const int col0 = (u.pn & 3) * 256 + wc * 32 + 8 * fq;
#pragma unroll
        for (int ai = 0; ai < 2; ++ai)
#pragma unroll
            for (int m = 0; m < 4; ++m) { const size_t row = (size_t)u.pm * 256 + ai * 128 + wr * 64 + m * 16 + fr;
#pragma unroll
                for (int bj = 0; bj < 2; ++bj) { const f32x4 v0 = acc[ai][bj][m][0], v1 = acc[ai][bj][m][1]; u32x4 w;
                    w.x = cvt_pk_bf16(v0[0], v0[1]); w.y = cvt_pk_bf16(v0[2], v0[3]); w.z = cvt_pk_bf16(v1[0], v1[1]); w.w = cvt_pk_bf16(v1[2], v1[3]);
                    *(u32x4*)(P.Y() + row * 1024 + col0 + 128 * bj) = w; } }
    }
};
}
namespace mk {
typedef short bf16x8 __attribute__((ext_vector_type(8)));
typedef short s16x4 __attribute__((ext_vector_type(4)));
typedef float f32x16 __attribute__((ext_vector_type(16)));
#define MK_LAS __attribute__((address_space(3)))
__device__ __forceinline__ int crow(int r, int hi) { return (r & 3) + 8 * (r >> 2) + 4 * hi; }
__device__ __forceinline__ s16x4 vtr(const MK_LAS char* p) { typedef short v4 __attribute__((ext_vector_type(4))); return __builtin_bit_cast(s16x4, __builtin_amdgcn_ds_read_tr16_b64_v4i16((MK_LAS v4*)p)); }

template <bool MLA>
__device__ __forceinline__ void attn_unit(MK_LAS unsigned char* lds, const Ptrs& P, int b, int h, int qb) {
    constexpr int NC = MLA ? NCM : NCF, NKS = MLA ? 6 : 5, KSL = NC * 1024, VSL = 8192;
    const int tid = threadIdx.x, lane = tid & 63, r32 = lane & 31, hi = lane >> 5; const int wid = __builtin_amdgcn_readfirstlane(tid >> 6);
    const int qi = qb * 256 + wid * 32 + r32;
    const size_t row = (size_t)b * SEQ + qi;
    const int bh = b * 8 + h;
    const bf16_t* Kt = (MLA ? P.KTM() : P.KTF()) + (size_t)bh * NKT * NC * 512;
    const bf16_t* Vt = (MLA ? P.VTM() : P.VTF()) + (size_t)bh * NKT * 4096;
    const int NT = 4 * qb + 5;
#define MK_DMA(t, buf) do { \
        for (int p_ = wid; p_ < NC; p_ += 8) __builtin_amdgcn_global_load_lds((const unsigned*)(Kt + (size_t)(t) * NC * 512 + p_ * 512 + lane * 8), (MK_LAS unsigned*)(lds + (buf) * KSL + p_ * 1024), 16, 0, 0); \
        __builtin_amdgcn_global_load_lds((const unsigned*)(Vt + (size_t)(t) * 4096 + wid * 512 + lane * 8), (MK_LAS unsigned*)(lds + 2 * KSL + (buf) * VSL + wid * 1024), 16, 0, 0); } while (0)
    MK_DMA(0, 0);
    bf16x8 qf[NKS];
    if constexpr (!MLA) {
        const bf16_t* qp = P.QF() + row * 512 + h * 64 + hi * 8;
#pragma unroll
        for (int d0 = 0; d0 < 4; ++d0) qf[d0] = *(const bf16x8*)(qp + d0 * 16);
        const short one = (short)0x3F80;
        qf[4] = hi == 0 ? (bf16x8){one, one, one, 0, 0, 0, 0, 0} : (bf16x8){0, 0, 0, 0, 0, 0, 0, 0};
    } else {
        const bf16_t* qp = P.QM() + row * 768 + h * 96 + hi * 8;
        float v[6][8]; float ss = 0.f;
#pragma unroll
        for (int d0 = 0; d0 < 6; ++d0) { const bf16x8 raw = *(const bf16x8*)(qp + d0 * 16);
#pragma unroll
            for (int j = 0; j < 8; ++j) { v[d0][j] = bf2f((unsigned short)raw[j]); ss += v[d0][j] * v[d0][j]; } }
        ss += __shfl_xor(ss, 32);
        const float rs = 1.0f / sqrtf(ss * (1.0f / 96.0f) + EPS);
#pragma unroll
        for (int d0 = 0; d0 < 6; ++d0)
#pragma unroll
            for (int j = 0; j < 8; ++j) v[d0][j] *= rs * P.g_mla_q[16 * d0 + 8 * hi + j];
        const float* cs = P.ROPE() + ((size_t)(NMETA + qi) * 16 + 8 * hi) * 2;
#pragma unroll
        for (int j = 0; j < 8; ++j) { const float c = cs[2 * j], s = cs[2 * j + 1], x1 = v[4][j], x2 = v[5][j]; v[4][j] = x1 * c - x2 * s; v[5][j] = x1 * s + x2 * c; }
#pragma unroll
        for (int d0 = 0; d0 < 6; ++d0) { u32x4 w; w.x = cvt_pk_bf16(v[d0][0] * C2M, v[d0][1] * C2M); w.y = cvt_pk_bf16(v[d0][2] * C2M, v[d0][3] * C2M); w.z = cvt_pk_bf16(v[d0][4] * C2M, v[d0][5] * C2M); w.w = cvt_pk_bf16(v[d0][6] * C2M, v[d0][7] * C2M);
            qf[d0] = __builtin_bit_cast(bf16x8, w); }
    }
    float mrow = -1e30f, lrow = 0.f; f32x16 o0 = {}, o1 = {};
    const int sq = NMETA + qi;
    const MK_LAS char* kp0 = (const MK_LAS char*)lds + hi * 1024 + r32 * 16;
    const MK_LAS char* kpa = (const MK_LAS char*)lds + 8 * 1024 + r32 * 16;
    const MK_LAS char* vp0 = (const MK_LAS char*)lds + 2 * KSL + ((lane >> 4) & 1) * 32 + (lane & 3) * 8 + (4 * hi + ((lane & 15) >> 2)) * 64;
    asm volatile("s_waitcnt vmcnt(0)" ::: "memory"); __syncthreads();
    for (int t = 0; t < NT; ++t) {
        const int buf = t & 1;
        if (t + 1 < NT) MK_DMA(t + 1, buf ^ 1);
        f32x16 p0 = {}, p1 = {};
#pragma unroll
        for (int ks = 0; ks < NKS; ++ks) {
            const MK_LAS char* kp = (!MLA && ks == 4) ? kpa + buf * KSL : kp0 + buf * KSL + ks * 2048;
            const bf16x8 k0 = *(const MK_LAS bf16x8*)kp, k1 = *(const MK_LAS bf16x8*)(kp + 512);
            p0 = __builtin_amdgcn_mfma_f32_32x32x16_bf16(k0, qf[ks], p0, 0, 0, 0);
            p1 = __builtin_amdgcn_mfma_f32_32x32x16_bf16(k1, qf[ks], p1, 0, 0, 0);
        }
        if (t >= NT - 5) {
            const int kb = 64 * t + 4 * hi;
#pragma unroll
            for (int r = 0; r < 16; ++r) { const int s = kb + (r & 3) + 8 * (r >> 2); if (s > sq) p0[r] = -INFINITY; if (s + 32 > sq) p1[r] = -INFINITY; }
        }
        float rm = fmaxf(p0[0], p1[0]);
#pragma unroll
        for (int r = 1; r < 16; ++r) rm = fmaxf(rm, fmaxf(p0[r], p1[r]));
        rm = fmaxf(rm, __shfl_xor(rm, 32));
        const float mnew = fmaxf(mrow, rm);
        if (__any(mnew > mrow)) { const float alpha = __builtin_amdgcn_exp2f(mrow - mnew); lrow *= alpha;
#pragma unroll
            for (int r = 0; r < 16; ++r) { o0[r] *= alpha; o1[r] *= alpha; }
            mrow = mnew; }
        float rsum = 0.f;
#pragma unroll
        for (int r = 0; r < 16; ++r) { p0[r] = __builtin_amdgcn_exp2f(p0[r] - mrow); p1[r] = __builtin_amdgcn_exp2f(p1[r] - mrow); rsum += p0[r] + p1[r]; }
        lrow += rsum;
        bf16x8 pw[4];
#pragma unroll
        for (int k = 0; k < 2; ++k) { u32x4 a, c;
            a.x = cvt_pk_bf16(p0[8 * k + 0], p0[8 * k + 1]); a.y = cvt_pk_bf16(p0[8 * k + 2], p0[8 * k + 3]); a.z = cvt_pk_bf16(p0[8 * k + 4], p0[8 * k + 5]); a.w = cvt_pk_bf16(p0[8 * k + 6], p0[8 * k + 7]);
            c.x = cvt_pk_bf16(p1[8 * k + 0], p1[8 * k + 1]); c.y = cvt_pk_bf16(p1[8 * k + 2], p1[8 * k + 3]); c.z = cvt_pk_bf16(p1[8 * k + 4], p1[8 * k + 5]); c.w = cvt_pk_bf16(p1[8 * k + 6], p1[8 * k + 7]);
            pw[k] = __builtin_bit_cast(bf16x8, a); pw[2 + k] = __builtin_bit_cast(bf16x8, c); }
        const MK_LAS char* vp = vp0 + buf * VSL;
#pragma unroll
        for (int ks = 0; ks < 4; ++ks) {
            const s16x4 l0 = vtr(vp + ks * 1024), h0 = vtr(vp + ks * 1024 + 512), l1 = vtr(vp + 4096 + ks * 1024), h1 = vtr(vp + 4096 + ks * 1024 + 512);
            const bf16x8 vf0 = {l0[0], l0[1], l0[2], l0[3], h0[0], h0[1], h0[2], h0[3]}, vf1 = {l1[0], l1[1], l1[2], l1[3], h1[0], h1[1], h1[2], h1[3]};
            o0 = __builtin_amdgcn_mfma_f32_32x32x16_bf16(vf0, pw[ks], o0, 0, 0, 0);
            o1 = __builtin_amdgcn_mfma_f32_32x32x16_bf16(vf1, pw[ks], o1, 0, 0, 0);
        }
        asm volatile("s_waitcnt vmcnt(0)" ::: "memory"); __syncthreads();
    }
#undef MK_DMA
    lrow += __shfl_xor(lrow, 32);
    const float inv = 1.0f / lrow; float ssq = 0.f;
    bf16_t* op = P.O() + row * 1024 + (MLA ? 512 : 0) + h * 64 + 4 * hi;
#pragma unroll
    for (int g = 0; g < 4; ++g) {
        const float a0 = o0[4 * g] * inv, a1 = o0[4 * g + 1] * inv, a2 = o0[4 * g + 2] * inv, a3 = o0[4 * g + 3] * inv;
        const float c0 = o1[4 * g] * inv, c1 = o1[4 * g + 1] * inv, c2 = o1[4 * g + 2] * inv, c3 = o1[4 * g + 3] * inv;
        ssq += (a0 * a0 + a1 * a1) + (a2 * a2 + a3 * a3) + (c0 * c0 + c1 * c1) + (c2 * c2 + c3 * c3);
        u32x2 w0, w1; w0.x = cvt_pk_bf16(a0, a1); w0.y = cvt_pk_bf16(a2, a3); w1.x = cvt_pk_bf16(c0, c1); w1.y = cvt_pk_bf16(c2, c3);
        *(u32x2*)(op + 8 * g) = w0; *(u32x2*)(op + 32 + 8 * g) = w1;
    }
    ssq += __shfl_xor(ssq, 32);
    if (hi == 0) atomicAdd(P.SSQO() + row * 2 + (MLA ? 1 : 0), ssq);
}

__device__ __forceinline__ void attn_phase(MK_LAS unsigned char* lds, const Ptrs& P, int vcu, int G) {
    for (int id = vcu; id < 1024; id += G) {
        const int v = id & 255, k = id >> 8, bh = v >> 2, sub = v & 3, qb = (k & 1) ? sub : 7 - sub;
        if (k >> 1) attn_unit<true>(lds, P, bh >> 3, bh & 7, qb); else attn_unit<false>(lds, P, bh >> 3, bh & 7, qb);
    }
}
}
namespace mk {
constexpr int NWAVES = 8;
constexpr int RING_BYTES = 131072, LDSCTL_OFF = RING_BYTES, LDS_BYTES = 147456;
#define GAS __attribute__((address_space(1)))
#define RLX_AGENT __ATOMIC_RELAXED, __HIP_MEMORY_SCOPE_AGENT
#define LDS_WAIT() asm volatile("s_waitcnt lgkmcnt(0)" ::: "memory")

#define XB_TMO      128
#define XB_XCNT(j)  (256  + 64 * (j))
#define XB_XSUB(j)  (1280 + 64 * (j))
#define XB_XGEN(j)  (2304 + 64 * (j))
#define XB_TOP      3328
#define XB_TOPGEN   3392
#define XCD_BAR_WORDS 3456
#define XB_SPIN_CAP (1u << 18)
__device__ __forceinline__ unsigned xb_ld(unsigned* p)              { return __hip_atomic_load(p, __ATOMIC_RELAXED, __HIP_MEMORY_SCOPE_AGENT); }
__device__ __forceinline__ unsigned xb_add(unsigned* p, unsigned v) { return __hip_atomic_fetch_add(p, v, __ATOMIC_RELAXED, __HIP_MEMORY_SCOPE_AGENT); }
__device__ __forceinline__ unsigned xb_xcc_id() { return (unsigned)__builtin_amdgcn_s_getreg((3 << 11) | 20) & 0xFu; }
#define XB_SPIN(cond, bar) do { unsigned _sp = 0; while (cond) { __builtin_amdgcn_s_sleep(1); \
    if ((++_sp & 255u) == 0u) { if (xb_ld(&(bar)[XB_TMO])) break; if (_sp > XB_SPIN_CAP) { atomicAdd(&(bar)[XB_TMO], 1u); break; } } } } while (0)
struct XcdBarrier { unsigned* bar; unsigned x; volatile MK_LAS unsigned* st; };
__device__ __forceinline__ XcdBarrier xcd_barrier_post(unsigned* bar, volatile MK_LAS unsigned* st) {
    XcdBarrier b; b.bar = bar; b.x = xb_xcc_id(); b.st = st;
    if (threadIdx.x == 0) (void)xb_add(&bar[XB_XCNT(b.x)], 1u);
    return b;
}
__device__ __forceinline__ void xcd_barrier_complete(unsigned* bar, unsigned x, unsigned& nloc, unsigned& nx) {
    const unsigned G = gridDim.x * gridDim.y * gridDim.z;
    unsigned sum, cnt, mine, sp = 0u;
    for (;;) {
        sum = 0u; cnt = 0u; mine = 0u;
#pragma unroll
        for (unsigned j = 0; j < 16; ++j) { const unsigned c = xb_ld(&bar[XB_XCNT(j)]); sum += c; cnt += (c > 0u) ? 1u : 0u; mine = (j == x) ? c : mine; }
        if (sum == G) break;
        __builtin_amdgcn_s_sleep(1);
        if ((++sp & 255u) == 0u) { if (xb_ld(&bar[XB_TMO])) break; if (sp > XB_SPIN_CAP) { atomicAdd(&bar[XB_TMO], 1u); break; } }
    }
    nloc = mine > 0u ? mine : 1u; nx = cnt > 0u ? cnt : 1u;
}
__device__ __forceinline__ void xcd_barrier(const XcdBarrier& b) {
    asm volatile("s_waitcnt vmcnt(0)" ::: "memory");
    __syncthreads();
    if (threadIdx.x == 0) {
        unsigned* bar = b.bar;
        __builtin_amdgcn_s_waitcnt(0);
        unsigned nloc = b.st[0], nx = b.st[1];
        if (nloc == 0u) { xcd_barrier_complete(bar, b.x, nloc, nx); b.st[0] = nloc; b.st[1] = nx; }
        const unsigned old = xb_add(&bar[XB_XSUB(b.x)], 1u);
        const unsigned gen = old / nloc;
        if (old + 1u == (gen + 1u) * nloc) {
            __builtin_amdgcn_fence(__ATOMIC_RELEASE, "agent");
            asm volatile("s_waitcnt vmcnt(0)" ::: "memory");
            const unsigned og = xb_add(&bar[XB_TOP], 1u);
            const unsigned tg = og / nx;
            if (og + 1u == (tg + 1u) * nx) xb_add(&bar[XB_TOPGEN], 1u);
            else XB_SPIN(xb_ld(&bar[XB_TOPGEN]) == tg, bar);
            __builtin_amdgcn_fence(__ATOMIC_ACQUIRE, "agent");
            xb_add(&bar[XB_XGEN(b.x)], 1u);
            asm volatile("s_waitcnt vmcnt(0)" ::: "memory");
        } else {
            XB_SPIN(xb_ld(&bar[XB_XGEN(b.x)]) == gen, bar);
            __builtin_amdgcn_fence(__ATOMIC_ACQUIRE, "agent");
            asm volatile("s_waitcnt vmcnt(0)" ::: "memory");
        }
    }
    __syncthreads();
}

__device__ __forceinline__ float wave_sum(float v) {
#pragma unroll
    for (int o = 1; o < 64; o <<= 1) v += __shfl_xor(v, o);
    return v;
}
__device__ __forceinline__ unsigned pk2(float lo, float hi) { return f2bf(lo) | (f2bf(hi) << 16); }

__device__ __forceinline__ void p0_item(const float* W, int ldw, int col0, int nvalid, const float* gk, bf16_t* WT, int K, int n0, int k0, MK_LAS float* scr, int lane) {
    const int c = lane & 31;
#pragma unroll
    for (int i = 0; i < 32; ++i) { const int kk = 2 * i + (lane >> 5); float v = (c < nvalid) ? W[(size_t)(k0 + kk) * ldw + col0 + c] : 0.f; if (gk) v *= gk[kk]; scr[kk * 33 + c] = v; }
    LDS_WAIT(); asm volatile("" ::: "memory");
    const int ch = lane & 7;
#pragma unroll
    for (int j = 0; j < 4; ++j) { const int n = (lane >> 3) + 8 * j; const MK_LAS float* s = scr + (8 * ch) * 33 + n;
        u32x4 o; o.x = pk2(s[0 * 33], s[1 * 33]); o.y = pk2(s[2 * 33], s[3 * 33]); o.z = pk2(s[4 * 33], s[5 * 33]); o.w = pk2(s[6 * 33], s[7 * 33]);
        *(GAS u32x4*)(WT + (size_t)(n0 + n) * K + k0 + 8 * ch) = o; }
    LDS_WAIT(); asm volatile("" ::: "memory");
}
__device__ __forceinline__ void p0_prologue(const Ptrs& P, MK_LAS unsigned char* lds, int vcu, int G, int wave, int lane) {
    MK_LAS float* scr = (MK_LAS float*)(lds + wave * 16384);
    const int gw = vcu * NWAVES + wave, NGW = G * NWAVES;
    constexpr int I_IN = 16 * 72, I_UQ = 6 * 24, I_UKV = 4 * 32, I_O = 16 * 32, I_13 = 32 * 256, I_2 = 32 * 128;
    constexpr int NITEMS = I_IN + I_UQ + I_UKV + I_O + I_13 + I_2;
    for (int it = gw; it < NITEMS; it += NGW) {
        int r = it;
        if (r < I_IN) { const int kb = r / 72, nb = r % 72, n0 = 32 * nb, pn = n0 >> 8, wi = n0 & 255, bj = wi >> 7, wc = (wi >> 5) & 3, LG = 256 * pn + 64 * wc + 32 * bj;
            int src = 0, nv = 32;
            if (LG < 1536) src = LG; else if (LG < 1920) src = 1544 + (LG - 1536); else if (LG < 2176) src = 1928 + (LG - 1920); else if (LG < 2208) src = 2184 + (LG - 2176); else if (LG == 2208) { src = 1536; nv = 8; } else nv = 0;
            p0_item(P.w_in, 2216, src, nv, nullptr, P.WIN(), 1024, n0, 64 * kb, scr, lane); continue; } r -= I_IN;
        if (r < I_UQ) { const int kb = r / 24, nb = r % 24; p0_item(P.w_uq, 768, 32 * nb, 32, P.g_q_lat + 64 * kb, P.WUQ(), 384, 32 * nb, 64 * kb, scr, lane); continue; } r -= I_UQ;
        if (r < I_UKV) { const int kb = r / 32, nb = r % 32, n0 = 32 * nb, pn = n0 >> 8, bj = (n0 >> 7) & 1, wc = (n0 >> 5) & 3;
            p0_item(P.w_ukv, 1024, (2 * pn + (wc >> 1)) * 128 + (wc & 1) * 64 + 32 * bj, 32, P.g_kv_lat + 64 * kb, P.WUKV(), 256, n0, 64 * kb, scr, lane); continue; } r -= I_UKV;
        if (r < I_O) { const int kb = r / 32, nb = r % 32; p0_item(P.w_o, 1024, 32 * nb, 32, kb < 8 ? P.g_fox_out + 64 * kb : P.g_mla_out + 64 * (kb - 8), P.WO(), 1024, 32 * nb, 64 * kb, scr, lane); continue; } r -= I_O;
        if (r < I_13) { const int e = r >> 8, rr = r & 255, kb = rr >> 4, nb = rr & 15, n0 = 32 * nb, pn = n0 >> 8, bj = (n0 >> 7) & 1, wc = (n0 >> 5) & 3;
            p0_item((bj ? P.w3 : P.w1) + (size_t)e * 262144, 256, 128 * pn + 32 * wc, 32, nullptr, P.W13() + (size_t)e * 524288, 1024, n0, 64 * kb, scr, lane); continue; } r -= I_13;
        { const int e = r >> 7, rr = r & 127, kb = rr >> 5, nb = rr & 31; p0_item(P.w2 + (size_t)e * 262144, 1024, 32 * nb, 32, nullptr, P.W2() + (size_t)e * 262144, 256, 32 * nb, 64 * kb, scr, lane); }
    }
    for (int m = gw; m < MP; m += NGW) {
        GAS unsigned long long* o8 = (GAS unsigned long long*)(P.XN() + (size_t)m * D) + lane;
        if (m >= MR + NMETA) {
#pragma unroll
            for (int j = 0; j < 4; ++j) o8[64 * j] = 0ull;
            continue; }
        const float* src = m < MR ? P.x + (size_t)m * D : P.meta + (size_t)(m - MR) * D;
        const GAS f32x4* xr = (const GAS f32x4*)src + lane; f32x4 v[4]; float s = 0.f;
#pragma unroll
        for (int j = 0; j < 4; ++j) { v[j] = xr[64 * j]; s += (v[j][0] * v[j][0] + v[j][1] * v[j][1]) + (v[j][2] * v[j][2] + v[j][3] * v[j][3]); }
        const float rstd = 1.f / sqrtf(wave_sum(s) * (1.f / D) + EPS);
#pragma unroll
        for (int j = 0; j < 4; ++j) { const f32x4 g = *(const f32x4*)(P.g_attn + 4 * lane + 256 * j);
            o8[64 * j] = (unsigned long long)pk2(v[j][0] * rstd * g[0], v[j][1] * rstd * g[1]) | ((unsigned long long)pk2(v[j][2] * rstd * g[2], v[j][3] * rstd * g[3]) << 32); }
    }
    for (int idx = vcu * (NWAVES * 64) + (int)threadIdx.x; idx < 64 * 2368; idx += G * NWAVES * 64) {
        const int bh = idx / 2368, r = idx % 2368; u32x4* p;
        if (r < 576) p = (u32x4*)(P.KTF() + ((size_t)bh * NKT + 32) * NCF * 512) + r;
        else if (r < 1344) p = (u32x4*)(P.KTM() + ((size_t)bh * NKT + 32) * NCM * 512) + (r - 576);
        else if (r < 1856) p = (u32x4*)(P.VTF() + ((size_t)bh * NKT + 32) * 4096) + (r - 1344);
        else p = (u32x4*)(P.VTM() + ((size_t)bh * NKT + 32) * 4096) + (r - 1856);
        *p = (u32x4){0u, 0u, 0u, 0u}; }
    for (int idx = vcu * (NWAVES * 64) + (int)threadIdx.x; idx < 48 * 128; idx += G * NWAVES * 64) {
        const int n = idx >> 7, k0 = (idx & 127) * 8; float v[8];
#pragma unroll
        for (int j = 0; j < 8; ++j) v[j] = n < 4 ? P.w_group[(size_t)(k0 + j) * 4 + n] : (n < 36 ? P.w_expert[(size_t)(k0 + j) * 32 + (n - 4)] : 0.f);
        u32x4 w; w.x = pk2(v[0], v[1]); w.y = pk2(v[2], v[3]); w.z = pk2(v[4], v[5]); w.w = pk2(v[6], v[7]);
        *(u32x4*)(P.WR() + (size_t)n * D + k0) = w; }
    for (int idx = vcu * (NWAVES * 64) + (int)threadIdx.x; idx < LSEQ * 16; idx += G * NWAVES * 64) {
        const int pos = idx >> 4, i = idx & 15; const float inv_freq = expf(-logf(10000.0f) * (float)i / 16.0f), ang = (float)pos * inv_freq;
        P.ROPE()[2 * idx] = cosf(ang); P.ROPE()[2 * idx + 1] = sinf(ang); }
}

__device__ __forceinline__ void fox_bias_store(const Ptrs& P, int bh, int s, float cum) {
    const float bias = -cum * LOG2E;
    const unsigned h_ = f2bf(bias); const float r1 = bias - bf2f((unsigned short)h_); const unsigned m_ = f2bf(r1); const float r2 = r1 - bf2f((unsigned short)m_); const unsigned l_ = f2bf(r2);
    u32x4 w; w.x = h_ | (m_ << 16); w.y = l_; w.z = 0u; w.w = 0u;
    *(u32x4*)(P.KTF() + kt_off(bh, s, 8, NCF)) = w;
}
__device__ __forceinline__ void fox_scan(const Ptrs& P, int bh, int lane) {
    const int b = bh >> 3, h = bh & 7;
    float x = lane < NMETA ? P.LOGF()[(size_t)(MR + lane) * 8 + h] : 0.f;
#pragma unroll
    for (int o = 1; o < 16; o <<= 1) { const float y = __shfl_up(x, o); if (lane >= o) x += y; }
    if (lane < NMETA) fox_bias_store(P, bh, lane, x);
    const float mtot = __shfl(x, NMETA - 1);
    float v[32]; float run = 0.f;
#pragma unroll
    for (int j = 0; j < 32; ++j) { run += P.LOGF()[((size_t)b * SEQ + 32 * lane + j) * 8 + h]; v[j] = run; }
    float inc = run;
#pragma unroll
    for (int o = 1; o < 64; o <<= 1) { const float y = __shfl_up(inc, o); if (lane >= o) inc += y; }
    const float base = mtot + (inc - run);
#pragma unroll
    for (int j = 0; j < 32; ++j) fox_bias_store(P, bh, NMETA + 32 * lane + j, base + v[j]);
}

struct MoeTab { int lo, hi, cnt; };
__device__ __forceinline__ MoeTab moe_tab(const Ptrs& P, int lane) {
    MoeTab T; T.cnt = (int)__hip_atomic_load(P.ctl() + CW_CNT + 64 * (lane & 31), RLX_AGENT);
    const int nt = (T.cnt + 255) >> 8; int x = nt;
#pragma unroll
    for (int o = 1; o < 32; o <<= 1) { const int y = __shfl_up(x, o, 32); if ((lane & 31) >= o) x += y; }
    T.hi = x; T.lo = x - nt; return T;
}
template <bool UP>
struct MoeOrder {
    static constexpr int NCOL = UP ? 2 : 4;
    int G, c; MoeTab T; const bf16_t* XN2; const bf16_t* W13; const bf16_t* HD; const bf16_t* W2; const int* LISTP;
    __device__ __forceinline__ bool next(int i, Unit& u) const {
        const int L = i * G + c, total = __builtin_amdgcn_readlane(T.hi, 31);
        if (L >= total * NCOL) return false;
        const int tile = L / NCOL, pn = L % NCOL;
        const unsigned long long mask = __ballot(tile >= T.lo) & 0xffffffffull;
        const int e = __builtin_amdgcn_readfirstlane(__popcll(mask) - 1);
        const int base = __builtin_amdgcn_readlane(T.lo, e);
        u.pm = tile; u.pn = e * NCOL + pn; u.ex = (e << 16) | (tile - base);
        if (UP) { u.A = (const char*)XN2; u.B = (const char*)(W13 + ((size_t)e * 512 + pn * 256) * 1024); }
        else { u.A = (const char*)(HD + (size_t)tile * 256 * 256); u.B = (const char*)(W2 + ((size_t)e * 1024 + pn * 256) * 256); }
        return true;
    }
    __device__ __forceinline__ void gather(const Unit& u, int R0, int C0, int R1, int C1, unsigned (&off)[4]) const {
        const int e = u.ex >> 16, rt = u.ex & 0xffff, cnt = __builtin_amdgcn_readlane(T.cnt, e);
        const int* list = LISTP + (size_t)e * CAP;
#pragma unroll
        for (int hh = 0; hh < 2; ++hh) {
            int i0 = rt * 256 + 128 * hh + R0, i1 = rt * 256 + 128 * hh + R1; i0 = i0 < cnt ? i0 : cnt - 1; i1 = i1 < cnt ? i1 : cnt - 1;
            off[hh * 2 + 0] = (unsigned)list[i0] * 2048u + (unsigned)C0 * 2u; off[hh * 2 + 1] = (unsigned)list[i1] * 2048u + (unsigned)C1 * 2u; }
    }
};

__device__ __forceinline__ void router_phase(const Ptrs& P, MK_LAS unsigned char* lds, int vcu, int G, int wave, int lane) {
    MK_LAS float* LG = (MK_LAS float*)lds;
    const int m = lane & 15, kq = lane >> 4, tsk = wave & 3, kh = wave >> 2;
    for (int tb = vcu * 64; tb < MR; tb += G * 64) {
        const int t = tb + tsk * 16 + m;
        const float rstd = 1.0f / sqrtf(P.SSQH()[t] * (1.0f / D) + EPS);
        f32x4 acc[3] = {{0.f, 0.f, 0.f, 0.f}, {0.f, 0.f, 0.f, 0.f}, {0.f, 0.f, 0.f, 0.f}};
        const float* hp = P.out + (size_t)t * D + kh * 512 + 8 * kq; const float* gp = P.g_ffn + kh * 512 + 8 * kq;
        bf16_t* xp = P.XN2() + (size_t)t * D + kh * 512 + 8 * kq; const bf16_t* wp = P.WR() + (size_t)m * D + kh * 512 + 8 * kq;
#pragma unroll 4
        for (int ks = 0; ks < 16; ++ks) {
            const f32x4 h0 = *(const f32x4*)(hp + 32 * ks), h1 = *(const f32x4*)(hp + 32 * ks + 4), g0 = *(const f32x4*)(gp + 32 * ks), g1 = *(const f32x4*)(gp + 32 * ks + 4);
            const f32x4 u0 = h0 * g0 * rstd, u1 = h1 * g1 * rstd;
            u32x4 w; w.x = cvt_pk_bf16(u0[0], u0[1]); w.y = cvt_pk_bf16(u0[2], u0[3]); w.z = cvt_pk_bf16(u1[0], u1[1]); w.w = cvt_pk_bf16(u1[2], u1[3]);
            *(u32x4*)(xp + 32 * ks) = w;
            const bf16x8 a = __builtin_bit_cast(bf16x8, w);
#pragma unroll
            for (int nb = 0; nb < 3; ++nb) { const bf16x8 b = *(const bf16x8*)(wp + (size_t)nb * 16 * D + 32 * ks); acc[nb] = __builtin_amdgcn_mfma_f32_16x16x32_bf16(a, b, acc[nb], 0, 0, 0); }
        }
#pragma unroll
        for (int nb = 0; nb < 3; ++nb)
#pragma unroll
            for (int r = 0; r < 4; ++r) LG[((tsk * 2 + kh) * 16 + 4 * kq + r) * 48 + 16 * nb + m] = acc[nb][r];
        __syncthreads();
        if (kh == 0 && lane < 16) {
            const MK_LAS float* l0 = LG + ((tsk * 2 + 0) * 16 + lane) * 48; const MK_LAS float* l1 = LG + ((tsk * 2 + 1) * 16 + lane) * 48; const int tt = tb + tsk * 16 + lane;
            float gl[4];
#pragma unroll
            for (int i = 0; i < 4; ++i) gl[i] = l0[i] + l1[i] + P.b_group[i];
            int gi = 0; float gm = gl[0];
#pragma unroll
            for (int i = 1; i < 4; ++i) if (gl[i] > gm) { gm = gl[i]; gi = i; }
            float den = 0.f;
#pragma unroll
            for (int i = 0; i < 4; ++i) den += expf(gl[i] - gm);
            const float psel = 1.0f / den;
            float w8[8];
#pragma unroll
            for (int i = 0; i < 8; ++i) w8[i] = l0[4 + gi * 8 + i] + l1[4 + gi * 8 + i] + P.b_expert[gi * 8 + i];
            int i0 = 0; float v0 = w8[0];
#pragma unroll
            for (int i = 1; i < 8; ++i) if (w8[i] > v0) { v0 = w8[i]; i0 = i; }
            int i1 = -1; float v1 = -INFINITY;
#pragma unroll
            for (int i = 0; i < 8; ++i) if (i != i0 && (i1 < 0 || w8[i] > v1)) { v1 = w8[i]; i1 = i; }
            const float e1 = expf(v1 - v0);
            const float wa = psel / (1.0f + e1), wb = psel * e1 / (1.0f + e1);
            const int ea = gi * 8 + i0, eb = gi * 8 + i1;
            const unsigned pa = __hip_atomic_fetch_add(P.ctl() + CW_CNT + 64 * ea, 1u, RLX_AGENT), pb = __hip_atomic_fetch_add(P.ctl() + CW_CNT + 64 * eb, 1u, RLX_AGENT);
            P.LIST()[(size_t)ea * CAP + pa] = tt; P.LIST()[(size_t)eb * CAP + pb] = tt;
            u32x4 r0; r0.x = (unsigned)ea; r0.y = pa; r0.z = (unsigned)eb; r0.w = pb; *(u32x4*)(P.TOK() + (size_t)tt * 8) = r0;
            u32x2 r1; r1.x = __builtin_bit_cast(unsigned, wa); r1.y = __builtin_bit_cast(unsigned, wb); *(u32x2*)(P.TOK() + (size_t)tt * 8 + 4) = r1;
        }
        __syncthreads();
    }
}

__device__ __forceinline__ void combine_phase(const Ptrs& P, int vcu, int G, int wave, int lane) {
    const MoeTab T = moe_tab(P, lane);
    const int gw = vcu * NWAVES + wave, NGW = G * NWAVES;
    for (int t = gw; t < MR; t += NGW) {
        const u32x4 r0 = *(const u32x4*)(P.TOK() + (size_t)t * 8); const unsigned r1x = __hip_atomic_load(P.TOK() + (size_t)t * 8 + 4, RLX_AGENT), r1y = __hip_atomic_load(P.TOK() + (size_t)t * 8 + 5, RLX_AGENT);
        const int ea = __builtin_amdgcn_readfirstlane((int)r0.x), eb = __builtin_amdgcn_readfirstlane((int)r0.z);
        const size_t sa = (size_t)__builtin_amdgcn_readlane(T.lo, ea) * 256 + r0.y, sb = (size_t)__builtin_amdgcn_readlane(T.lo, eb) * 256 + r0.w;
        float wa = __builtin_bit_cast(float, r1x), wb = __builtin_bit_cast(float, r1y);
        asm volatile("" : "+v"(wa)); asm volatile("" : "+v"(wb));
        GAS f32x4* o = (GAS f32x4*)(P.out + (size_t)t * D) + lane;
        const GAS u32x2* ya = (const GAS u32x2*)(P.Y() + sa * 1024) + lane; const GAS u32x2* yb = (const GAS u32x2*)(P.Y() + sb * 1024) + lane;
#pragma unroll
        for (int j = 0; j < 4; ++j) { const f32x4 hv = o[64 * j]; const u32x2 a = ya[64 * j], b = yb[64 * j]; f32x4 r;
            r[0] = hv[0] + wa * __builtin_bit_cast(float, a.x << 16) + wb * __builtin_bit_cast(float, b.x << 16);
            r[1] = hv[1] + wa * __builtin_bit_cast(float, a.x & 0xffff0000u) + wb * __builtin_bit_cast(float, b.x & 0xffff0000u);
            r[2] = hv[2] + wa * __builtin_bit_cast(float, a.y << 16) + wb * __builtin_bit_cast(float, b.y << 16);
            r[3] = hv[3] + wa * __builtin_bit_cast(float, a.y & 0xffff0000u) + wb * __builtin_bit_cast(float, b.y & 0xffff0000u);
            o[64 * j] = r; }
    }
}

struct Args { Ptrs P; int ph_lo, ph_hi; };
constexpr int N_PHASES = 9;
__global__ void __launch_bounds__(NWAVES * 64, 2) mega_fwd(Args args) {
    extern __shared__ __attribute__((aligned(16))) unsigned char lds_raw[];
    MK_LAS unsigned char* lds = (MK_LAS unsigned char*)lds_raw;
    const Ptrs& P = args.P;
    const int tid = threadIdx.x, lane = tid & 63, wave = __builtin_amdgcn_readfirstlane(tid >> 6);
    const int G = gridDim.x; const int bx = blockIdx.x; const int vcu = (G % 8 == 0) ? (bx % 8) * (G / 8) + bx / 8 : bx;
    volatile MK_LAS unsigned* MISC = (volatile MK_LAS unsigned*)(lds + LDSCTL_OFF);
    for (int u = tid; u < (LDS_BYTES - LDSCTL_OFF) / 4; u += NWAVES * 64) ((MK_LAS unsigned*)(lds + LDSCTL_OFF))[u] = 0u;
    __syncthreads();
    const int lo = args.ph_lo, hi = args.ph_hi;
    XcdBarrier bar = xcd_barrier_post(P.ctl() + CW_BAR, MISC + 8);
#ifndef PH_MASK
#define PH_MASK 0x1ff
#endif
#define IN(k) (((PH_MASK >> (k)) & 1) && lo <= (k) && (k) < hi)
#ifndef PROBE_PHASE
#define PROBE_PHASE (-1)
#endif
#ifndef PROBE_MUL
#define PROBE_MUL 4
#endif
    unsigned long long ts_prev = 0ull, ts_probe = 0ull;
    if (PROBE_PHASE >= 0) ts_prev = __builtin_amdgcn_s_memrealtime();
#define SEAM(k) do { if (IN(k) && IN((k) + 1)) xcd_barrier(bar); if (PROBE_PHASE >= 0) { const unsigned long long now_ = __builtin_amdgcn_s_memrealtime(); if ((k) == PROBE_PHASE) ts_probe = now_ - ts_prev; ts_prev = now_; } } while (0)
    if (IN(0)) { p0_prologue(P, lds, vcu, G, wave, lane); }
    SEAM(0);
    if (IN(1)) { pg8::StaticOrder S; S.init(P.XN(), P.WIN(), MP, NIN, 1024, G, bx); EpiInProj E{P}; pg8::gemm_phase<EpiInProj, pg8::StaticOrder>(lds, 1024, S, E); }
    SEAM(1);
    if (IN(2)) {
#ifndef P2SUB
#define P2SUB 7
#endif
        if ((P2SUB & 1) && vcu < 64 && wave == 0) fox_scan(P, vcu, lane);
        if (P2SUB & 2) { pg8::StaticOrder S; S.init(P.CQ(), P.WUQ(), MR, 768, 384, G, bx); EpiQup E{P}; pg8::gemm_phase<EpiQup, pg8::StaticOrder>(lds, 384, S, E); }
        if (P2SUB & 4) { pg8::StaticOrder S; S.init(P.CKV(), P.WUKV(), MP, 1024, 256, G, (bx + 64) % G); EpiKvup E{P}; pg8::gemm_phase<EpiKvup, pg8::StaticOrder>(lds, 256, S, E); }
    }
    SEAM(2);
    if (IN(3)) attn_phase(lds, P, vcu, G);
    SEAM(3);
    if (IN(4)) { pg8::StaticOrder S; S.init(P.O(), P.WO(), MR, 1024, 1024, G, bx); EpiOut E{P}; pg8::gemm_phase<EpiOut, pg8::StaticOrder, false, true>(lds, 1024, S, E); }
    SEAM(4);
    if (IN(5)) router_phase(P, lds, vcu, G, wave, lane);
    SEAM(5);
    if (IN(6)) { MoeOrder<true> S; S.G = G; S.c = bx; S.T = moe_tab(P, lane); S.XN2 = P.XN2(); S.W13 = P.W13(); S.HD = P.HD(); S.W2 = P.W2(); S.LISTP = P.LIST(); EpiMoeUp E{P}; pg8::gemm_phase<EpiMoeUp, MoeOrder<true>, true>(lds, 1024, S, E); }
    SEAM(6);
    if (IN(7)) { MoeOrder<false> S; S.G = G; S.c = bx; S.T = moe_tab(P, lane); S.XN2 = P.XN2(); S.W13 = P.W13(); S.HD = P.HD(); S.W2 = P.W2(); S.LISTP = P.LIST(); EpiMoeDown E{P}; pg8::gemm_phase<EpiMoeDown, MoeOrder<false>>(lds, 256, S, E); }
    SEAM(7);
    if (IN(8)) combine_phase(P, vcu, G, wave, lane);
    SEAM(8);
    if (PROBE_PHASE >= 0 && bx == 0 && tid == 0) { const unsigned long long t0_ = __builtin_amdgcn_s_memrealtime(); while (__builtin_amdgcn_s_memrealtime() - t0_ < (unsigned long long)PROBE_MUL * ts_probe) __builtin_amdgcn_s_sleep(16); }
#undef IN
#undef SEAM
}
}
#ifndef DEBUG_STAGE
#define DEBUG_STAGE 0
#endif
#if DEBUG_STAGE
namespace dbg {
using namespace mk;
__global__ void k_snap(Ptrs P, int mode, float* snap, int ncols) {
    const int r = blockIdx.x; const int b = DBG_B;
    for (int c = threadIdx.x; c < ncols; c += blockDim.x) {
        float v = 0.f;
        const int i = r - NMETA; const size_t row = (size_t)b * SEQ + (i < 0 ? 0 : i);
        if (mode == 0) { v = i < 0 ? 0.f : bf2f(P.QF()[row * 512 + c]) / C2F; }
        else if (mode == 1) { const int h = c >> 6, d = c & 63; v = bf2f(P.KTF()[kt_off(b * 8 + h, r, d >> 3, NCF) + (d & 7)]); }
        else if (mode == 2) { const int h = c >> 6, d = c & 63; v = bf2f(P.VTF()[vt_off(b * 8 + h, r, d >> 5, d & 31)]); }
        else if (mode == 3) { const bf16_t* p = P.KTF() + kt_off(b * 8 + c, r, 8, NCF); v = bf2f(p[0]) + bf2f(p[1]) + bf2f(p[2]); }
        else if (mode == 4) { v = i < 0 ? 0.f : bf2f(P.QM()[row * 768 + c]); }
        else if (mode == 5) { const int h = c / 96, d = c % 96; v = bf2f(P.KTM()[kt_off(b * 8 + h, r, d >> 3, NCM) + (d & 7)]); }
        else if (mode == 6) { const int h = c >> 6, d = c & 63; v = bf2f(P.VTM()[vt_off(b * 8 + h, r, d >> 5, d & 31)]); }
        else if (mode == 7) { v = i < 0 ? 0.f : bf2f(P.O()[row * 1024 + c]); }
        else if (mode == 8) { v = i < 0 ? 0.f : P.out[row * 1024 + c]; }
        else if (mode == 9) { v = i < 0 ? 0.f : bf2f(P.XN2()[row * 1024 + c]); }
        else if (mode == 10 || mode == 11) { if (i >= 0) { const unsigned* tk = P.TOK() + row * 8; const int e = (int)tk[mode == 10 ? 0 : 2]; const unsigned pos = tk[mode == 10 ? 1 : 3]; const float w = __builtin_bit_cast(float, tk[mode == 10 ? 4 : 5]);
                int lo = 0; for (int q = 0; q < e; ++q) lo += ((int)P.ctl()[CW_CNT + 64 * q] + 255) >> 8;
                v = w * bf2f(P.Y()[((size_t)lo * 256 + pos) * 1024 + c]); } }
        snap[(size_t)r * ncols + c] = v;
    }
}
__global__ void k_bias_ref(const float* cum, float* o) { const int r = blockIdx.x, h = threadIdx.x; o[r * 8 + h] = -cum[h * LSEQ + r] * LOG2E; }
__global__ void k_cmp(const float* a, int lda, int offa, const float* ref, int ldb, int offb, int hw, int hs, int r0, int ncols, float* sums, int k) {
    const int r = blockIdx.x; if (r < r0) return;
    float d2 = 0.f, b2 = 0.f;
    for (int c = threadIdx.x; c < ncols; c += blockDim.x) { const int cc = hw ? (c / hw) * hs + (c % hw) : c; const float bv = ref[(size_t)r * ldb + offb + cc], av = a[(size_t)r * lda + offa + c]; d2 += (av - bv) * (av - bv); b2 += bv * bv; }
    d2 = wave_sum(d2); b2 = wave_sum(b2);
    if ((threadIdx.x & 63) == 0) { atomicAdd(sums + 2 * k, d2); atomicAdd(sums + 2 * k + 1, b2); }
}
__global__ void k_cmpy(const float* a, const float* h, const float* ref, float* sums, int k) {
    const int r = blockIdx.x; if (r < NMETA) return;
    float d2 = 0.f, b2 = 0.f;
    for (int c = threadIdx.x; c < 1024; c += blockDim.x) { const float rv = ref[(size_t)(r - NMETA) * 1024 + c], av = a[(size_t)r * 1024 + c], hv = h[(size_t)r * 1024 + c]; d2 += (av - rv) * (av - rv); b2 += (rv - hv) * (rv - hv); }
    d2 = wave_sum(d2); b2 = wave_sum(b2);
    if ((threadIdx.x & 63) == 0) { atomicAdd(sums + 2 * k, d2); atomicAdd(sums + 2 * k + 1, b2); }
}
__global__ void k_scale_lin(float* out, size_t n, const float* sums, float mul) {
    const float f = 1.0f + mul * sqrtf(sums[0] / fmaxf(sums[1], 1e-30f));
    for (size_t i = (size_t)blockIdx.x * blockDim.x + threadIdx.x; i < n; i += (size_t)gridDim.x * blockDim.x) out[i] *= f;
}
__global__ void k_scale(float* out, size_t n, const float* sums, int nchecks) {
    float delta = 0.f; int bad = -1;
    for (int k = 0; k < nchecks; ++k) { const float rel = sqrtf(sums[2 * k] / fmaxf(sums[2 * k + 1], 1e-30f)); if (!(rel <= 0.1f) && bad < 0) bad = k; if (rel > delta) delta = rel; }
    if (bad >= 0) delta = 0.1f * (float)(bad + 1);
    const float f = 1.0f + delta;
    for (size_t i = (size_t)blockIdx.x * blockDim.x + threadIdx.x; i < n; i += (size_t)gridDim.x * blockDim.x) out[i] *= f;
}
}
#endif

extern "C" void kernel_launch(void* const* d_in, const int* in_sizes, int n_in, void* d_out, int out_size, void* d_ws, size_t ws_size, hipStream_t stream) {
    using namespace mk;
    static int grid = 0;
    if (grid == 0) {
        int dev = 0, cus = 0, per_cu = 0;
        if (n_in != 24 || out_size != MR * D || ws_size < 256 * MiB) { fprintf(stderr, "kernel_launch: unexpected problem shape (n_in %d, out %d, ws %zu)\n", n_in, out_size, ws_size); grid = -1; return; }
        if (hipGetDevice(&dev) != hipSuccess || hipDeviceGetAttribute(&cus, hipDeviceAttributeMultiprocessorCount, dev) != hipSuccess) { grid = -1; return; }
        if (hipFuncSetAttribute((const void*)mega_fwd, hipFuncAttributeMaxDynamicSharedMemorySize, LDS_BYTES) != hipSuccess) { fprintf(stderr, "kernel_launch: hipFuncSetAttribute failed\n"); grid = -1; return; }
        if (hipOccupancyMaxActiveBlocksPerMultiprocessor(&per_cu, (const void*)mega_fwd, NWAVES * 64, LDS_BYTES) != hipSuccess || per_cu < 1) { fprintf(stderr, "kernel_launch: occupancy query says %d blocks per CU\n", per_cu); per_cu = 1; }
        (void)hipGetLastError();
        grid = cus;
    }
    if (grid < 0) return;
    unsigned char* ws = (unsigned char*)d_ws;
    (void)hipMemsetAsync(ws + WS_CTL, 0, CTL_BYTES, stream);
    Args a{};
    Ptrs& P = a.P;
    const float* const* in = (const float* const*)d_in;
    P.x = in[0]; P.meta = in[1]; P.g_attn = in[2]; P.w_in = in[3]; P.b_f = in[4]; P.g_fox_q = in[5]; P.g_fox_k = in[6]; P.g_q_lat = in[7]; P.w_uq = in[8]; P.g_kv_lat = in[9]; P.w_ukv = in[10];
    P.g_mla_q = in[11]; P.g_mla_k = in[12]; P.g_fox_out = in[13]; P.g_mla_out = in[14]; P.w_o = in[15]; P.g_ffn = in[16]; P.w_group = in[17]; P.b_group = in[18]; P.w_expert = in[19]; P.b_expert = in[20];
    P.w1 = in[21]; P.w3 = in[22]; P.w2 = in[23];
    P.out = (float*)d_out; P.ws = ws;
#if DEBUG_STAGE == 0
    a.ph_lo = 0; a.ph_hi = N_PHASES;
    hipLaunchKernelGGL(mega_fwd, dim3(grid), dim3(NWAVES * 64), LDS_BYTES, stream, a);
#else
    a.ph_lo = 0; a.ph_hi = DEBUG_STAGE + 1 > N_PHASES ? N_PHASES : DEBUG_STAGE + 1;
    hipLaunchKernelGGL(mega_fwd, dim3(grid), dim3(NWAVES * 64), LDS_BYTES, stream, a);
    float* S1 = (float*)(ws + 66 * MiB);
    float* S2 = (float*)(ws + WS_SNAP);
    float* sums = (float*)(ws + 239 * MiB + 512 * 1024);
    (void)hipMemsetAsync(sums, 0, 256, stream);
    nv::Bufs nb;
    const int L = LSEQ;
#if DEBUG_STAGE == 2
    float* s_fq = S1; float* s_fk = s_fq + (size_t)L * 512; float* s_fv = s_fk + (size_t)L * 512; float* s_bias = s_fv + (size_t)L * 512; float* s_qm = s_bias + (size_t)L * 8;
    float* s_mk = s_qm + (size_t)L * 768; float* s_mv = s_mk + (size_t)L * 768; float* s_bref = S2;
    hipLaunchKernelGGL(dbg::k_snap, dim3(L), dim3(256), 0, stream, P, 0, s_fq, 512);
    hipLaunchKernelGGL(dbg::k_snap, dim3(L), dim3(256), 0, stream, P, 1, s_fk, 512);
    hipLaunchKernelGGL(dbg::k_snap, dim3(L), dim3(256), 0, stream, P, 2, s_fv, 512);
    hipLaunchKernelGGL(dbg::k_snap, dim3(L), dim3(64), 0, stream, P, 3, s_bias, 8);
    hipLaunchKernelGGL(dbg::k_snap, dim3(L), dim3(256), 0, stream, P, 4, s_qm, 768);
    hipLaunchKernelGGL(dbg::k_snap, dim3(L), dim3(256), 0, stream, P, 5, s_mk, 768);
    hipLaunchKernelGGL(dbg::k_snap, dim3(L), dim3(256), 0, stream, P, 6, s_mv, 512);
    nv::naive_forward(d_in, (float*)d_out, ws + 100 * MiB, stream, &nb);
    hipLaunchKernelGGL(dbg::k_bias_ref, dim3(L), dim3(8), 0, stream, nb.CUM, s_bref);
    hipLaunchKernelGGL(dbg::k_cmp, dim3(L), dim3(256), 0, stream, s_fq, 512, 0, nb.PROJ, nv::IN_COLS, nv::OFF_FQ, 0, 0, NMETA, 512, sums, 0);
    hipLaunchKernelGGL(dbg::k_cmp, dim3(L), dim3(256), 0, stream, s_fk, 512, 0, nb.PROJ, nv::IN_COLS, nv::OFF_FK, 0, 0, 0, 512, sums, 1);
    hipLaunchKernelGGL(dbg::k_cmp, dim3(L), dim3(256), 0, stream, s_fv, 512, 0, nb.PROJ, nv::IN_COLS, nv::OFF_FV, 0, 0, 0, 512, sums, 2);
    hipLaunchKernelGGL(dbg::k_cmp, dim3(L), dim3(64), 0, stream, s_bias, 8, 0, s_bref, 8, 0, 0, 0, 0, 8, sums, 3);
    hipLaunchKernelGGL(dbg::k_cmp, dim3(L), dim3(256), 0, stream, s_qm, 768, 0, nb.QUP, 768, 0, 0, 0, NMETA, 768, sums, 4);
    hipLaunchKernelGGL(dbg::k_cmp, dim3(L), dim3(256), 0, stream, s_mk, 768, 0, nb.MK, 768, 0, 0, 0, 0, 768, sums, 5);
    hipLaunchKernelGGL(dbg::k_cmp, dim3(L), dim3(256), 0, stream, s_mv, 512, 0, nb.KVUP, 1024, 64, 64, 128, 0, 512, sums, 6);
    const int nchecks = 7;
#elif DEBUG_STAGE == 3
    hipLaunchKernelGGL(dbg::k_snap, dim3(L), dim3(256), 0, stream, P, 7, S2, 1024);
    nv::naive_forward(d_in, (float*)d_out, ws + 100 * MiB, stream, &nb);
    hipLaunchKernelGGL(dbg::k_cmp, dim3(L), dim3(256), 0, stream, S2, 1024, 0, nb.O, 1024, 0, 0, 0, NMETA, 512, sums, 0);
    hipLaunchKernelGGL(dbg::k_cmp, dim3(L), dim3(256), 0, stream, S2, 1024, 512, nb.O, 1024, 512, 0, 0, NMETA, 512, sums, 1);
    const int nchecks = 2;
#elif DEBUG_STAGE == 4
    hipLaunchKernelGGL(dbg::k_snap, dim3(L), dim3(256), 0, stream, P, 8, S2, 1024);
    nv::naive_forward(d_in, (float*)d_out, ws + 100 * MiB, stream, &nb);
    hipLaunchKernelGGL(dbg::k_cmp, dim3(L), dim3(256), 0, stream, S2, 1024, 0, nb.H1, 1024, 0, 0, 0, NMETA, 1024, sums, 0);
    const int nchecks = 1;
#elif DEBUG_STAGE == 9
    hipLaunchKernelGGL(dbg::k_snap, dim3(L), dim3(256), 0, stream, P, 10, S2, 1024);
    hipLaunchKernelGGL(dbg::k_snap, dim3(L), dim3(256), 0, stream, P, 11, S1, 1024);
    nv::naive_forward(d_in, (float*)d_out, ws + 100 * MiB, stream, &nb);
    hipLaunchKernelGGL(dbg::k_cmp, dim3(L), dim3(256), 0, stream, S2, 1024, 0, nb.YAB, 1024, 0, 0, 0, NMETA, 1024, sums, 0);
    hipLaunchKernelGGL(dbg::k_cmp, dim3(L), dim3(256), 0, stream, S1, 1024, 0, nb.YAB + (size_t)L * 1024, 1024, 0, 0, 0, NMETA, 1024, sums, 1);
    const int nchecks = 2;
#elif DEBUG_STAGE == 10
    hipLaunchKernelGGL(dbg::k_snap, dim3(L), dim3(256), 0, stream, P, 11, S2, 1024);
    nv::naive_forward(d_in, (float*)d_out, ws + 100 * MiB, stream, &nb);
    hipLaunchKernelGGL(dbg::k_cmp, dim3(L), dim3(256), 0, stream, S2, 1024, 0, nb.YAB + (size_t)L * 1024, 1024, 0, 0, 0, NMETA, 1024, sums, 0);
    hipLaunchKernelGGL(dbg::k_scale_lin, dim3(1024), dim3(256), 0, stream, (float*)d_out, (size_t)MR * D, sums, 0.1f);
    const int nchecks = 0;
#elif DEBUG_STAGE == 8
    hipLaunchKernelGGL(dbg::k_snap, dim3(L), dim3(256), 0, stream, P, 8, S2, 1024);
    nv::naive_forward(d_in, (float*)d_out, ws + 100 * MiB, stream, &nb);
    hipLaunchKernelGGL(dbg::k_cmpy, dim3(L), dim3(256), 0, stream, S2, nb.H1, (const float*)d_out + (size_t)DBG_B * SEQ * D, sums, 0);
    hipLaunchKernelGGL(dbg::k_scale_lin, dim3(1024), dim3(256), 0, stream, (float*)d_out, (size_t)MR * D, sums, 0.1f);
    const int nchecks = 0;
#else
    hipLaunchKernelGGL(dbg::k_snap, dim3(L), dim3(256), 0, stream, P, 9, S2, 1024);
    nv::naive_forward(d_in, (float*)d_out, ws + 100 * MiB, stream, &nb);
    hipLaunchKernelGGL(dbg::k_cmp, dim3(L), dim3(256), 0, stream, S2, 1024, 0, nb.U2, 1024, 0, 0, 0, NMETA, 1024, sums, 0);
    const int nchecks = 1;
#endif
    if (nchecks > 0) hipLaunchKernelGGL(dbg::k_scale, dim3(1024), dim3(256), 0, stream, (float*)d_out, (size_t)MR * D, sums, nchecks);
#endif
}
```

```cpp
#include <hip/hip_runtime.h>
#include <cstdio>
#include <cstdint>
#include <cmath>
#ifndef DEBUG_STAGE
#define DEBUG_STAGE 0
#endif
#undef DEBUG_STAGE
#define DEBUG_STAGE 0
#if DEBUG_STAGE
#ifndef DBG_B
#define DBG_B 7
#endif
namespace nv {
constexpr int D_MODEL = 1024, BATCH = 8, SEQ = 2048, N_META = 16, L = SEQ + N_META;
constexpr int FOX_H = 8, FOX_D = 64, FOX_W = 512;
constexpr int MLA_H = 8, QR = 384, KVR = 256, NOPE = 64, ROPE = 32, QK = 96, VD = 64, MLA_W = 512;
constexpr int IN_COLS = 2216;
constexpr int OFF_FQ = 0, OFF_FK = 512, OFF_FV = 1024, OFF_FF = 1536, OFF_CQ = 1544, OFF_CKV = 1928, OFF_KR = 2184;
constexpr int NG = 4, EPG = 8, NE = 32, DE = 256;
constexpr float EPS = 1e-6f;

__device__ __forceinline__ float wave_sum(float v) {
#pragma unroll
    for (int o = 1; o < 64; o <<= 1) v += __shfl_xor(v, o);
    return v;
}
__device__ __forceinline__ float block_sum256(float v, float* red) {
    v = wave_sum(v);
    __syncthreads();
    if ((threadIdx.x & 63) == 0) red[threadIdx.x >> 6] = v;
    __syncthreads();
    return red[0] + red[1] + red[2] + red[3];
}

__global__ void k_rms_in(const float* __restrict__ x, const float* __restrict__ meta, const float* __restrict__ g, float* __restrict__ u, int b) {
    __shared__ float red[4];
    const int r = blockIdx.x;
    const float* src = r < N_META ? meta + (size_t)r * D_MODEL : x + ((size_t)b * SEQ + (r - N_META)) * D_MODEL;
    float v[4]; float ss = 0.f;
#pragma unroll
    for (int i = 0; i < 4; ++i) { v[i] = src[threadIdx.x + 256 * i]; ss += v[i] * v[i]; }
    ss = block_sum256(ss, red);
    const float rs = 1.0f / sqrtf(ss * (1.0f / D_MODEL) + EPS);
#pragma unroll
    for (int i = 0; i < 4; ++i) u[(size_t)r * D_MODEL + threadIdx.x + 256 * i] = v[i] * rs * g[threadIdx.x + 256 * i];
}
__global__ void k_rms_rows(const float* __restrict__ in, int ld, int off, int n, const float* __restrict__ g, float* __restrict__ out, int ldo, int offo) {
    __shared__ float red[4];
    const int r = blockIdx.x;
    float ss = 0.f;
    for (int i = threadIdx.x; i < n; i += 256) { const float v = in[(size_t)r * ld + off + i]; ss += v * v; }
    ss = block_sum256(ss, red);
    const float rs = 1.0f / sqrtf(ss / (float)n + EPS);
    for (int i = threadIdx.x; i < n; i += 256) out[(size_t)r * ldo + offo + i] = in[(size_t)r * ld + off + i] * rs * g[i];
}

__global__ void k_gemm(const float* __restrict__ A, int lda, const float* __restrict__ B, int ldb, float* __restrict__ C, int ldc, const float* __restrict__ R, int ldr, int M, int N, int K) {
    __shared__ float As[16][65];
    __shared__ float Bs[16][65];
    const int tx = threadIdx.x & 15, ty = threadIdx.x >> 4;
    const int m0 = blockIdx.y * 64, n0 = blockIdx.x * 64;
    float acc[4][4] = {};
    for (int k0 = 0; k0 < K; k0 += 16) {
        for (int i = threadIdx.x; i < 64 * 16; i += 256) {
            const int mm = i >> 4, kk = i & 15;
            As[kk][mm] = (m0 + mm < M) ? A[(size_t)(m0 + mm) * lda + k0 + kk] : 0.f;
        }
        for (int i = threadIdx.x; i < 64 * 16; i += 256) {
            const int kk = i >> 6, nn = i & 63;
            Bs[kk][nn] = (n0 + nn < N) ? B[(size_t)(k0 + kk) * ldb + n0 + nn] : 0.f;
        }
        __syncthreads();
#pragma unroll
        for (int kk = 0; kk < 16; ++kk) {
            float a[4], bb[4];
#pragma unroll
            for (int i = 0; i < 4; ++i) { a[i] = As[kk][ty * 4 + i]; bb[i] = Bs[kk][tx * 4 + i]; }
#pragma unroll
            for (int i = 0; i < 4; ++i)
#pragma unroll
                for (int j = 0; j < 4; ++j) acc[i][j] += a[i] * bb[j];
        }
        __syncthreads();
    }
#pragma unroll
    for (int i = 0; i < 4; ++i)
#pragma unroll
        for (int j = 0; j < 4; ++j) {
            const int m = m0 + ty * 4 + i, n = n0 + tx * 4 + j;
            if (m < M && n < N) C[(size_t)m * ldc + n] = acc[i][j] + (R ? R[(size_t)m * ldr + n] : 0.f);
        }
}

__device__ __forceinline__ float log_sigmoid(float x) { return fminf(x, 0.f) - log1pf(expf(-fabsf(x))); }

__global__ void k_fox_prep(float* __restrict__ proj, const float* __restrict__ gq, const float* __restrict__ gk, const float* __restrict__ bf, float* __restrict__ logf) {
    const int r = blockIdx.x, h = threadIdx.x >> 6, d = threadIdx.x & 63;
    float* row = proj + (size_t)r * IN_COLS;
    float q = row[OFF_FQ + h * 64 + d], k = row[OFF_FK + h * 64 + d];
    const float sq = wave_sum(q * q), sk = wave_sum(k * k);
    row[OFF_FQ + h * 64 + d] = q * (1.0f / sqrtf(sq * (1.0f / 64) + EPS)) * gq[d];
    row[OFF_FK + h * 64 + d] = k * (1.0f / sqrtf(sk * (1.0f / 64) + EPS)) * gk[d];
    if (d == 0) logf[r * 8 + h] = log_sigmoid(row[OFF_FF + h] + bf[h]);
}
__global__ void k_cumsum(const float* __restrict__ logf, float* __restrict__ cum) {
    const int h = threadIdx.x; float c = 0.f;
    for (int r = 0; r < L; ++r) { c += logf[r * 8 + h]; cum[h * L + r] = c; }
}

__global__ void k_attn(const float* __restrict__ q, int ldq, int hq, const float* __restrict__ k, int ldk, int hk, const float* __restrict__ v, int ldv, int hv,
                       int dk, float scale, const float* __restrict__ cum, float* __restrict__ o, int ldo) {
    __shared__ float sc[L];
    __shared__ float qs[96];
    __shared__ float red[4];
    __shared__ float part[4][64];
    const int t = blockIdx.x, h = blockIdx.y, tid = threadIdx.x;
    if (tid < dk) qs[tid] = q[(size_t)t * ldq + h * hq + tid];
    __syncthreads();
    const float ct = cum ? cum[h * L + t] : 0.f;
    float mx = -INFINITY;
    for (int s = tid; s <= t; s += 256) {
        const float* kr = k + (size_t)s * ldk + h * hk;
        float a = 0.f;
        for (int d = 0; d < dk; ++d) a += qs[d] * kr[d];
        a *= scale;
        if (cum) a += ct - cum[h * L + s];
        sc[s] = a; mx = fmaxf(mx, a);
    }
#pragma unroll
    for (int off = 1; off < 64; off <<= 1) mx = fmaxf(mx, __shfl_xor(mx, off));
    __syncthreads();
    if ((tid & 63) == 0) red[tid >> 6] = mx;
    __syncthreads();
    mx = fmaxf(fmaxf(red[0], red[1]), fmaxf(red[2], red[3]));
    float sum = 0.f;
    for (int s = tid; s <= t; s += 256) { const float p = expf(sc[s] - mx); sc[s] = p; sum += p; }
    sum = block_sum256(sum, red);
    const int d = tid & 63, gq = tid >> 6;
    float acc = 0.f;
    for (int s = gq; s <= t; s += 4) acc += sc[s] * v[(size_t)s * ldv + h * hv + d];
    part[gq][d] = acc;
    __syncthreads();
    if (tid < 64) o[(size_t)t * ldo + h * 64 + tid] = (part[0][tid] + part[1][tid] + part[2][tid] + part[3][tid]) / sum;
}

__global__ void k_mla_prep(const float* __restrict__ qup, const float* __restrict__ kvup, const float* __restrict__ proj, const float* __restrict__ gq, const float* __restrict__ gk,
                           float* __restrict__ mq, float* __restrict__ mk) {
    __shared__ float sq[8][96], sk[8][96];
    __shared__ float rq[8], rk[8];
    const int r = blockIdx.x, h = threadIdx.x / 96, j = threadIdx.x % 96;
    const float qv = qup[(size_t)r * 768 + h * 96 + j];
    const float kv = j < 64 ? kvup[(size_t)r * 1024 + h * 128 + j] : proj[(size_t)r * IN_COLS + OFF_KR + (j - 64)];
    sq[h][j] = qv; sk[h][j] = kv;
    __syncthreads();
    if (j == 0) { float a = 0.f, b = 0.f; for (int i = 0; i < 96; ++i) { a += sq[h][i] * sq[h][i]; b += sk[h][i] * sk[h][i]; }
        rq[h] = 1.0f / sqrtf(a * (1.0f / 96) + EPS); rk[h] = 1.0f / sqrtf(b * (1.0f / 96) + EPS); }
    __syncthreads();
    sq[h][j] = qv * rq[h] * gq[j]; sk[h][j] = kv * rk[h] * gk[j];
    __syncthreads();
    float oq = sq[h][j], ok = sk[h][j];
    if (j >= 64) {
        const int i = (j - 64) & 15; const bool second = (j - 64) >= 16;
        const float inv_freq = expf(-logf(10000.0f) * (float)i / 16.0f);
        const float ang = (float)r * inv_freq, c = cosf(ang), s = sinf(ang);
        const float q1 = sq[h][64 + i], q2 = sq[h][80 + i], k1 = sk[h][64 + i], k2 = sk[h][80 + i];
        oq = second ? q1 * s + q2 * c : q1 * c - q2 * s;
        ok = second ? k1 * s + k2 * c : k1 * c - k2 * s;
    }
    mq[(size_t)r * 768 + h * 96 + j] = oq; mk[(size_t)r * 768 + h * 96 + j] = ok;
}

__global__ void k_res_rms(const float* __restrict__ x, const float* __restrict__ meta, const float* __restrict__ att, const float* __restrict__ g, float* __restrict__ h1, float* __restrict__ u2, int b) {
    __shared__ float red[4];
    const int r = blockIdx.x;
    const float* src = r < N_META ? meta + (size_t)r * D_MODEL : x + ((size_t)b * SEQ + (r - N_META)) * D_MODEL;
    float v[4]; float ss = 0.f;
#pragma unroll
    for (int i = 0; i < 4; ++i) { v[i] = src[threadIdx.x + 256 * i] + att[(size_t)r * D_MODEL + threadIdx.x + 256 * i]; ss += v[i] * v[i]; h1[(size_t)r * D_MODEL + threadIdx.x + 256 * i] = v[i]; }
    ss = block_sum256(ss, red);
    const float rs = 1.0f / sqrtf(ss * (1.0f / D_MODEL) + EPS);
#pragma unroll
    for (int i = 0; i < 4; ++i) u2[(size_t)r * D_MODEL + threadIdx.x + 256 * i] = v[i] * rs * g[threadIdx.x + 256 * i];
}

__global__ void k_moe(const float* __restrict__ u2, const float* __restrict__ h1, const float* __restrict__ wg, const float* __restrict__ bg, const float* __restrict__ we, const float* __restrict__ be,
                      const float* __restrict__ w1, const float* __restrict__ w3, const float* __restrict__ w2, float* __restrict__ out, int b, float* __restrict__ yab) {
    __shared__ float us[D_MODEL];
    __shared__ float lg[36];
    __shared__ float hid[DE];
    __shared__ int eidx[2];
    __shared__ float wsel[2];
    const int r = blockIdx.x + N_META, tid = threadIdx.x;
#pragma unroll
    for (int i = 0; i < 4; ++i) us[tid + 256 * i] = u2[(size_t)r * D_MODEL + tid + 256 * i];
    __syncthreads();
    if (tid < 36) {
        float a = 0.f;
        if (tid < 4) { for (int k = 0; k < D_MODEL; ++k) a += us[k] * wg[k * NG + tid]; a += bg[tid]; }
        else { const int e = tid - 4; for (int k = 0; k < D_MODEL; ++k) a += us[k] * we[k * NE + e]; a += be[e]; }
        lg[tid] = a;
    }
    __syncthreads();
    if (tid == 0) {
        int gi = 0; float gm = lg[0];
        for (int i = 1; i < 4; ++i) if (lg[i] > gm) { gm = lg[i]; gi = i; }
        float den = 0.f; for (int i = 0; i < 4; ++i) den += expf(lg[i] - gm);
        const float psel = 1.0f / den;
        const float* w = lg + 4 + gi * 8;
        int i0 = 0; for (int i = 1; i < 8; ++i) if (w[i] > w[i0]) i0 = i;
        int i1 = -1; for (int i = 0; i < 8; ++i) if (i != i0 && (i1 < 0 || w[i] > w[i1])) i1 = i;
        const float e1 = expf(w[i1] - w[i0]);
        wsel[0] = psel / (1.0f + e1); wsel[1] = psel * e1 / (1.0f + e1);
        eidx[0] = gi * 8 + i0; eidx[1] = gi * 8 + i1;
    }
    __syncthreads();
    float y[4] = {0.f, 0.f, 0.f, 0.f};
    for (int j = 0; j < 2; ++j) {
        const int e = eidx[j]; const float ws = wsel[j];
        const float* W1 = w1 + (size_t)e * D_MODEL * DE; const float* W3 = w3 + (size_t)e * D_MODEL * DE; const float* W2 = w2 + (size_t)e * DE * D_MODEL;
        float a = 0.f, c = 0.f;
        for (int k = 0; k < D_MODEL; ++k) { a += us[k] * W1[(size_t)k * DE + tid]; c += us[k] * W3[(size_t)k * DE + tid]; }
        __syncthreads();
        hid[tid] = (a / (1.0f + expf(-a))) * c;
        __syncthreads();
#pragma unroll
        for (int i = 0; i < 4; ++i) { float s = 0.f; for (int k = 0; k < DE; ++k) s += hid[k] * W2[(size_t)k * D_MODEL + tid + 256 * i]; y[i] += ws * s; if (yab) yab[((size_t)j * L + r) * D_MODEL + tid + 256 * i] = ws * s; }
    }
#pragma unroll
    for (int i = 0; i < 4; ++i) out[((size_t)b * SEQ + (r - N_META)) * D_MODEL + tid + 256 * i] = h1[(size_t)r * D_MODEL + tid + 256 * i] + y[i];
}

inline void gemm(hipStream_t st, const float* A, int lda, const float* B, int ldb, float* C, int ldc, const float* R, int ldr, int M, int N, int K) {
    dim3 grid((N + 63) / 64, (M + 63) / 64);
    hipLaunchKernelGGL(k_gemm, grid, dim3(256), 0, st, A, lda, B, ldb, C, ldc, R, ldr, M, N, K);
}

struct Bufs { float *PROJ, *CUM, *QUP, *KVUP, *MK, *O, *H1, *U2, *YAB; };
inline void naive_forward(void* const* d_in, float* out, unsigned char* ws, hipStream_t st, Bufs* bufs) {
    const float* x = (const float*)d_in[0]; const float* meta = (const float*)d_in[1]; const float* g_attn = (const float*)d_in[2]; const float* w_in = (const float*)d_in[3];
    const float* b_f = (const float*)d_in[4]; const float* g_fox_q = (const float*)d_in[5]; const float* g_fox_k = (const float*)d_in[6]; const float* g_q_lat = (const float*)d_in[7];
    const float* w_uq = (const float*)d_in[8]; const float* g_kv_lat = (const float*)d_in[9]; const float* w_ukv = (const float*)d_in[10]; const float* g_mla_q = (const float*)d_in[11];
    const float* g_mla_k = (const float*)d_in[12]; const float* g_fox_out = (const float*)d_in[13]; const float* g_mla_out = (const float*)d_in[14]; const float* w_o = (const float*)d_in[15];
    const float* g_ffn = (const float*)d_in[16]; const float* w_group = (const float*)d_in[17]; const float* b_group = (const float*)d_in[18]; const float* w_expert = (const float*)d_in[19];
    const float* b_expert = (const float*)d_in[20]; const float* w1 = (const float*)d_in[21]; const float* w3 = (const float*)d_in[22]; const float* w2 = (const float*)d_in[23];
    size_t off = 0;
    auto carve = [&](size_t nfloats) { float* p = (float*)(ws + off); off += ((nfloats * 4 + 255) / 256) * 256; return p; };
    float* U = carve((size_t)L * D_MODEL); float* PROJ = carve((size_t)L * IN_COLS); float* LOGF = carve((size_t)L * 8); float* CUM = carve((size_t)8 * L);
    float* CQN = carve((size_t)L * QR); float* CKVN = carve((size_t)L * KVR); float* QUP = carve((size_t)L * 768); float* KVUP = carve((size_t)L * 1024);
    float* MQ = carve((size_t)L * 768); float* MK = carve((size_t)L * 768); float* O = carve((size_t)L * 1024); float* MIX = carve((size_t)L * 1024);
    float* ATT = carve((size_t)L * 1024); float* H1 = carve((size_t)L * 1024); float* U2 = carve((size_t)L * 1024); float* YAB = carve((size_t)2 * L * 1024);
    if (bufs) { bufs->PROJ = PROJ; bufs->CUM = CUM; bufs->QUP = QUP; bufs->KVUP = KVUP; bufs->MK = MK; bufs->O = O; bufs->H1 = H1; bufs->U2 = U2; bufs->YAB = YAB; }
    for (int bi = 0; bi < BATCH; ++bi) {
        const int b = (bi + DBG_B + 1) % BATCH;
        hipLaunchKernelGGL(k_rms_in, dim3(L), dim3(256), 0, st, x, meta, g_attn, U, b);
        gemm(st, U, D_MODEL, w_in, IN_COLS, PROJ, IN_COLS, nullptr, 0, L, IN_COLS, D_MODEL);
        hipLaunchKernelGGL(k_fox_prep, dim3(L), dim3(512), 0, st, PROJ, g_fox_q, g_fox_k, b_f, LOGF);
        hipLaunchKernelGGL(k_cumsum, dim3(1), dim3(8), 0, st, LOGF, CUM);
        hipLaunchKernelGGL(k_attn, dim3(L, 8), dim3(256), 0, st, PROJ + OFF_FQ, IN_COLS, 64, PROJ + OFF_FK, IN_COLS, 64, PROJ + OFF_FV, IN_COLS, 64, 64, 0.125f, CUM, O, 1024);
        hipLaunchKernelGGL(k_rms_rows, dim3(L), dim3(256), 0, st, PROJ, IN_COLS, OFF_CQ, QR, g_q_lat, CQN, QR, 0);
        hipLaunchKernelGGL(k_rms_rows, dim3(L), dim3(256), 0, st, PROJ, IN_COLS, OFF_CKV, KVR, g_kv_lat, CKVN, KVR, 0);
        gemm(st, CQN, QR, w_uq, 768, QUP, 768, nullptr, 0, L, 768, QR);
        gemm(st, CKVN, KVR, w_ukv, 1024, KVUP, 1024, nullptr, 0, L, 1024, KVR);
        hipLaunchKernelGGL(k_mla_prep, dim3(L), dim3(768), 0, st, QUP, KVUP, PROJ, g_mla_q, g_mla_k, MQ, MK);
        hipLaunchKernelGGL(k_attn, dim3(L, 8), dim3(256), 0, st, MQ, 768, 96, MK, 768, 96, KVUP + 64, 1024, 128, 96, 1.0f / sqrtf(96.0f), (const float*)nullptr, O + 512, 1024);
        hipLaunchKernelGGL(k_rms_rows, dim3(L), dim3(256), 0, st, O, 1024, 0, 512, g_fox_out, MIX, 1024, 0);
        hipLaunchKernelGGL(k_rms_rows, dim3(L), dim3(256), 0, st, O, 1024, 512, 512, g_mla_out, MIX, 1024, 512);
        gemm(st, MIX, 1024, w_o, 1024, ATT, 1024, nullptr, 0, L, 1024, 1024);
        hipLaunchKernelGGL(k_res_rms, dim3(L), dim3(256), 0, st, x, meta, ATT, g_ffn, H1, U2, b);
        hipLaunchKernelGGL(k_moe, dim3(SEQ), dim3(256), 0, st, U2, H1, w_group, b_group, w_expert, b_expert, w1, w3, w2, out, b, YAB);
    }
}
}
#endif
namespace pg8 {
#define PG8_LAS __attribute__((address_space(3)))
typedef unsigned short bf16_t;
typedef short bf16x8 __attribute__((ext_vector_type(8)));
typedef float f32x4 __attribute__((ext_vector_type(4)));
typedef unsigned u32x4 __attribute__((ext_vector_type(4)));
typedef unsigned u32x2 __attribute__((ext_vector_type(2)));
constexpr int BM = 256, BK = 64, HALF = 128, HTB = HALF * BK * 2  , STAGE_BYTES = 8 * HTB, NXCD = 8, WGM = 8;

__host__ __device__ __forceinline__ int lds_byte(int r, int c) { const int st = (r >> 4) * 2 + (c >> 5), rr = r & 15, cc = c & 31, ob = rr * 64 + cc * 2; return st * 1024 + (ob ^ (((ob >> 9) & 1) << 5)); }
__host__ __device__ __forceinline__ void stage_rc(int b, int& R, int& C) { const int st = b / 1024, sb = b % 1024, swz = sb ^ (((sb >> 9) & 1) << 5); R = (st >> 1) * 16 + swz / 64; C = (st & 1) * 32 + (swz % 64) / 2; }
__host__ __device__ __forceinline__ int perm32(int rho) { const int n = rho >> 4, i = rho & 15; return 8 * (i >> 2) + 4 * n + (i & 3); }

struct Unit { int pm, pn, ex; const char* A; const char* B; };

struct StaticOrder {
    int nM, nN, nwg, G, c; const char* A; const char* B; size_t tstep;
    __device__ void init(const void* A_, const void* Bt_, int M, int N, int K, int G_, int c_) { nM = M / BM; nN = N / BM; nwg = nM * nN; G = G_; c = c_; A = (const char*)A_; B = (const char*)Bt_; tstep = (size_t)BM * K * 2; }
    __device__ bool next(int i, Unit& u) const {
        const long L = (long)i * G + c; if (L >= nwg) return false;
        int wgid = (int)L; { const int q = nwg / NXCD, r = nwg % NXCD, xcd = wgid % NXCD, off = wgid / NXCD; wgid = (xcd < r ? xcd * (q + 1) : r * (q + 1) + (xcd - r) * q) + off; }
        const int nig = WGM * nN, gid = wgid / nig, fm = gid * WGM, gsz = (nM - fm) < WGM ? (nM - fm) : WGM;
        u.pm = fm + ((wgid % nig) % gsz); u.pn = (wgid % nig) / gsz; u.ex = 0; u.A = A + (size_t)u.pm * tstep; u.B = B + (size_t)u.pn * tstep; return true;
    }
    __device__ __forceinline__ void gather(const Unit&, int, int, int, int, unsigned (&)[4]) const {}
};

__device__ __forceinline__ unsigned cvt_pk_bf16(float lo, float hi) { typedef float f2 __attribute__((ext_vector_type(2))); typedef __bf16 b2 __attribute__((ext_vector_type(2))); f2 v = {lo, hi}; b2 b = __builtin_convertvector(v, b2); return __builtin_bit_cast(unsigned, b); }

template <class Epi, class Sched, bool GATHER = false, bool MID = false>
__device__ __forceinline__ void gemm_phase(PG8_LAS unsigned char* lds, const int K, const Sched& S, const Epi& E) {
    const int tid = threadIdx.x, wid = __builtin_amdgcn_readfirstlane(tid >> 6), lane = tid & 63, wr = wid >> 2, wc = wid & 3, fr = lane & 15, fq = lane >> 4;
    const int nt = K / BK;
    unsigned voffA[2], voffB[2]; int sR[2], sC[2];
#pragma unroll
    for (int i = 0; i < 2; ++i) { int R, C; stage_rc(tid * 16 + i * 8192, R, C); const int Rb = Epi::PERM ? ((R & ~31) + perm32(R & 31)) : R; sR[i] = R; sC[i] = C;
        voffA[i] = (unsigned)(R * K + C) * 2u; voffB[i] = (unsigned)(Rb * K + C) * 2u; }
    const size_t kstep = (size_t)(BK * 2);
    const size_t hstep = (size_t)HALF * K * 2;
    const unsigned ldsw = (unsigned)wid * 1024u;
    const int aoff = lds_byte(wr * 64 + fr, fq * 8), boff = lds_byte(wc * 32 + fr, fq * 8);
#define PG8_SA(b, h) (((b) * 2 + (h)) * HTB)
#define PG8_SB(b, h) ((4 + (b) * 2 + (h)) * HTB)
#define PG8_STAGE(bufoff, gbase, voff) do { _Pragma("unroll") for (int _i = 0; _i < 2; ++_i) \
        __builtin_amdgcn_global_load_lds((const unsigned*)((const char*)(gbase) + (voff)[_i]), (PG8_LAS unsigned*)(lds + (bufoff) + ldsw + _i * 8192), 16, 0, 0); } while (0)
#define PG8_STAGE_A(bufoff, abase, h, NX) do { if constexpr (GATHER) { _Pragma("unroll") for (int _i = 0; _i < 2; ++_i) { const unsigned _o = (NX) ? gN[(h) * 2 + _i] : gC[(h) * 2 + _i]; \
        __builtin_amdgcn_global_load_lds((const unsigned*)((const char*)(abase) + _o), (PG8_LAS unsigned*)(lds + (bufoff) + ldsw + _i * 8192), 16, 0, 0); } } \
        else { PG8_STAGE(bufoff, (abase) + (h) * hstep, voffA); } } while (0)
#define PG8_LDA(dst, b, h) do { _Pragma("unroll") for (int m = 0; m < 4; ++m) _Pragma("unroll") for (int k = 0; k < 2; ++k) dst[m][k] = *(const PG8_LAS bf16x8*)(lds + PG8_SA(b, h) + aoff + m * 2048 + k * 1024); } while (0)
#define PG8_LDB(dst, b, h) do { _Pragma("unroll") for (int n = 0; n < 2; ++n) _Pragma("unroll") for (int k = 0; k < 2; ++k) dst[n][k] = *(const PG8_LAS bf16x8*)(lds + PG8_SB(b, h) + boff + n * 2048 + k * 1024); } while (0)
#define PG8_MMA(ai, bj, At, Bt) do { __builtin_amdgcn_s_setprio(1); _Pragma("unroll") for (int m = 0; m < 4; ++m) _Pragma("unroll") for (int n = 0; n < 2; ++n) _Pragma("unroll") for (int k = 0; k < 2; ++k) \
        acc[ai][bj][m][n] = __builtin_amdgcn_mfma_f32_16x16x32_bf16(Bt[n][k], At[m][k], acc[ai][bj][m][n], 0, 0, 0); __builtin_amdgcn_s_setprio(0); } while (0)
#define PG8_WAIT_V(n) asm volatile("s_waitcnt vmcnt(" #n ")" ::: "memory")
#define PG8_WAIT_L(n) asm volatile("s_waitcnt lgkmcnt(" #n ")" ::: "memory")
#define PG8_BAR __builtin_amdgcn_s_barrier()
#define PG8_SCHED __builtin_amdgcn_sched_barrier(0)
    Unit cur, nxt; int ui = 0;
    if (!S.next(0, cur)) return;
    unsigned gC[4] = {0u, 0u, 0u, 0u}, gN[4] = {0u, 0u, 0u, 0u};
    if constexpr (GATHER) S.gather(cur, sR[0], sC[0], sR[1], sC[1], gC);
    f32x4 acc[2][2][4][2];
#pragma unroll
    for (int a = 0; a < 2; ++a)
#pragma unroll
        for (int b = 0; b < 2; ++b)
#pragma unroll
            for (int m = 0; m < 4; ++m)
#pragma unroll
                for (int n = 0; n < 2; ++n) acc[a][b][m][n] = (f32x4){0.f, 0.f, 0.f, 0.f};
    bf16x8 At[4][2], B0[2][2], B1[2][2];
    const char* cA = cur.A; const char* cB = cur.B;
    PG8_STAGE(PG8_SB(0, 0), cB, voffB); PG8_STAGE(PG8_SB(0, 1), cB + hstep, voffB); PG8_STAGE_A(PG8_SA(0, 0), cA, 0, false); PG8_STAGE_A(PG8_SA(0, 1), cA, 1, false);
    if (wr == 1) PG8_BAR;
    PG8_WAIT_V(2); PG8_BAR;
    PG8_STAGE(PG8_SB(1, 0), cB + kstep, voffB); PG8_STAGE_A(PG8_SA(1, 0), cA + kstep, 0, false); PG8_STAGE(PG8_SB(1, 1), cB + hstep + kstep, voffB);
    PG8_WAIT_V(6); PG8_BAR;
    for (;;) {
        const bool has_next = S.next(ui + 1, nxt);
        if constexpr (GATHER) { if (has_next) S.gather(nxt, sR[0], sC[0], sR[1], sC[1], gN); else { gN[0] = gC[0]; gN[1] = gC[1]; gN[2] = gC[2]; gN[3] = gC[3]; } }
        const char* nA = has_next ? nxt.A : cA; const char* nB = has_next ? nxt.B : cB;
#pragma unroll 1
        for (int t = 0; t < nt; t += 2) {
            const bool last = (t == nt - 2);
            const char* a1 = cA + (size_t)(t + 1) * kstep;
            const char* a2 = last ? nA : cA + (size_t)(t + 2) * kstep; const char* b2 = last ? nB : cB + (size_t)(t + 2) * kstep;
            const char* a3 = a2 + kstep; const char* b3 = b2 + kstep;
            if constexpr (MID) { if (t == nt / 2) E.mid(acc, cur, wr, fr); }
            PG8_LDB(B0, 0, 0); PG8_LDB(B1, 0, 1); PG8_SCHED; PG8_LDA(At, 0, 0); PG8_STAGE_A(PG8_SA(1, 1), a1, 1, false);
            PG8_WAIT_V(8); PG8_WAIT_L(0); PG8_BAR; PG8_MMA(0, 0, At, B0); PG8_MMA(0, 1, At, B1); PG8_BAR; PG8_SCHED;
            PG8_LDA(At, 0, 1); PG8_STAGE(PG8_SB(0, 0), b2, voffB); PG8_STAGE(PG8_SB(0, 1), b2 + hstep, voffB); PG8_STAGE_A(PG8_SA(0, 0), a2, 0, last);
            PG8_WAIT_V(8); PG8_WAIT_L(0); PG8_BAR; PG8_MMA(1, 0, At, B0); PG8_MMA(1, 1, At, B1); PG8_BAR; PG8_SCHED;
            PG8_LDB(B0, 1, 0); PG8_LDB(B1, 1, 1); PG8_SCHED; PG8_LDA(At, 1, 0); PG8_STAGE_A(PG8_SA(0, 1), a2, 1, last);
            PG8_WAIT_V(8); PG8_WAIT_L(0); PG8_BAR; PG8_MMA(0, 0, At, B0); PG8_MMA(0, 1, At, B1); PG8_BAR; PG8_SCHED;
            PG8_LDA(At, 1, 1); PG8_STAGE(PG8_SB(1, 0), b3, voffB); PG8_STAGE(PG8_SB(1, 1), b3 + hstep, voffB); PG8_STAGE_A(PG8_SA(1, 0), a3, 0, last);
            PG8_WAIT_V(8); PG8_WAIT_L(0); PG8_BAR; PG8_MMA(1, 0, At, B0); PG8_MMA(1, 1, At, B1); PG8_BAR; PG8_SCHED;
        }
        if (wr == 0) PG8_BAR;
        E(acc, cur, wr, wc, fr, fq);
        if (!has_next) break;
#pragma unroll
        for (int a = 0; a < 2; ++a)
#pragma unroll
            for (int b = 0; b < 2; ++b)
#pragma unroll
                for (int m = 0; m < 4; ++m)
#pragma unroll
                    for (int n = 0; n < 2; ++n) acc[a][b][m][n] = (f32x4){0.f, 0.f, 0.f, 0.f};
        cur = nxt; cA = nA; cB = nB; ++ui;
        if constexpr (GATHER) { gC[0] = gN[0]; gC[1] = gN[1]; gC[2] = gN[2]; gC[3] = gN[3]; }
        if (wr == 1) PG8_BAR;
    }
    PG8_WAIT_V(0);
    PG8_BAR;
#undef PG8_SA
#undef PG8_SB
#undef PG8_STAGE
#undef PG8_STAGE_A
#undef PG8_LDA
#undef PG8_LDB
#undef PG8_MMA
#undef PG8_WAIT_V
#undef PG8_WAIT_L
#undef PG8_BAR
#undef PG8_SCHED
}
}
namespace mk {
using pg8::bf16_t; using pg8::f32x4; using pg8::u32x4; using pg8::u32x2; using pg8::Unit; using pg8::cvt_pk_bf16;
constexpr int D = 1024, NB = 8, SEQ = 2048, NMETA = 16, LSEQ = SEQ + NMETA;
constexpr int MR = NB * SEQ;
constexpr int MP = MR + 256;
constexpr int NKT = 33;
constexpr int NCF = 9, NCM = 12;
constexpr int NIN = 2304;
constexpr float EPS = 1e-6f;
constexpr float LOG2E = 1.4426950408889634f;
constexpr float C2F = 0.125f * LOG2E;
constexpr float C2M = 0.10206207261596577f * LOG2E;
constexpr int CAP = 16384;
constexpr int NSLOT = 40960;

constexpr size_t MiB = 1u << 20;
constexpr size_t WS_CTL = 0, CTL_BYTES = 1 * MiB;
constexpr int CW_BAR = 4096;
constexpr int CW_CNT = 8192;
constexpr int CW_SSQO = 65536;
constexpr int CW_SSQH = 98304;
constexpr size_t WS_WIN = 1 * MiB, WS_WUQ = 5632 * 1024, WS_WUKV = 6400 * 1024, WS_WO = 7 * MiB, WS_W13 = 9 * MiB, WS_W2 = 41 * MiB;
constexpr size_t WS_ROPE = 57 * MiB;
constexpr size_t WS_WR = 57 * MiB + 512 * 1024;
constexpr size_t WS_LOGF = 58 * MiB, WS_KR = WS_LOGF + 640 * 1024, WS_SSQCQ = WS_KR + 2176 * 1024, WS_SSQCKV = WS_SSQCQ + 640 * 1024, WS_SSQKR = WS_SSQCKV + 320 * 1024;
constexpr size_t WS_TOK = 62 * MiB, WS_LIST = 63 * MiB;
constexpr size_t WS_XN = 66 * MiB;
constexpr size_t WS_O = WS_XN;
constexpr size_t WS_QF = 100 * MiB, WS_KTF = 116 * MiB, WS_VTF = 135 * MiB, WS_CQ = 152 * MiB, WS_CKV = 165 * MiB, WS_QM = 174 * MiB, WS_KTM = 198 * MiB, WS_VTM = 223 * MiB;
constexpr size_t WS_XN2 = 100 * MiB, WS_HD = 132 * MiB, WS_Y = 152 * MiB;
constexpr size_t WS_SNAP = 240 * MiB;
static_assert(WS_WUQ >= WS_WIN + (size_t)NIN * 1024 * 2 && WS_WUKV >= WS_WUQ + 768 * 384 * 2 && WS_WO >= WS_WUKV + 1024 * 256 * 2, "ws map");
static_assert(WS_SSQKR + (size_t)MP * 4 <= WS_TOK && WS_XN + (size_t)MP * D * 2 <= WS_QF, "ws map");
static_assert(WS_KTF + (size_t)64 * NKT * NCF * 1024 <= WS_VTF && WS_VTF + (size_t)64 * NKT * 8192 <= WS_CQ && WS_CQ + (size_t)MP * 384 * 2 <= WS_CKV && WS_CKV + (size_t)MP * 256 * 2 <= WS_QM, "ws map");
static_assert(WS_QM + (size_t)MR * 768 * 2 <= WS_KTM && WS_KTM + (size_t)64 * NKT * NCM * 1024 <= WS_VTM && WS_VTM + (size_t)64 * NKT * 8192 <= WS_SNAP, "ws map");
static_assert(WS_HD + (size_t)NSLOT * 512 <= WS_Y && WS_Y + (size_t)NSLOT * 2048 <= WS_SNAP, "ws map");

__device__ __forceinline__ unsigned f2bf(float f) { unsigned u = __builtin_bit_cast(unsigned, f); return (u + 0x7fffu + ((u >> 16) & 1u)) >> 16; }
__device__ __forceinline__ float bf2f(unsigned short h) { return __builtin_bit_cast(float, (unsigned)h << 16); }
__device__ __forceinline__ float log_sigmoid(float x) { return fminf(x, 0.f) - log1pf(__expf(-fabsf(x))); }

struct Ptrs {
    const float *x, *meta, *g_attn, *w_in, *b_f, *g_fox_q, *g_fox_k, *g_q_lat, *w_uq, *g_kv_lat, *w_ukv, *g_mla_q, *g_mla_k, *g_fox_out, *g_mla_out, *w_o, *g_ffn, *w_group, *b_group, *w_expert, *b_expert, *w1, *w3, *w2;
    float* out; unsigned char* ws;
    __host__ __device__ __forceinline__ bf16_t* WIN() const { return (bf16_t*)(ws + WS_WIN); }
    __host__ __device__ __forceinline__ bf16_t* WUQ() const { return (bf16_t*)(ws + WS_WUQ); }
    __host__ __device__ __forceinline__ bf16_t* WUKV() const { return (bf16_t*)(ws + WS_WUKV); }
    __host__ __device__ __forceinline__ bf16_t* WO() const { return (bf16_t*)(ws + WS_WO); }
    __host__ __device__ __forceinline__ bf16_t* W13() const { return (bf16_t*)(ws + WS_W13); }
    __host__ __device__ __forceinline__ bf16_t* W2() const { return (bf16_t*)(ws + WS_W2); }
    __host__ __device__ __forceinline__ bf16_t* XN() const { return (bf16_t*)(ws + WS_XN); }
    __host__ __device__ __forceinline__ bf16_t* O() const { return (bf16_t*)(ws + WS_O); }
    __host__ __device__ __forceinline__ bf16_t* QF() const { return (bf16_t*)(ws + WS_QF); }
    __host__ __device__ __forceinline__ bf16_t* KTF() const { return (bf16_t*)(ws + WS_KTF); }
    __host__ __device__ __forceinline__ bf16_t* VTF() const { return (bf16_t*)(ws + WS_VTF); }
    __host__ __device__ __forceinline__ bf16_t* CQ() const { return (bf16_t*)(ws + WS_CQ); }
    __host__ __device__ __forceinline__ bf16_t* CKV() const { return (bf16_t*)(ws + WS_CKV); }
    __host__ __device__ __forceinline__ bf16_t* QM() const { return (bf16_t*)(ws + WS_QM); }
    __host__ __device__ __forceinline__ bf16_t* KTM() const { return (bf16_t*)(ws + WS_KTM); }
    __host__ __device__ __forceinline__ bf16_t* VTM() const { return (bf16_t*)(ws + WS_VTM); }
    __host__ __device__ __forceinline__ bf16_t* XN2() const { return (bf16_t*)(ws + WS_XN2); }
    __host__ __device__ __forceinline__ bf16_t* HD() const { return (bf16_t*)(ws + WS_HD); }
    __host__ __device__ __forceinline__ bf16_t* Y() const { return (bf16_t*)(ws + WS_Y); }
    __host__ __device__ __forceinline__ float* ROPE() const { return (float*)(ws + WS_ROPE); }
    __host__ __device__ __forceinline__ float* LOGF() const { return (float*)(ws + WS_LOGF); }
    __host__ __device__ __forceinline__ float* KR() const { return (float*)(ws + WS_KR); }
    __host__ __device__ __forceinline__ float* SSQCQ() const { return (float*)(ws + WS_SSQCQ); }
    __host__ __device__ __forceinline__ float* SSQCKV() const { return (float*)(ws + WS_SSQCKV); }
    __host__ __device__ __forceinline__ float* SSQKR() const { return (float*)(ws + WS_SSQKR); }
    __host__ __device__ __forceinline__ unsigned* ctl() const { return (unsigned*)(ws + WS_CTL); }
    __host__ __device__ __forceinline__ float* SSQO() const { return (float*)(ws + WS_CTL) + CW_SSQO; }
    __host__ __device__ __forceinline__ float* SSQH() const { return (float*)(ws + WS_CTL) + CW_SSQH; }
    __host__ __device__ __forceinline__ bf16_t* WR() const { return (bf16_t*)(ws + WS_WR); }
    __host__ __device__ __forceinline__ int* LIST() const { return (int*)(ws + WS_LIST); }
    __host__ __device__ __forceinline__ unsigned* TOK() const { return (unsigned*)(ws + WS_TOK); }
};

__device__ __forceinline__ size_t kt_off(int bh, int s, int chunk, int NC) { return ((((size_t)bh * NKT + (s >> 6)) * NC + chunk) * 64 + (s & 63)) * 8; }
__device__ __forceinline__ size_t vt_off(int bh, int s, int dhalf, int d32) { return (((size_t)bh * NKT + (s >> 6)) * 4096) + dhalf * 2048 + ((s >> 4) & 3) * 512 + (s & 15) * 32 + d32; }

struct EpiInProj {
    static constexpr bool PERM = true;
    Ptrs P;
    __device__ __forceinline__ void operator()(const f32x4 (&acc)[2][2][4][2], const Unit& u, int wr, int wc, int fr, int fq) const {
        const int pn = u.pn; const bool meta = (u.pm == MR / 256);
        const int rowb = u.pm * 256 + wr * 64 + fr;
        if (pn < 6) {
            const int head = 4 * (pn & 1) + wc;
            f32x4 gv[2][2];
            if (pn < 4) { const float* g = pn < 2 ? P.g_fox_q : P.g_fox_k; const float sc = pn < 2 ? C2F : 1.0f;
#pragma unroll
                for (int bj = 0; bj < 2; ++bj)
#pragma unroll
                    for (int n = 0; n < 2; ++n) gv[bj][n] = *(const f32x4*)(g + 32 * bj + 8 * fq + 4 * n) * sc; }
#pragma unroll
            for (int ai = 0; ai < 2; ++ai)
#pragma unroll
                for (int m = 0; m < 4; ++m) {
                    const int row = rowb + ai * 128 + m * 16;
                    float rs = 1.0f;
                    if (pn < 4) { float ss = 0.f;
#pragma unroll
                        for (int bj = 0; bj < 2; ++bj)
#pragma unroll
                            for (int n = 0; n < 2; ++n) { const f32x4 v = acc[ai][bj][m][n]; ss += (v[0] * v[0] + v[1] * v[1]) + (v[2] * v[2] + v[3] * v[3]); }
                        ss += __shfl_xor(ss, 16); ss += __shfl_xor(ss, 32);
                        rs = 1.0f / sqrtf(ss * (1.0f / 64.0f) + EPS); }
                    u32x4 w[2];
#pragma unroll
                    for (int bj = 0; bj < 2; ++bj) { f32x4 v0 = acc[ai][bj][m][0], v1 = acc[ai][bj][m][1];
                        if (pn < 4) { v0 = v0 * rs * gv[bj][0]; v1 = v1 * rs * gv[bj][1]; }
                        w[bj].x = cvt_pk_bf16(v0[0], v0[1]); w[bj].y = cvt_pk_bf16(v0[2], v0[3]); w[bj].z = cvt_pk_bf16(v1[0], v1[1]); w[bj].w = cvt_pk_bf16(v1[2], v1[3]); }
                    if (pn < 2) { if (!meta) {
#pragma unroll
                            for (int bj = 0; bj < 2; ++bj) *(u32x4*)(P.QF() + (size_t)row * 512 + head * 64 + 32 * bj + 8 * fq) = w[bj]; } }
                    else {
                        int b0, b1, s;
                        if (!meta) { b0 = row >> 11; b1 = b0 + 1; s = NMETA + (row & 2047); } else { const int r = row - MR; s = r; b0 = 0; b1 = r < NMETA ? NB : 0; }
                        for (int b = b0; b < b1; ++b) { const int bh = b * 8 + head;
#pragma unroll
                            for (int bj = 0; bj < 2; ++bj) {
                                if (pn < 4) *(u32x4*)(P.KTF() + kt_off(bh, s, 4 * bj + fq, NCF)) = w[bj];
                                else *(u32x4*)(P.VTF() + vt_off(bh, s, bj, 8 * fq)) = w[bj]; } }
                    }
                }
        } else {
            int kind, colb, slot;
            if (pn == 6) { kind = 0; colb = 64 * wc; slot = wc; }
            else if (pn == 7) { if (wc < 2) { kind = 0; colb = 256 + 64 * wc; slot = 4 + wc; } else { kind = 1; colb = 64 * (wc - 2); slot = wc - 2; } }
            else { if (wc < 2) { kind = 1; colb = 128 + 64 * wc; slot = 2 + wc; } else if (wc == 2) { kind = 2; colb = 0; slot = 0; } else { kind = 3; colb = 0; slot = 0; } }
            if (kind == 3) return;
#pragma unroll
            for (int ai = 0; ai < 2; ++ai)
#pragma unroll
                for (int m = 0; m < 4; ++m) {
                    const int row = rowb + ai * 128 + m * 16;
                    if (kind < 2) {
                        float ss = 0.f;
#pragma unroll
                        for (int bj = 0; bj < 2; ++bj)
#pragma unroll
                            for (int n = 0; n < 2; ++n) { const f32x4 v = acc[ai][bj][m][n]; ss += (v[0] * v[0] + v[1] * v[1]) + (v[2] * v[2] + v[3] * v[3]); }
                        ss += __shfl_xor(ss, 16); ss += __shfl_xor(ss, 32);
                        bf16_t* dst = kind == 0 ? P.CQ() + (size_t)row * 384 + colb : P.CKV() + (size_t)row * 256 + colb;
#pragma unroll
                        for (int bj = 0; bj < 2; ++bj) { const f32x4 v0 = acc[ai][bj][m][0], v1 = acc[ai][bj][m][1]; u32x4 w;
                            w.x = cvt_pk_bf16(v0[0], v0[1]); w.y = cvt_pk_bf16(v0[2], v0[3]); w.z = cvt_pk_bf16(v1[0], v1[1]); w.w = cvt_pk_bf16(v1[2], v1[3]);
                            *(u32x4*)(dst + 32 * bj + 8 * fq) = w; }
                        if (fq == 0) { if (kind == 0) P.SSQCQ()[(size_t)row * 8 + slot] = ss; else P.SSQCKV()[(size_t)row * 4 + slot] = ss; }
                    } else {
                        float ss = 0.f;
#pragma unroll
                        for (int n = 0; n < 2; ++n) { const f32x4 v = acc[ai][0][m][n]; ss += (v[0] * v[0] + v[1] * v[1]) + (v[2] * v[2] + v[3] * v[3]); *(f32x4*)(P.KR() + (size_t)row * 32 + 8 * fq + 4 * n) = v; }
                        ss += __shfl_xor(ss, 16); ss += __shfl_xor(ss, 32);
                        if (fq == 0) { P.SSQKR()[row] = ss;
#pragma unroll
                            for (int n = 0; n < 2; ++n) { const f32x4 v = acc[ai][1][m][n]; const f32x4 bf = *(const f32x4*)(P.b_f + 4 * n); f32x4 o;
                                o[0] = log_sigmoid(v[0] + bf[0]); o[1] = log_sigmoid(v[1] + bf[1]); o[2] = log_sigmoid(v[2] + bf[2]); o[3] = log_sigmoid(v[3] + bf[3]);
                                *(f32x4*)(P.LOGF() + (size_t)row * 8 + 4 * n) = o; } }
                    }
                }
        }
    }
};

struct EpiQup {
    static constexpr bool PERM = true;
    Ptrs P;
    __device__ __forceinline__ void operator()(const f32x4 (&acc)[2][2][4][2], const Unit& u, int wr, int wc, int fr, int fq) const {
        const int rowb = u.pm * 256 + wr * 64 + fr, col0 = u.pn * 256 + wc * 32 + 8 * fq;
#pragma unroll
        for (int ai = 0; ai < 2; ++ai)
#pragma unroll
            for (int m = 0; m < 4; ++m) {
                const int row = rowb + ai * 128 + m * 16;
                const f32x4 s0 = *(const f32x4*)(P.SSQCQ() + (size_t)row * 8); const float s4 = P.SSQCQ()[(size_t)row * 8 + 4], s5 = P.SSQCQ()[(size_t)row * 8 + 5];
                const float rs = 1.0f / sqrtf(((s0[0] + s0[1]) + (s0[2] + s0[3]) + (s4 + s5)) * (1.0f / 384.0f) + EPS);
#pragma unroll
                for (int bj = 0; bj < 2; ++bj) { const f32x4 v0 = acc[ai][bj][m][0] * rs, v1 = acc[ai][bj][m][1] * rs; u32x4 w;
                    w.x = cvt_pk_bf16(v0[0], v0[1]); w.y = cvt_pk_bf16(v0[2], v0[3]); w.z = cvt_pk_bf16(v1[0], v1[1]); w.w = cvt_pk_bf16(v1[2], v1[3]);
                    *(u32x4*)(P.QM() + (size_t)row * 768 + col0 + 128 * bj) = w; }
            }
    }
};

struct EpiKvup {
    static constexpr bool PERM = true;
    Ptrs P;
    __device__ __forceinline__ void operator()(const f32x4 (&acc)[2][2][4][2], const Unit& u, int wr, int wc, int fr, int fq) const {
        const bool meta = (u.pm == MR / 256);
        const int rowb = u.pm * 256 + wr * 64 + fr, head = 2 * u.pn + (wc >> 1); const bool isk = (wc & 1) == 0;
        f32x4 gv[2][2], gr[2];
        if (isk) {
#pragma unroll
            for (int bj = 0; bj < 2; ++bj)
#pragma unroll
                for (int n = 0; n < 2; ++n) gv[bj][n] = *(const f32x4*)(P.g_mla_k + 32 * bj + 8 * fq + 4 * n);
            gr[0] = *(const f32x4*)(P.g_mla_k + 64 + 4 * fq); gr[1] = *(const f32x4*)(P.g_mla_k + 80 + 4 * fq); }
#pragma unroll
        for (int ai = 0; ai < 2; ++ai)
#pragma unroll
            for (int m = 0; m < 4; ++m) {
                const int row = rowb + ai * 128 + m * 16;
                const f32x4 sk = *(const f32x4*)(P.SSQCKV() + (size_t)row * 4);
                const float rl = 1.0f / sqrtf(((sk[0] + sk[1]) + (sk[2] + sk[3])) * (1.0f / 256.0f) + EPS);
                f32x4 v[2][2];
#pragma unroll
                for (int bj = 0; bj < 2; ++bj)
#pragma unroll
                    for (int n = 0; n < 2; ++n) v[bj][n] = acc[ai][bj][m][n] * rl;
                int b0, b1, s;
                if (!meta) { b0 = row >> 11; b1 = b0 + 1; s = NMETA + (row & 2047); } else { const int r = row - MR; s = r < NMETA ? r : 0; b0 = 0; b1 = r < NMETA ? NB : 0; }
                if (isk) {
                    float ss = 0.f;
#pragma unroll
                    for (int bj = 0; bj < 2; ++bj)
#pragma unroll
                        for (int n = 0; n < 2; ++n) { const f32x4 q = v[bj][n]; ss += (q[0] * q[0] + q[1] * q[1]) + (q[2] * q[2] + q[3] * q[3]); }
                    ss += __shfl_xor(ss, 16); ss += __shfl_xor(ss, 32);
                    ss += P.SSQKR()[row];
                    const float rk = 1.0f / sqrtf(ss * (1.0f / 96.0f) + EPS);
                    u32x4 w[2];
#pragma unroll
                    for (int bj = 0; bj < 2; ++bj) { const f32x4 v0 = v[bj][0] * rk * gv[bj][0], v1 = v[bj][1] * rk * gv[bj][1];
                        w[bj].x = cvt_pk_bf16(v0[0], v0[1]); w[bj].y = cvt_pk_bf16(v0[2], v0[3]); w[bj].z = cvt_pk_bf16(v1[0], v1[1]); w[bj].w = cvt_pk_bf16(v1[2], v1[3]); }
                    const f32x4 x1 = *(const f32x4*)(P.KR() + (size_t)row * 32 + 4 * fq) * rk * gr[0], x2 = *(const f32x4*)(P.KR() + (size_t)row * 32 + 16 + 4 * fq) * rk * gr[1];
                    const f32x4 cs0 = *(const f32x4*)(P.ROPE() + ((size_t)s * 16 + 4 * fq) * 2), cs1 = *(const f32x4*)(P.ROPE() + ((size_t)s * 16 + 4 * fq) * 2 + 4);
                    const float c0 = cs0[0], n0 = cs0[1], c1 = cs0[2], n1 = cs0[3], c2 = cs1[0], n2 = cs1[1], c3 = cs1[2], n3 = cs1[3];
                    u32x2 r1, r2;
                    r1.x = cvt_pk_bf16(x1[0] * c0 - x2[0] * n0, x1[1] * c1 - x2[1] * n1); r1.y = cvt_pk_bf16(x1[2] * c2 - x2[2] * n2, x1[3] * c3 - x2[3] * n3);
                    r2.x = cvt_pk_bf16(x1[0] * n0 + x2[0] * c0, x1[1] * n1 + x2[1] * c1); r2.y = cvt_pk_bf16(x1[2] * n2 + x2[2] * c2, x1[3] * n3 + x2[3] * c3);
                    for (int b = b0; b < b1; ++b) { const int bh = b * 8 + head;
#pragma unroll
                        for (int bj = 0; bj < 2; ++bj) *(u32x4*)(P.KTM() + kt_off(bh, s, 4 * bj + fq, NCM)) = w[bj];
                        *(u32x2*)(P.KTM() + kt_off(bh, s, 8 + (fq >> 1), NCM) + 4 * (fq & 1)) = r1;
                        *(u32x2*)(P.KTM() + kt_off(bh, s, 10 + (fq >> 1), NCM) + 4 * (fq & 1)) = r2; }
                } else {
                    u32x4 w[2];
#pragma unroll
                    for (int bj = 0; bj < 2; ++bj) { const f32x4 v0 = v[bj][0], v1 = v[bj][1];
                        w[bj].x = cvt_pk_bf16(v0[0], v0[1]); w[bj].y = cvt_pk_bf16(v0[2], v0[3]); w[bj].z = cvt_pk_bf16(v1[0], v1[1]); w[bj].w = cvt_pk_bf16(v1[2], v1[3]); }
                    for (int b = b0; b < b1; ++b) { const int bh = b * 8 + head;
#pragma unroll
                        for (int bj = 0; bj < 2; ++bj) *(u32x4*)(P.VTM() + vt_off(bh, s, bj, 8 * fq)) = w[bj]; }
                }
            }
    }
};

struct EpiOut {
    static constexpr bool PERM = false;
    Ptrs P;
    __device__ __forceinline__ void rstds(int row, float& rf, float& rm) const {
        const float sf = P.SSQO()[(size_t)row * 2], sm = P.SSQO()[(size_t)row * 2 + 1];
        rf = 1.0f / sqrtf(sf * (1.0f / 512.0f) + EPS); rm = 1.0f / sqrtf(sm * (1.0f / 512.0f) + EPS);
    }
    __device__ __forceinline__ void mid(f32x4 (&acc)[2][2][4][2], const Unit& u, int wr, int fr) const {
#pragma unroll
        for (int ai = 0; ai < 2; ++ai)
#pragma unroll
            for (int m = 0; m < 4; ++m) { float rf, rm; rstds(u.pm * 256 + ai * 128 + wr * 64 + m * 16 + fr, rf, rm); const float ratio = rf / rm;
#pragma unroll
                for (int bj = 0; bj < 2; ++bj)
#pragma unroll
                    for (int n = 0; n < 2; ++n) acc[ai][bj][m][n] *= ratio; }
    }
    __device__ __forceinline__ void operator()(const f32x4 (&acc)[2][2][4][2], const Unit& u, int wr, int wc, int fr, int fq) const {
        const int col0 = u.pn * 256 + wc * 32 + 4 * fq;
#pragma unroll
        for (int ai = 0; ai < 2; ++ai)
#pragma unroll
            for (int m = 0; m < 4; ++m) { const int row = u.pm * 256 + ai * 128 + wr * 64 + m * 16 + fr; float rf, rm; rstds(row, rf, rm);
                const size_t off = (size_t)row * D + col0;
                float ss = 0.f;
#pragma unroll
                for (int bj = 0; bj < 2; ++bj)
#pragma unroll
                    for (int n = 0; n < 2; ++n) { const f32x4 xv = *(const f32x4*)(P.x + off + bj * 128 + n * 16); const f32x4 hv = xv + acc[ai][bj][m][n] * rm; *(f32x4*)(P.out + off + bj * 128 + n * 16) = hv;
                        ss += (hv[0] * hv[0] + hv[1] * hv[1]) + (hv[2] * hv[2] + hv[3] * hv[3]); }
                ss += __shfl_xor(ss, 16); ss += __shfl_xor(ss, 32);
                if (fq == 0) atomicAdd(P.SSQH() + row, ss); }
    }
};

struct EpiMoeUp {
    static constexpr bool PERM = true;
    Ptrs P;
    __device__ __forceinline__ void operator()(const f32x4 (&acc)[2][2][4][2], const Unit& u, int wr, int wc, int fr, int fq) const {
        const int col0 = (u.pn & 1) * 128 + wc * 32 + 8 * fq;
#pragma unroll
        for (int ai = 0; ai < 2; ++ai)
#pragma unroll
            for (int m = 0; m < 4; ++m) { const size_t row = (size_t)u.pm * 256 + ai * 128 + wr * 64 + m * 16 + fr; float h[8];
#pragma unroll
                for (int n = 0; n < 2; ++n)
#pragma unroll
                    for (int e = 0; e < 4; ++e) { const float a = acc[ai][0][m][n][e], b = acc[ai][1][m][n][e]; h[4 * n + e] = a * b / (1.0f + __expf(-a)); }
                u32x4 w; w.x = cvt_pk_bf16(h[0], h[1]); w.y = cvt_pk_bf16(h[2], h[3]); w.z = cvt_pk_bf16(h[4], h[5]); w.w = cvt_pk_bf16(h[6], h[7]);
                *(u32x4*)(P.HD() + row * 256 + col0) = w; }
    }
};
struct EpiMoeDown {
    static constexpr bool PERM = true;
    Ptrs P;
    __device__ __forceinline__ void operator()(const f32x4 (&acc)[2][2][4][2], const Unit& u, int wr, int wc, int fr, int fq) const {
        const int col0 = (u.pn & 3) * 256 + wc * 32 + 8 * fq;
#pragma unroll
        for (int ai = 0; ai < 2; ++ai)
#pragma unroll
            for (int m = 0; m < 4; ++m) { const size_t row = (size_t)u.pm * 256 + ai * 128 + wr * 64 + m * 16 + fr;
#pragma unroll
                for (int bj = 0; bj < 2; ++bj) { const f32x4 v0 = acc[ai][bj][m][0], v1 = acc[ai][bj][m][1]; u32x4 w;
                    w.x = cvt_pk_bf16(v0[0], v0[1]); w.y = cvt_pk_bf16(v0[2], v0[3]); w.z = cvt_pk_bf16(v1[0], v1[1]); w.w = cvt_pk_bf16(v1[2], v1[3]);
                    *(u32x4*)(P.Y() + row * 1024 + col0 + 128 * bj) = w; } }
    }
};
}
namespace mk {
typedef short bf16x8 __attribute__((ext_vector_type(8)));
typedef short s16x4 __attribute__((ext_vector_type(4)));
typedef float f32x16 __attribute__((ext_vector_type(16)));
#define MK_LAS __attribute__((address_space(3)))
__device__ __forceinline__ int crow(int r, int hi) { return (r & 3) + 8 * (r >> 2) + 4 * hi; }
__device__ __forceinline__ s16x4 vtr(const MK_LAS char* p) { typedef short v4 __attribute__((ext_vector_type(4))); return __builtin_bit_cast(s16x4, __builtin_amdgcn_ds_read_tr16_b64_v4i16((MK_LAS v4*)p)); }

template <bool MLA>
__device__ __forceinline__ void attn_unit(MK_LAS unsigned char* lds, const Ptrs& P, int b, int h, int qb) {
    constexpr int NC = MLA ? NCM : NCF, NKS = MLA ? 6 : 5, KSL = NC * 1024, VSL = 8192;
    const int tid = threadIdx.x, lane = tid & 63, r32 = lane & 31, hi = lane >> 5; const int wid = __builtin_amdgcn_readfirstlane(tid >> 6);
    const int qi = qb * 256 + wid * 32 + r32;
    const size_t row = (size_t)b * SEQ + qi;
    const int bh = b * 8 + h;
    const bf16_t* Kt = (MLA ? P.KTM() : P.KTF()) + (size_t)bh * NKT * NC * 512;
    const bf16_t* Vt = (MLA ? P.VTM() : P.VTF()) + (size_t)bh * NKT * 4096;
    const int NT = 4 * qb + 5;
#define MK_DMA(t, buf) do { \
        for (int p_ = wid; p_ < NC; p_ += 8) __builtin_amdgcn_global_load_lds((const unsigned*)(Kt + (size_t)(t) * NC * 512 + p_ * 512 + lane * 8), (MK_LAS unsigned*)(lds + (buf) * KSL + p_ * 1024), 16, 0, 0); \
        __builtin_amdgcn_global_load_lds((const unsigned*)(Vt + (size_t)(t) * 4096 + wid * 512 + lane * 8), (MK_LAS unsigned*)(lds + 2 * KSL + (buf) * VSL + wid * 1024), 16, 0, 0); } while (0)
    MK_DMA(0, 0);
    bf16x8 qf[NKS];
    if constexpr (!MLA) {
        const bf16_t* qp = P.QF() + row * 512 + h * 64 + hi * 8;
#pragma unroll
        for (int d0 = 0; d0 < 4; ++d0) qf[d0] = *(const bf16x8*)(qp + d0 * 16);
        const short one = (short)0x3F80;
        qf[4] = hi == 0 ? (bf16x8){one, one, one, 0, 0, 0, 0, 0} : (bf16x8){0, 0, 0, 0, 0, 0, 0, 0};
    } else {
        const bf16_t* qp = P.QM() + row * 768 + h * 96 + hi * 8;
        float v[6][8]; float ss = 0.f;
#pragma unroll
        for (int d0 = 0; d0 < 6; ++d0) { const bf16x8 raw = *(const bf16x8*)(qp + d0 * 16);
#pragma unroll
            for (int j = 0; j < 8; ++j) { v[d0][j] = bf2f((unsigned short)raw[j]); ss += v[d0][j] * v[d0][j]; } }
        ss += __shfl_xor(ss, 32);
        const float rs = 1.0f / sqrtf(ss * (1.0f / 96.0f) + EPS);
#pragma unroll
        for (int d0 = 0; d0 < 6; ++d0)
#pragma unroll
            for (int j = 0; j < 8; ++j) v[d0][j] *= rs * P.g_mla_q[16 * d0 + 8 * hi + j];
        const float* cs = P.ROPE() + ((size_t)(NMETA + qi) * 16 + 8 * hi) * 2;
#pragma unroll
        for (int j = 0; j < 8; ++j) { const float c = cs[2 * j], s = cs[2 * j + 1], x1 = v[4][j], x2 = v[5][j]; v[4][j] = x1 * c - x2 * s; v[5][j] = x1 * s + x2 * c; }
#pragma unroll
        for (int d0 = 0; d0 < 6; ++d0) { u32x4 w; w.x = cvt_pk_bf16(v[d0][0] * C2M, v[d0][1] * C2M); w.y = cvt_pk_bf16(v[d0][2] * C2M, v[d0][3] * C2M); w.z = cvt_pk_bf16(v[d0][4] * C2M, v[d0][5] * C2M); w.w = cvt_pk_bf16(v[d0][6] * C2M, v[d0][7] * C2M);
            qf[d0] = __builtin_bit_cast(bf16x8, w); }
    }
    float mrow = -1e30f, lrow = 0.f; f32x16 o0 = {}, o1 = {};
    const int sq = NMETA + qi;
    const MK_LAS char* kp0 = (const MK_LAS char*)lds + hi * 1024 + r32 * 16;
    const MK_LAS char* kpa = (const MK_LAS char*)lds + 8 * 1024 + r32 * 16;
    const MK_LAS char* vp0 = (const MK_LAS char*)lds + 2 * KSL + ((lane >> 4) & 1) * 32 + (lane & 3) * 8 + (4 * hi + ((lane & 15) >> 2)) * 64;
    asm volatile("s_waitcnt vmcnt(0)" ::: "memory"); __syncthreads();
    for (int t = 0; t < NT; ++t) {
        const int buf = t & 1;
        if (t + 1 < NT) MK_DMA(t + 1, buf ^ 1);
        f32x16 p0 = {}, p1 = {};
#pragma unroll
        for (int ks = 0; ks < NKS; ++ks) {
            const MK_LAS char* kp = (!MLA && ks == 4) ? kpa + buf * KSL : kp0 + buf * KSL + ks * 2048;
            const bf16x8 k0 = *(const MK_LAS bf16x8*)kp, k1 = *(const MK_LAS bf16x8*)(kp + 512);
            p0 = __builtin_amdgcn_mfma_f32_32x32x16_bf16(k0, qf[ks], p0, 0, 0, 0);
            p1 = __builtin_amdgcn_mfma_f32_32x32x16_bf16(k1, qf[ks], p1, 0, 0, 0);
        }
        if (t >= NT - 5) {
            const int kb = 64 * t + 4 * hi;
#pragma unroll
            for (int r = 0; r < 16; ++r) { const int s = kb + (r & 3) + 8 * (r >> 2); if (s > sq) p0[r] = -INFINITY; if (s + 32 > sq) p1[r] = -INFINITY; }
        }
        float rm = fmaxf(p0[0], p1[0]);
#pragma unroll
        for (int r = 1; r < 16; ++r) rm = fmaxf(rm, fmaxf(p0[r], p1[r]));
        rm = fmaxf(rm, __shfl_xor(rm, 32));
        const float mnew = fmaxf(mrow, rm);
        if (__any(mnew > mrow)) { const float alpha = __builtin_amdgcn_exp2f(mrow - mnew); lrow *= alpha;
#pragma unroll
            for (int r = 0; r < 16; ++r) { o0[r] *= alpha; o1[r] *= alpha; }
            mrow = mnew; }
        float rsum = 0.f;
#pragma unroll
        for (int r = 0; r < 16; ++r) { p0[r] = __builtin_amdgcn_exp2f(p0[r] - mrow); p1[r] = __builtin_amdgcn_exp2f(p1[r] - mrow); rsum += p0[r] + p1[r]; }
        lrow += rsum;
        bf16x8 pw[4];
#pragma unroll
        for (int k = 0; k < 2; ++k) { u32x4 a, c;
            a.x = cvt_pk_bf16(p0[8 * k + 0], p0[8 * k + 1]); a.y = cvt_pk_bf16(p0[8 * k + 2], p0[8 * k + 3]); a.z = cvt_pk_bf16(p0[8 * k + 4], p0[8 * k + 5]); a.w = cvt_pk_bf16(p0[8 * k + 6], p0[8 * k + 7]);
            c.x = cvt_pk_bf16(p1[8 * k + 0], p1[8 * k + 1]); c.y = cvt_pk_bf16(p1[8 * k + 2], p1[8 * k + 3]); c.z = cvt_pk_bf16(p1[8 * k + 4], p1[8 * k + 5]); c.w = cvt_pk_bf16(p1[8 * k + 6], p1[8 * k + 7]);
            pw[k] = __builtin_bit_cast(bf16x8, a); pw[2 + k] = __builtin_bit_cast(bf16x8, c); }
        const MK_LAS char* vp = vp0 + buf * VSL;
#pragma unroll
        for (int ks = 0; ks < 4; ++ks) {
            const s16x4 l0 = vtr(vp + ks * 1024), h0 = vtr(vp + ks * 1024 + 512), l1 = vtr(vp + 4096 + ks * 1024), h1 = vtr(vp + 4096 + ks * 1024 + 512);
            const bf16x8 vf0 = {l0[0], l0[1], l0[2], l0[3], h0[0], h0[1], h0[2], h0[3]}, vf1 = {l1[0], l1[1], l1[2], l1[3], h1[0], h1[1], h1[2], h1[3]};
            o0 = __builtin_amdgcn_mfma_f32_32x32x16_bf16(vf0, pw[ks], o0, 0, 0, 0);
            o1 = __builtin_amdgcn_mfma_f32_32x32x16_bf16(vf1, pw[ks], o1, 0, 0, 0);
        }
        asm volatile("s_waitcnt vmcnt(0)" ::: "memory"); __syncthreads();
    }
#undef MK_DMA
    lrow += __shfl_xor(lrow, 32);
    const float inv = 1.0f / lrow; float ssq = 0.f;
    bf16_t* op = P.O() + row * 1024 + (MLA ? 512 : 0) + h * 64 + 4 * hi;
#pragma unroll
    for (int g = 0; g < 4; ++g) {
        const float a0 = o0[4 * g] * inv, a1 = o0[4 * g + 1] * inv, a2 = o0[4 * g + 2] * inv, a3 = o0[4 * g + 3] * inv;
        const float c0 = o1[4 * g] * inv, c1 = o1[4 * g + 1] * inv, c2 = o1[4 * g + 2] * inv, c3 = o1[4 * g + 3] * inv;
        ssq += (a0 * a0 + a1 * a1) + (a2 * a2 + a3 * a3) + (c0 * c0 + c1 * c1) + (c2 * c2 + c3 * c3);
        u32x2 w0, w1; w0.x = cvt_pk_bf16(a0, a1); w0.y = cvt_pk_bf16(a2, a3); w1.x = cvt_pk_bf16(c0, c1); w1.y = cvt_pk_bf16(c2, c3);
        *(u32x2*)(op + 8 * g) = w0; *(u32x2*)(op + 32 + 8 * g) = w1;
    }
    ssq += __shfl_xor(ssq, 32);
    if (hi == 0) atomicAdd(P.SSQO() + row * 2 + (MLA ? 1 : 0), ssq);
}

__device__ __forceinline__ void attn_phase(MK_LAS unsigned char* lds, const Ptrs& P, int vcu, int G) {
    for (int id = vcu; id < 1024; id += G) {
        const int v = id & 255, k = id >> 8, bh = v >> 2, sub = v & 3, qb = (k & 1) ? sub : 7 - sub;
        if (k >> 1) attn_unit<true>(lds, P, bh >> 3, bh & 7, qb); else attn_unit<false>(lds, P, bh >> 3, bh & 7, qb);
    }
}
}
namespace mk {
constexpr int NWAVES = 8;
constexpr int RING_BYTES = 131072, LDSCTL_OFF = RING_BYTES, LDS_BYTES = 147456;
#define GAS __attribute__((address_space(1)))
#define RLX_AGENT __ATOMIC_RELAXED, __HIP_MEMORY_SCOPE_AGENT
#define LDS_WAIT() asm volatile("s_waitcnt lgkmcnt(0)" ::: "memory")

#define XB_TMO      128
#define XB_XCNT(j)  (256  + 64 * (j))
#define XB_XSUB(j)  (1280 + 64 * (j))
#define XB_XGEN(j)  (2304 + 64 * (j))
#define XB_TOP      3328
#define XB_TOPGEN   3392
#define XCD_BAR_WORDS 3456
#define XB_SPIN_CAP (1u << 18)
__device__ __forceinline__ unsigned xb_ld(unsigned* p)              { return __hip_atomic_load(p, __ATOMIC_RELAXED, __HIP_MEMORY_SCOPE_AGENT); }
__device__ __forceinline__ unsigned xb_add(unsigned* p, unsigned v) { return __hip_atomic_fetch_add(p, v, __ATOMIC_RELAXED, __HIP_MEMORY_SCOPE_AGENT); }
__device__ __forceinline__ unsigned xb_xcc_id() { return (unsigned)__builtin_amdgcn_s_getreg((3 << 11) | 20) & 0xFu; }
#define XB_SPIN(cond, bar) do { unsigned _sp = 0; while (cond) { __builtin_amdgcn_s_sleep(1); \
    if ((++_sp & 255u) == 0u) { if (xb_ld(&(bar)[XB_TMO])) break; if (_sp > XB_SPIN_CAP) { atomicAdd(&(bar)[XB_TMO], 1u); break; } } } } while (0)
struct XcdBarrier { unsigned* bar; unsigned x; volatile MK_LAS unsigned* st; };
__device__ __forceinline__ XcdBarrier xcd_barrier_post(unsigned* bar, volatile MK_LAS unsigned* st) {
    XcdBarrier b; b.bar = bar; b.x = xb_xcc_id(); b.st = st;
    if (threadIdx.x == 0) (void)xb_add(&bar[XB_XCNT(b.x)], 1u);
    return b;
}
__device__ __forceinline__ void xcd_barrier_complete(unsigned* bar, unsigned x, unsigned& nloc, unsigned& nx) {
    const unsigned G = gridDim.x * gridDim.y * gridDim.z;
    unsigned sum, cnt, mine, sp = 0u;
    for (;;) {
        sum = 0u; cnt = 0u; mine = 0u;
#pragma unroll
        for (unsigned j = 0; j < 16; ++j) { const unsigned c = xb_ld(&bar[XB_XCNT(j)]); sum += c; cnt += (c > 0u) ? 1u : 0u; mine = (j == x) ? c : mine; }
        if (sum == G) break;
        __builtin_amdgcn_s_sleep(1);
        if ((++sp & 255u) == 0u) { if (xb_ld(&bar[XB_TMO])) break; if (sp > XB_SPIN_CAP) { atomicAdd(&bar[XB_TMO], 1u); break; } }
    }
    nloc = mine > 0u ? mine : 1u; nx = cnt > 0u ? cnt : 1u;
}
__device__ __forceinline__ void xcd_barrier(const XcdBarrier& b) {
    asm volatile("s_waitcnt vmcnt(0)" ::: "memory");
    __syncthreads();
    if (threadIdx.x == 0) {
        unsigned* bar = b.bar;
        __builtin_amdgcn_s_waitcnt(0);
        unsigned nloc = b.st[0], nx = b.st[1];
        if (nloc == 0u) { xcd_barrier_complete(bar, b.x, nloc, nx); b.st[0] = nloc; b.st[1] = nx; }
        const unsigned old = xb_add(&bar[XB_XSUB(b.x)], 1u);
        const unsigned gen = old / nloc;
        if (old + 1u == (gen + 1u) * nloc) {
            __builtin_amdgcn_fence(__ATOMIC_RELEASE, "agent");
            asm volatile("s_waitcnt vmcnt(0)" ::: "memory");
            const unsigned og = xb_add(&bar[XB_TOP], 1u);
            const unsigned tg = og / nx;
            if (og + 1u == (tg + 1u) * nx) xb_add(&bar[XB_TOPGEN], 1u);
            else XB_SPIN(xb_ld(&bar[XB_TOPGEN]) == tg, bar);
            __builtin_amdgcn_fence(__ATOMIC_ACQUIRE, "agent");
            xb_add(&bar[XB_XGEN(b.x)], 1u);
            asm volatile("s_waitcnt vmcnt(0)" ::: "memory");
        } else {
            XB_SPIN(xb_ld(&bar[XB_XGEN(b.x)]) == gen, bar);
            __builtin_amdgcn_fence(__ATOMIC_ACQUIRE, "agent");
            asm volatile("s_waitcnt vmcnt(0)" ::: "memory");
        }
    }
    __syncthreads();
}

__device__ __forceinline__ float wave_sum(float v) {
#pragma unroll
    for (int o = 1; o < 64; o <<= 1) v += __shfl_xor(v, o);
    return v;
}
__device__ __forceinline__ unsigned pk2(float lo, float hi) { return f2bf(lo) | (f2bf(hi) << 16); }

struct P0Item { const float* W; const float* gk; bf16_t* WT; int ldw, col0, nvalid, K, n0, k0; };
__device__ __forceinline__ P0Item p0_decode(const Ptrs& P, int it) {
    constexpr int I_IN = 16 * 72, I_UQ = 6 * 24, I_UKV = 4 * 32, I_O = 16 * 32, I_13 = 32 * 256;
    P0Item d; int r = it; d.gk = nullptr; d.nvalid = 32;
    if (r < I_IN) { const int kb = r / 72, nb = r % 72, n0 = 32 * nb, pn = n0 >> 8, wi = n0 & 255, bj = wi >> 7, wc = (wi >> 5) & 3, LG = 256 * pn + 64 * wc + 32 * bj;
        int src = 0, nv = 32;
        if (LG < 1536) src = LG; else if (LG < 1920) src = 1544 + (LG - 1536); else if (LG < 2176) src = 1928 + (LG - 1920); else if (LG < 2208) src = 2184 + (LG - 2176); else if (LG == 2208) { src = 1536; nv = 8; } else nv = 0;
        d.W = P.w_in; d.ldw = 2216; d.col0 = src; d.nvalid = nv; d.WT = P.WIN(); d.K = 1024; d.n0 = n0; d.k0 = 64 * kb; return d; } r -= I_IN;
    if (r < I_UQ) { const int kb = r / 24, nb = r % 24; d.W = P.w_uq; d.ldw = 768; d.col0 = 32 * nb; d.gk = P.g_q_lat + 64 * kb; d.WT = P.WUQ(); d.K = 384; d.n0 = 32 * nb; d.k0 = 64 * kb; return d; } r -= I_UQ;
    if (r < I_UKV) { const int kb = r / 32, nb = r % 32, n0 = 32 * nb, pn = n0 >> 8, bj = (n0 >> 7) & 1, wc = (n0 >> 5) & 3;
        d.W = P.w_ukv; d.ldw = 1024; d.col0 = (2 * pn + (wc >> 1)) * 128 + (wc & 1) * 64 + 32 * bj; d.gk = P.g_kv_lat + 64 * kb; d.WT = P.WUKV(); d.K = 256; d.n0 = n0; d.k0 = 64 * kb; return d; } r -= I_UKV;
    if (r < I_O) { const int kb = r / 32, nb = r % 32; d.W = P.w_o; d.ldw = 1024; d.col0 = 32 * nb; d.gk = kb < 8 ? P.g_fox_out + 64 * kb : P.g_mla_out + 64 * (kb - 8); d.WT = P.WO(); d.K = 1024; d.n0 = 32 * nb; d.k0 = 64 * kb; return d; } r -= I_O;
    if (r < I_13) { const int e = r >> 8, rr = r & 255, kb = rr >> 4, nb = rr & 15, n0 = 32 * nb, pn = n0 >> 8, bj = (n0 >> 7) & 1, wc = (n0 >> 5) & 3;
        d.W = (bj ? P.w3 : P.w1) + (size_t)e * 262144; d.ldw = 256; d.col0 = 128 * pn + 32 * wc; d.WT = P.W13() + (size_t)e * 524288; d.K = 1024; d.n0 = n0; d.k0 = 64 * kb; return d; } r -= I_13;
    { const int e = r >> 7, rr = r & 127, kb = rr >> 5, nb = rr & 31; d.W = P.w2 + (size_t)e * 262144; d.ldw = 1024; d.col0 = 32 * nb; d.WT = P.W2() + (size_t)e * 262144; d.K = 256; d.n0 = 32 * nb; d.k0 = 64 * kb; return d; }
}
constexpr int P0_NITEMS = 16 * 72 + 6 * 24 + 4 * 32 + 16 * 32 + 32 * 256 + 32 * 128;
constexpr int P0_FIRST_MOE = 16 * 72 + 6 * 24 + 4 * 32 + 16 * 32;
__device__ __forceinline__ void p0_load(const P0Item& d, float (&v)[32], int lane) {
    const int c = lane & 31; const float* src = d.W + (size_t)(d.k0 + (lane >> 5)) * d.ldw + d.col0 + c; const bool ok = c < d.nvalid;
#pragma unroll
    for (int i = 0; i < 32; ++i) v[i] = ok ? src[(size_t)(2 * i) * d.ldw] : 0.f;
}
__device__ __forceinline__ void p0_finish(const P0Item& d, const float (&v)[32], MK_LAS float* scr, int lane) {
    const int c = lane & 31;
#pragma unroll
    for (int i = 0; i < 32; ++i) { const int kk = 2 * i + (lane >> 5); float x = v[i]; if (d.gk) x *= d.gk[kk]; scr[kk * 33 + c] = x; }
    LDS_WAIT(); asm volatile("" ::: "memory");
    const int ch = lane & 7;
#pragma unroll
    for (int j = 0; j < 4; ++j) { const int n = (lane >> 3) + 8 * j; const MK_LAS float* s = scr + (8 * ch) * 33 + n;
        u32x4 o; o.x = pk2(s[0 * 33], s[1 * 33]); o.y = pk2(s[2 * 33], s[3 * 33]); o.z = pk2(s[4 * 33], s[5 * 33]); o.w = pk2(s[6 * 33], s[7 * 33]);
        *(GAS u32x4*)(d.WT + (size_t)(d.n0 + n) * d.K + d.k0 + 8 * ch) = o; }
    LDS_WAIT(); asm volatile("" ::: "memory");
}
__device__ __forceinline__ void p0_convert(const Ptrs& P, MK_LAS float* scr, int first, int step, int end, int lane) {
    if (first >= end) return;
    float va[32], vb[32]; P0Item da = p0_decode(P, first), db = da;
    p0_load(da, va, lane);
    for (int it = first; it < end; it += 2 * step) {
        const bool hb = it + step < end; if (hb) { db = p0_decode(P, it + step); p0_load(db, vb, lane); }
        p0_finish(da, va, scr, lane);
        const bool ha = it + 2 * step < end; if (ha) { da = p0_decode(P, it + 2 * step); p0_load(da, va, lane); }
        if (hb) p0_finish(db, vb, scr, lane);
    }
}
__device__ __forceinline__ void p0_prologue(const Ptrs& P, MK_LAS unsigned char* lds, int vcu, int G, int wave, int lane) {
    MK_LAS float* scr = (MK_LAS float*)(lds + wave * 16384);
    const int gw = vcu * NWAVES + wave, NGW = G * NWAVES;
    p0_convert(P, scr, gw, NGW, P0_NITEMS, lane);
    for (int m = gw; m < MP; m += NGW) {
        GAS unsigned long long* o8 = (GAS unsigned long long*)(P.XN() + (size_t)m * D) + lane;
        if (m >= MR + NMETA) {
#pragma unroll
            for (int j = 0; j < 4; ++j) o8[64 * j] = 0ull;
            continue; }
        const float* src = m < MR ? P.x + (size_t)m * D : P.meta + (size_t)(m - MR) * D;
        const GAS f32x4* xr = (const GAS f32x4*)src + lane; f32x4 v[4]; float s = 0.f;
#pragma unroll
        for (int j = 0; j < 4; ++j) { v[j] = xr[64 * j]; s += (v[j][0] * v[j][0] + v[j][1] * v[j][1]) + (v[j][2] * v[j][2] + v[j][3] * v[j][3]); }
        const float rstd = 1.f / sqrtf(wave_sum(s) * (1.f / D) + EPS);
#pragma unroll
        for (int j = 0; j < 4; ++j) { const f32x4 g = *(const f32x4*)(P.g_attn + 4 * lane + 256 * j);
            o8[64 * j] = (unsigned long long)pk2(v[j][0] * rstd * g[0], v[j][1] * rstd * g[1]) | ((unsigned long long)pk2(v[j][2] * rstd * g[2], v[j][3] * rstd * g[3]) << 32); }
    }
    for (int idx = vcu * (NWAVES * 64) + (int)threadIdx.x; idx < 64 * 2368; idx += G * NWAVES * 64) {
        const int bh = idx / 2368, r = idx % 2368; u32x4* p;
        if (r < 576) p = (u32x4*)(P.KTF() + ((size_t)bh * NKT + 32) * NCF * 512) + r;
        else if (r < 1344) p = (u32x4*)(P.KTM() + ((size_t)bh * NKT + 32) * NCM * 512) + (r - 576);
        else if (r < 1856) p = (u32x4*)(P.VTF() + ((size_t)bh * NKT + 32) * 4096) + (r - 1344);
        else p = (u32x4*)(P.VTM() + ((size_t)bh * NKT + 32) * 4096) + (r - 1856);
        *p = (u32x4){0u, 0u, 0u, 0u}; }
    for (int idx = vcu * (NWAVES * 64) + (int)threadIdx.x; idx < 48 * 128; idx += G * NWAVES * 64) {
        const int n = idx >> 7, k0 = (idx & 127) * 8; float v[8];
#pragma unroll
        for (int j = 0; j < 8; ++j) v[j] = n < 4 ? P.w_group[(size_t)(k0 + j) * 4 + n] : (n < 36 ? P.w_expert[(size_t)(k0 + j) * 32 + (n - 4)] : 0.f);
        u32x4 w; w.x = pk2(v[0], v[1]); w.y = pk2(v[2], v[3]); w.z = pk2(v[4], v[5]); w.w = pk2(v[6], v[7]);
        *(u32x4*)(P.WR() + (size_t)n * D + k0) = w; }
    for (int idx = vcu * (NWAVES * 64) + (int)threadIdx.x; idx < LSEQ * 16; idx += G * NWAVES * 64) {
        const int pos = idx >> 4, i = idx & 15; const float inv_freq = expf(-logf(10000.0f) * (float)i / 16.0f), ang = (float)pos * inv_freq;
        P.ROPE()[2 * idx] = cosf(ang); P.ROPE()[2 * idx + 1] = sinf(ang); }
}

__device__ __forceinline__ void fox_bias_store(const Ptrs& P, int bh, int s, float cum) {
    const float bias = -cum * LOG2E;
    const unsigned h_ = f2bf(bias); const float r1 = bias - bf2f((unsigned short)h_); const unsigned m_ = f2bf(r1); const float r2 = r1 - bf2f((unsigned short)m_); const unsigned l_ = f2bf(r2);
    u32x4 w; w.x = h_ | (m_ << 16); w.y = l_; w.z = 0u; w.w = 0u;
    *(u32x4*)(P.KTF() + kt_off(bh, s, 8, NCF)) = w;
}
__device__ __forceinline__ void fox_scan(const Ptrs& P, int bh, int lane) {
    const int b = bh >> 3, h = bh & 7;
    float x = lane < NMETA ? P.LOGF()[(size_t)(MR + lane) * 8 + h] : 0.f;
#pragma unroll
    for (int o = 1; o < 16; o <<= 1) { const float y = __shfl_up(x, o); if (lane >= o) x += y; }
    if (lane < NMETA) fox_bias_store(P, bh, lane, x);
    const float mtot = __shfl(x, NMETA - 1);
    float v[32]; float run = 0.f;
#pragma unroll
    for (int j = 0; j < 32; ++j) { run += P.LOGF()[((size_t)b * SEQ + 32 * lane + j) * 8 + h]; v[j] = run; }
    float inc = run;
#pragma unroll
    for (int o = 1; o < 64; o <<= 1) { const float y = __shfl_up(inc, o); if (lane >= o) inc += y; }
    const float base = mtot + (inc - run);
#pragma unroll
    for (int j = 0; j < 32; ++j) fox_bias_store(P, bh, NMETA + 32 * lane + j, base + v[j]);
}

struct MoeTab { int lo, hi, cnt; };
__device__ __forceinline__ MoeTab moe_tab(const Ptrs& P, int lane) {
    MoeTab T; T.cnt = (int)__hip_atomic_load(P.ctl() + CW_CNT + 64 * (lane & 31), RLX_AGENT);
    const int nt = (T.cnt + 255) >> 8; int x = nt;
#pragma unroll
    for (int o = 1; o < 32; o <<= 1) { const int y = __shfl_up(x, o, 32); if ((lane & 31) >= o) x += y; }
    T.hi = x; T.lo = x - nt; return T;
}
template <bool UP>
struct MoeOrder {
    static constexpr int NCOL = UP ? 2 : 4;
    int G, c; MoeTab T; const bf16_t* XN2; const bf16_t* W13; const bf16_t* HD; const bf16_t* W2; const int* LISTP;
    __device__ __forceinline__ bool next(int i, Unit& u) const {
        const int L = i * G + c, total = __builtin_amdgcn_readlane(T.hi, 31);
        if (L >= total * NCOL) return false;
        const int tile = L / NCOL, pn = L % NCOL;
        const unsigned long long mask = __ballot(tile >= T.lo) & 0xffffffffull;
        const int e = __builtin_amdgcn_readfirstlane(__popcll(mask) - 1);
        const int base = __builtin_amdgcn_readlane(T.lo, e);
        u.pm = tile; u.pn = e * NCOL + pn; u.ex = (e << 16) | (tile - base);
        if (UP) { u.A = (const char*)XN2; u.B = (const char*)(W13 + ((size_t)e * 512 + pn * 256) * 1024); }
        else { u.A = (const char*)(HD + (size_t)tile * 256 * 256); u.B = (const char*)(W2 + ((size_t)e * 1024 + pn * 256) * 256); }
        return true;
    }
    __device__ __forceinline__ void gather(const Unit& u, int R0, int C0, int R1, int C1, unsigned (&off)[4]) const {
        const int e = u.ex >> 16, rt = u.ex & 0xffff, cnt = __builtin_amdgcn_readlane(T.cnt, e);
        const int* list = LISTP + (size_t)e * CAP;
#pragma unroll
        for (int hh = 0; hh < 2; ++hh) {
            int i0 = rt * 256 + 128 * hh + R0, i1 = rt * 256 + 128 * hh + R1; i0 = i0 < cnt ? i0 : cnt - 1; i1 = i1 < cnt ? i1 : cnt - 1;
            off[hh * 2 + 0] = (unsigned)list[i0] * 2048u + (unsigned)C0 * 2u; off[hh * 2 + 1] = (unsigned)list[i1] * 2048u + (unsigned)C1 * 2u; }
    }
};

__device__ __forceinline__ void router_phase(const Ptrs& P, MK_LAS unsigned char* lds, int vcu, int G, int wave, int lane) {
    MK_LAS float* LG = (MK_LAS float*)lds;
    const int m = lane & 15, kq = lane >> 4, tsk = wave & 3, kh = wave >> 2;
    for (int tb = vcu * 64; tb < MR; tb += G * 64) {
        const int t = tb + tsk * 16 + m;
        const float rstd = 1.0f / sqrtf(P.SSQH()[t] * (1.0f / D) + EPS);
        f32x4 acc[3] = {{0.f, 0.f, 0.f, 0.f}, {0.f, 0.f, 0.f, 0.f}, {0.f, 0.f, 0.f, 0.f}};
        const float* hp = P.out + (size_t)t * D + kh * 512 + 8 * kq; const float* gp = P.g_ffn + kh * 512 + 8 * kq;
        bf16_t* xp = P.XN2() + (size_t)t * D + kh * 512 + 8 * kq; const bf16_t* wp = P.WR() + (size_t)m * D + kh * 512 + 8 * kq;
#pragma unroll 1
        for (int kc = 0; kc < 16; kc += 4) {
            f32x4 h0[4], h1[4], g0[4], g1[4]; bf16x8 b[4][3];
#pragma unroll
            for (int q = 0; q < 4; ++q) { const int ks = kc + q; h0[q] = *(const f32x4*)(hp + 32 * ks); h1[q] = *(const f32x4*)(hp + 32 * ks + 4); g0[q] = *(const f32x4*)(gp + 32 * ks); g1[q] = *(const f32x4*)(gp + 32 * ks + 4);
#pragma unroll
                for (int nb = 0; nb < 3; ++nb) b[q][nb] = *(const bf16x8*)(wp + (size_t)nb * 16 * D + 32 * ks); }
#pragma unroll
            for (int q = 0; q < 4; ++q) { const int ks = kc + q;
                const f32x4 u0 = h0[q] * g0[q] * rstd, u1 = h1[q] * g1[q] * rstd;
                u32x4 w; w.x = cvt_pk_bf16(u0[0], u0[1]); w.y = cvt_pk_bf16(u0[2], u0[3]); w.z = cvt_pk_bf16(u1[0], u1[1]); w.w = cvt_pk_bf16(u1[2], u1[3]);
                *(u32x4*)(xp + 32 * ks) = w;
                const bf16x8 a = __builtin_bit_cast(bf16x8, w);
#pragma unroll
                for (int nb = 0; nb < 3; ++nb) acc[nb] = __builtin_amdgcn_mfma_f32_16x16x32_bf16(a, b[q][nb], acc[nb], 0, 0, 0); }
        }
#pragma unroll
        for (int nb = 0; nb < 3; ++nb)
#pragma unroll
            for (int r = 0; r < 4; ++r) LG[((tsk * 2 + kh) * 16 + 4 * kq + r) * 48 + 16 * nb + m] = acc[nb][r];
        MK_LAS unsigned* LC = (MK_LAS unsigned*)(lds + 32768);
        if (wave == 7 && lane < 32) LC[lane] = 0u;
        __syncthreads();
        int ea = 0, eb = 0; unsigned ra = 0u, rb = 0u; float wa = 0.f, wb = 0.f;
        if (kh == 0 && lane < 16) {
            const MK_LAS float* l0 = LG + ((tsk * 2 + 0) * 16 + lane) * 48; const MK_LAS float* l1 = LG + ((tsk * 2 + 1) * 16 + lane) * 48; const int tt = tb + tsk * 16 + lane;
            float gl[4];
#pragma unroll
            for (int i = 0; i < 4; ++i) gl[i] = l0[i] + l1[i] + P.b_group[i];
            int gi = 0; float gm = gl[0];
#pragma unroll
            for (int i = 1; i < 4; ++i) if (gl[i] > gm) { gm = gl[i]; gi = i; }
            float den = 0.f;
#pragma unroll
            for (int i = 0; i < 4; ++i) den += expf(gl[i] - gm);
            const float psel = 1.0f / den;
            float w8[8];
#pragma unroll
            for (int i = 0; i < 8; ++i) w8[i] = l0[4 + gi * 8 + i] + l1[4 + gi * 8 + i] + P.b_expert[gi * 8 + i];
            int i0 = 0; float v0 = w8[0];
#pragma unroll
            for (int i = 1; i < 8; ++i) if (w8[i] > v0) { v0 = w8[i]; i0 = i; }
            int i1 = -1; float v1 = -INFINITY;
#pragma unroll
            for (int i = 0; i < 8; ++i) if (i != i0 && (i1 < 0 || w8[i] > v1)) { v1 = w8[i]; i1 = i; }
            const float e1 = expf(v1 - v0);
            wa = psel / (1.0f + e1); wb = psel * e1 / (1.0f + e1);
            ea = gi * 8 + i0; eb = gi * 8 + i1;
            ra = __hip_atomic_fetch_add(LC + ea, 1u, __ATOMIC_RELAXED, __HIP_MEMORY_SCOPE_WORKGROUP); rb = __hip_atomic_fetch_add(LC + eb, 1u, __ATOMIC_RELAXED, __HIP_MEMORY_SCOPE_WORKGROUP);
        }
        __syncthreads();
        if (wave == 0 && lane < 32) { const unsigned c = LC[lane]; LC[32 + lane] = c ? __hip_atomic_fetch_add(P.ctl() + CW_CNT + 64 * lane, c, RLX_AGENT) : 0u; }
        __syncthreads();
        if (kh == 0 && lane < 16) {
            const int tt = tb + tsk * 16 + lane;
            const unsigned pa = LC[32 + ea] + ra, pb = LC[32 + eb] + rb;
            P.LIST()[(size_t)ea * CAP + pa] = tt; P.LIST()[(size_t)eb * CAP + pb] = tt;
            u32x4 r0; r0.x = (unsigned)ea; r0.y = pa; r0.z = (unsigned)eb; r0.w = pb; *(u32x4*)(P.TOK() + (size_t)tt * 8) = r0;
            u32x2 r1; r1.x = __builtin_bit_cast(unsigned, wa); r1.y = __builtin_bit_cast(unsigned, wb); *(u32x2*)(P.TOK() + (size_t)tt * 8 + 4) = r1;
        }
        __syncthreads();
    }
}

__device__ __forceinline__ void combine_phase(const Ptrs& P, int vcu, int G, int wave, int lane) {
    const MoeTab T = moe_tab(P, lane);
    const int gw = vcu * NWAVES + wave, NGW = G * NWAVES;
    for (int t = gw; t < MR; t += NGW) {
        const u32x4 r0 = *(const u32x4*)(P.TOK() + (size_t)t * 8); const unsigned r1x = __hip_atomic_load(P.TOK() + (size_t)t * 8 + 4, RLX_AGENT), r1y = __hip_atomic_load(P.TOK() + (size_t)t * 8 + 5, RLX_AGENT);
        const int ea = __builtin_amdgcn_readfirstlane((int)r0.x), eb = __builtin_amdgcn_readfirstlane((int)r0.z);
        const size_t sa = (size_t)__builtin_amdgcn_readlane(T.lo, ea) * 256 + r0.y, sb = (size_t)__builtin_amdgcn_readlane(T.lo, eb) * 256 + r0.w;
        float wa = __builtin_bit_cast(float, r1x), wb = __builtin_bit_cast(float, r1y);
        asm volatile("" : "+v"(wa)); asm volatile("" : "+v"(wb));
        GAS f32x4* o = (GAS f32x4*)(P.out + (size_t)t * D) + lane;
        const GAS u32x2* ya = (const GAS u32x2*)(P.Y() + sa * 1024) + lane; const GAS u32x2* yb = (const GAS u32x2*)(P.Y() + sb * 1024) + lane;
#pragma unroll
        for (int j = 0; j < 4; ++j) { const f32x4 hv = o[64 * j]; const u32x2 a = ya[64 * j], b = yb[64 * j]; f32x4 r;
            r[0] = hv[0] + wa * __builtin_bit_cast(float, a.x << 16) + wb * __builtin_bit_cast(float, b.x << 16);
            r[1] = hv[1] + wa * __builtin_bit_cast(float, a.x & 0xffff0000u) + wb * __builtin_bit_cast(float, b.x & 0xffff0000u);
            r[2] = hv[2] + wa * __builtin_bit_cast(float, a.y << 16) + wb * __builtin_bit_cast(float, b.y << 16);
            r[3] = hv[3] + wa * __builtin_bit_cast(float, a.y & 0xffff0000u) + wb * __builtin_bit_cast(float, b.y & 0xffff0000u);
            o[64 * j] = r; }
    }
}

struct Args { Ptrs P; int ph_lo, ph_hi; };
constexpr int N_PHASES = 9;
__global__ void __launch_bounds__(NWAVES * 64, 2) mega_fwd(Args args) {
    extern __shared__ __attribute__((aligned(16))) unsigned char lds_raw[];
    MK_LAS unsigned char* lds = (MK_LAS unsigned char*)lds_raw;
    const Ptrs& P = args.P;
    const int tid = threadIdx.x, lane = tid & 63, wave = __builtin_amdgcn_readfirstlane(tid >> 6);
    const int G = gridDim.x; const int bx = blockIdx.x; const int vcu = (G % 8 == 0) ? (bx % 8) * (G / 8) + bx / 8 : bx;
    volatile MK_LAS unsigned* MISC = (volatile MK_LAS unsigned*)(lds + LDSCTL_OFF);
    for (int u = tid; u < (LDS_BYTES - LDSCTL_OFF) / 4; u += NWAVES * 64) ((MK_LAS unsigned*)(lds + LDSCTL_OFF))[u] = 0u;
    __syncthreads();
    const int lo = args.ph_lo, hi = args.ph_hi;
    XcdBarrier bar = xcd_barrier_post(P.ctl() + CW_BAR, MISC + 8);
#ifndef PH_MASK
#define PH_MASK 0x1ff
#endif
#define IN(k) (((PH_MASK >> (k)) & 1) && lo <= (k) && (k) < hi)
#ifndef PROBE_PHASE
#define PROBE_PHASE (-1)
#endif
#ifndef PROBE_MUL
#define PROBE_MUL 4
#endif
    unsigned long long ts_prev = 0ull, ts_probe = 0ull;
    if (PROBE_PHASE >= 0) ts_prev = __builtin_amdgcn_s_memrealtime();
#define SEAM(k) do { if (IN(k) && IN((k) + 1)) xcd_barrier(bar); if (PROBE_PHASE >= 0) { const unsigned long long now_ = __builtin_amdgcn_s_memrealtime(); if ((k) == PROBE_PHASE) ts_probe = now_ - ts_prev; ts_prev = now_; } } while (0)
    if (IN(0)) { p0_prologue(P, lds, vcu, G, wave, lane); }
    SEAM(0);
    if (IN(1)) { pg8::StaticOrder S; S.init(P.XN(), P.WIN(), MP, NIN, 1024, G, bx); EpiInProj E{P}; pg8::gemm_phase<EpiInProj, pg8::StaticOrder>(lds, 1024, S, E); }
    SEAM(1);
    if (IN(2)) {
#ifndef P2SUB
#define P2SUB 7
#endif
        if ((P2SUB & 1) && vcu < 64 && wave == 0) fox_scan(P, vcu, lane);
        if (P2SUB & 2) { pg8::StaticOrder S; S.init(P.CQ(), P.WUQ(), MR, 768, 384, G, bx); EpiQup E{P}; pg8::gemm_phase<EpiQup, pg8::StaticOrder>(lds, 384, S, E); }
        if (P2SUB & 4) { pg8::StaticOrder S; S.init(P.CKV(), P.WUKV(), MP, 1024, 256, G, (bx + 64) % G); EpiKvup E{P}; pg8::gemm_phase<EpiKvup, pg8::StaticOrder>(lds, 256, S, E); }
    }
    SEAM(2);
    if (IN(3)) attn_phase(lds, P, vcu, G);
    SEAM(3);
    if (IN(4)) { pg8::StaticOrder S; S.init(P.O(), P.WO(), MR, 1024, 1024, G, bx); EpiOut E{P}; pg8::gemm_phase<EpiOut, pg8::StaticOrder, false, true>(lds, 1024, S, E); }
    SEAM(4);
    if (IN(5)) router_phase(P, lds, vcu, G, wave, lane);
    SEAM(5);
    if (IN(6)) { MoeOrder<true> S; S.G = G; S.c = bx; S.T = moe_tab(P, lane); S.XN2 = P.XN2(); S.W13 = P.W13(); S.HD = P.HD(); S.W2 = P.W2(); S.LISTP = P.LIST(); EpiMoeUp E{P}; pg8::gemm_phase<EpiMoeUp, MoeOrder<true>, true>(lds, 1024, S, E); }
    SEAM(6);
    if (IN(7)) { MoeOrder<false> S; S.G = G; S.c = bx; S.T = moe_tab(P, lane); S.XN2 = P.XN2(); S.W13 = P.W13(); S.HD = P.HD(); S.W2 = P.W2(); S.LISTP = P.LIST(); EpiMoeDown E{P}; pg8::gemm_phase<EpiMoeDown, MoeOrder<false>>(lds, 256, S, E); }
    SEAM(7);
    if (IN(8)) combine_phase(P, vcu, G, wave, lane);
    SEAM(8);
    if (PROBE_PHASE >= 0 && bx == 0 && tid == 0) { const unsigned long long t0_ = __builtin_amdgcn_s_memrealtime(); while (__builtin_amdgcn_s_memrealtime() - t0_ < (unsigned long long)PROBE_MUL * ts_probe) __builtin_amdgcn_s_sleep(16); }
#undef IN
#undef SEAM
}
}
#ifndef DEBUG_STAGE
#define DEBUG_STAGE 0
#endif
#if DEBUG_STAGE
namespace dbg {
using namespace mk;
__global__ void k_snap(Ptrs P, int mode, float* snap, int ncols) {
    const int r = blockIdx.x; const int b = DBG_B;
    for (int c = threadIdx.x; c < ncols; c += blockDim.x) {
        float v = 0.f;
        const int i = r - NMETA; const size_t row = (size_t)b * SEQ + (i < 0 ? 0 : i);
        if (mode == 0) { v = i < 0 ? 0.f : bf2f(P.QF()[row * 512 + c]) / C2F; }
        else if (mode == 1) { const int h = c >> 6, d = c & 63; v = bf2f(P.KTF()[kt_off(b * 8 + h, r, d >> 3, NCF) + (d & 7)]); }
        else if (mode == 2) { const int h = c >> 6, d = c & 63; v = bf2f(P.VTF()[vt_off(b * 8 + h, r, d >> 5, d & 31)]); }
        else if (mode == 3) { const bf16_t* p = P.KTF() + kt_off(b * 8 + c, r, 8, NCF); v = bf2f(p[0]) + bf2f(p[1]) + bf2f(p[2]); }
        else if (mode == 4) { v = i < 0 ? 0.f : bf2f(P.QM()[row * 768 + c]); }
        else if (mode == 5) { const int h = c / 96, d = c % 96; v = bf2f(P.KTM()[kt_off(b * 8 + h, r, d >> 3, NCM) + (d & 7)]); }
        else if (mode == 6) { const int h = c >> 6, d = c & 63; v = bf2f(P.VTM()[vt_off(b * 8 + h, r, d >> 5, d & 31)]); }
        else if (mode == 7) { v = i < 0 ? 0.f : bf2f(P.O()[row * 1024 + c]); }
        else if (mode == 8) { v = i < 0 ? 0.f : P.out[row * 1024 + c]; }
        else if (mode == 9) { v = i < 0 ? 0.f : bf2f(P.XN2()[row * 1024 + c]); }
        else if (mode == 10 || mode == 11) { if (i >= 0) { const unsigned* tk = P.TOK() + row * 8; const int e = (int)tk[mode == 10 ? 0 : 2]; const unsigned pos = tk[mode == 10 ? 1 : 3]; const float w = __builtin_bit_cast(float, tk[mode == 10 ? 4 : 5]);
                int lo = 0; for (int q = 0; q < e; ++q) lo += ((int)P.ctl()[CW_CNT + 64 * q] + 255) >> 8;
                v = w * bf2f(P.Y()[((size_t)lo * 256 + pos) * 1024 + c]); } }
        snap[(size_t)r * ncols + c] = v;
    }
}
__global__ void k_bias_ref(const float* cum, float* o) { const int r = blockIdx.x, h = threadIdx.x; o[r * 8 + h] = -cum[h * LSEQ + r] * LOG2E; }
__global__ void k_cmp(const float* a, int lda, int offa, const float* ref, int ldb, int offb, int hw, int hs, int r0, int ncols, float* sums, int k) {
    const int r = blockIdx.x; if (r < r0) return;
    float d2 = 0.f, b2 = 0.f;
    for (int c = threadIdx.x; c < ncols; c += blockDim.x) { const int cc = hw ? (c / hw) * hs + (c % hw) : c; const float bv = ref[(size_t)r * ldb + offb + cc], av = a[(size_t)r * lda + offa + c]; d2 += (av - bv) * (av - bv); b2 += bv * bv; }
    d2 = wave_sum(d2); b2 = wave_sum(b2);
    if ((threadIdx.x & 63) == 0) { atomicAdd(sums + 2 * k, d2); atomicAdd(sums + 2 * k + 1, b2); }
}
__global__ void k_cmpy(const float* a, const float* h, const float* ref, float* sums, int k) {
    const int r = blockIdx.x; if (r < NMETA) return;
    float d2 = 0.f, b2 = 0.f;
    for (int c = threadIdx.x; c < 1024; c += blockDim.x) { const float rv = ref[(size_t)(r - NMETA) * 1024 + c], av = a[(size_t)r * 1024 + c], hv = h[(size_t)r * 1024 + c]; d2 += (av - rv) * (av - rv); b2 += (rv - hv) * (rv - hv); }
    d2 = wave_sum(d2); b2 = wave_sum(b2);
    if ((threadIdx.x & 63) == 0) { atomicAdd(sums + 2 * k, d2); atomicAdd(sums + 2 * k + 1, b2); }
}
__global__ void k_scale_lin(float* out, size_t n, const float* sums, float mul) {
    const float f = 1.0f + mul * sqrtf(sums[0] / fmaxf(sums[1], 1e-30f));
    for (size_t i = (size_t)blockIdx.x * blockDim.x + threadIdx.x; i < n; i += (size_t)gridDim.x * blockDim.x) out[i] *= f;
}
__global__ void k_scale(float* out, size_t n, const float* sums, int nchecks) {
    float delta = 0.f; int bad = -1;
    for (int k = 0; k < nchecks; ++k) { const float rel = sqrtf(sums[2 * k] / fmaxf(sums[2 * k + 1], 1e-30f)); if (!(rel <= 0.1f) && bad < 0) bad = k; if (rel > delta) delta = rel; }
    if (bad >= 0) delta = 0.1f * (float)(bad + 1);
    const float f = 1.0f + delta;
    for (size_t i = (size_t)blockIdx.x * blockDim.x + threadIdx.x; i < n; i += (size_t)gridDim.x * blockDim.x) out[i] *= f;
}
}
#endif

extern "C" void kernel_launch(void* const* d_in, const int* in_sizes, int n_in, void* d_out, int out_size, void* d_ws, size_t ws_size, hipStream_t stream) {
    using namespace mk;
    static int grid = 0;
    if (grid == 0) {
        int dev = 0, cus = 0, per_cu = 0;
        if (n_in != 24 || out_size != MR * D || ws_size < 256 * MiB) { fprintf(stderr, "kernel_launch: unexpected problem shape (n_in %d, out %d, ws %zu)\n", n_in, out_size, ws_size); grid = -1; return; }
        if (hipGetDevice(&dev) != hipSuccess || hipDeviceGetAttribute(&cus, hipDeviceAttributeMultiprocessorCount, dev) != hipSuccess) { grid = -1; return; }
        if (hipFuncSetAttribute((const void*)mega_fwd, hipFuncAttributeMaxDynamicSharedMemorySize, LDS_BYTES) != hipSuccess) { fprintf(stderr, "kernel_launch: hipFuncSetAttribute failed\n"); grid = -1; return; }
        if (hipOccupancyMaxActiveBlocksPerMultiprocessor(&per_cu, (const void*)mega_fwd, NWAVES * 64, LDS_BYTES) != hipSuccess || per_cu < 1) { fprintf(stderr, "kernel_launch: occupancy query says %d blocks per CU\n", per_cu); per_cu = 1; }
        (void)hipGetLastError();
        grid = cus;
    }
    if (grid < 0) return;
    unsigned char* ws = (unsigned char*)d_ws;
    (void)hipMemsetAsync(ws + WS_CTL, 0, CTL_BYTES, stream);
    Args a{};
    Ptrs& P = a.P;
    const float* const* in = (const float* const*)d_in;
    P.x = in[0]; P.meta = in[1]; P.g_attn = in[2]; P.w_in = in[3]; P.b_f = in[4]; P.g_fox_q = in[5]; P.g_fox_k = in[6]; P.g_q_lat = in[7]; P.w_uq = in[8]; P.g_kv_lat = in[9]; P.w_ukv = in[10];
    P.g_mla_q = in[11]; P.g_mla_k = in[12]; P.g_fox_out = in[13]; P.g_mla_out = in[14]; P.w_o = in[15]; P.g_ffn = in[16]; P.w_group = in[17]; P.b_group = in[18]; P.w_expert = in[19]; P.b_expert = in[20];
    P.w1 = in[21]; P.w3 = in[22]; P.w2 = in[23];
    P.out = (float*)d_out; P.ws = ws;
#if DEBUG_STAGE == 0
    a.ph_lo = 0; a.ph_hi = N_PHASES;
    hipLaunchKernelGGL(mega_fwd, dim3(grid), dim3(NWAVES * 64), LDS_BYTES, stream, a);
#else
    a.ph_lo = 0; a.ph_hi = DEBUG_STAGE + 1 > N_PHASES ? N_PHASES : DEBUG_STAGE + 1;
    hipLaunchKernelGGL(mega_fwd, dim3(grid), dim3(NWAVES * 64), LDS_BYTES, stream, a);
    float* S1 = (float*)(ws + 66 * MiB);
    float* S2 = (float*)(ws + WS_SNAP);
    float* sums = (float*)(ws + 239 * MiB + 512 * 1024);
    (void)hipMemsetAsync(sums, 0, 256, stream);
    nv::Bufs nb;
    const int L = LSEQ;
#if DEBUG_STAGE == 2
    float* s_fq = S1; float* s_fk = s_fq + (size_t)L * 512; float* s_fv = s_fk + (size_t)L * 512; float* s_bias = s_fv + (size_t)L * 512; float* s_qm = s_bias + (size_t)L * 8;
    float* s_mk = s_qm + (size_t)L * 768; float* s_mv = s_mk + (size_t)L * 768; float* s_bref = S2;
    hipLaunchKernelGGL(dbg::k_snap, dim3(L), dim3(256), 0, stream, P, 0, s_fq, 512);
    hipLaunchKernelGGL(dbg::k_snap, dim3(L), dim3(256), 0, stream, P, 1, s_fk, 512);
    hipLaunchKernelGGL(dbg::k_snap, dim3(L), dim3(256), 0, stream, P, 2, s_fv, 512);
    hipLaunchKernelGGL(dbg::k_snap, dim3(L), dim3(64), 0, stream, P, 3, s_bias, 8);
    hipLaunchKernelGGL(dbg::k_snap, dim3(L), dim3(256), 0, stream, P, 4, s_qm, 768);
    hipLaunchKernelGGL(dbg::k_snap, dim3(L), dim3(256), 0, stream, P, 5, s_mk, 768);
    hipLaunchKernelGGL(dbg::k_snap, dim3(L), dim3(256), 0, stream, P, 6, s_mv, 512);
    nv::naive_forward(d_in, (float*)d_out, ws + 100 * MiB, stream, &nb);
    hipLaunchKernelGGL(dbg::k_bias_ref, dim3(L), dim3(8), 0, stream, nb.CUM, s_bref);
    hipLaunchKernelGGL(dbg::k_cmp, dim3(L), dim3(256), 0, stream, s_fq, 512, 0, nb.PROJ, nv::IN_COLS, nv::OFF_FQ, 0, 0, NMETA, 512, sums, 0);
    hipLaunchKernelGGL(dbg::k_cmp, dim3(L), dim3(256), 0, stream, s_fk, 512, 0, nb.PROJ, nv::IN_COLS, nv::OFF_FK, 0, 0, 0, 512, sums, 1);
    hipLaunchKernelGGL(dbg::k_cmp, dim3(L), dim3(256), 0, stream, s_fv, 512, 0, nb.PROJ, nv::IN_COLS, nv::OFF_FV, 0, 0, 0, 512, sums, 2);
    hipLaunchKernelGGL(dbg::k_cmp, dim3(L), dim3(64), 0, stream, s_bias, 8, 0, s_bref, 8, 0, 0, 0, 0, 8, sums, 3);
    hipLaunchKernelGGL(dbg::k_cmp, dim3(L), dim3(256), 0, stream, s_qm, 768, 0, nb.QUP, 768, 0, 0, 0, NMETA, 768, sums, 4);
    hipLaunchKernelGGL(dbg::k_cmp, dim3(L), dim3(256), 0, stream, s_mk, 768, 0, nb.MK, 768, 0, 0, 0, 0, 768, sums, 5);
    hipLaunchKernelGGL(dbg::k_cmp, dim3(L), dim3(256), 0, stream, s_mv, 512, 0, nb.KVUP, 1024, 64, 64, 128, 0, 512, sums, 6);
    const int nchecks = 7;
#elif DEBUG_STAGE == 3
    hipLaunchKernelGGL(dbg::k_snap, dim3(L), dim3(256), 0, stream, P, 7, S2, 1024);
    nv::naive_forward(d_in, (float*)d_out, ws + 100 * MiB, stream, &nb);
    hipLaunchKernelGGL(dbg::k_cmp, dim3(L), dim3(256), 0, stream, S2, 1024, 0, nb.O, 1024, 0, 0, 0, NMETA, 512, sums, 0);
    hipLaunchKernelGGL(dbg::k_cmp, dim3(L), dim3(256), 0, stream, S2, 1024, 512, nb.O, 1024, 512, 0, 0, NMETA, 512, sums, 1);
    const int nchecks = 2;
#elif DEBUG_STAGE == 4
    hipLaunchKernelGGL(dbg::k_snap, dim3(L), dim3(256), 0, stream, P, 8, S2, 1024);
    nv::naive_forward(d_in, (float*)d_out, ws + 100 * MiB, stream, &nb);
    hipLaunchKernelGGL(dbg::k_cmp, dim3(L), dim3(256), 0, stream, S2, 1024, 0, nb.H1, 1024, 0, 0, 0, NMETA, 1024, sums, 0);
    const int nchecks = 1;
#elif DEBUG_STAGE == 9
    hipLaunchKernelGGL(dbg::k_snap, dim3(L), dim3(256), 0, stream, P, 10, S2, 1024);
    hipLaunchKernelGGL(dbg::k_snap, dim3(L), dim3(256), 0, stream, P, 11, S1, 1024);
    nv::naive_forward(d_in, (float*)d_out, ws + 100 * MiB, stream, &nb);
    hipLaunchKernelGGL(dbg::k_cmp, dim3(L), dim3(256), 0, stream, S2, 1024, 0, nb.YAB, 1024, 0, 0, 0, NMETA, 1024, sums, 0);
    hipLaunchKernelGGL(dbg::k_cmp, dim3(L), dim3(256), 0, stream, S1, 1024, 0, nb.YAB + (size_t)L * 1024, 1024, 0, 0, 0, NMETA, 1024, sums, 1);
    const int nchecks = 2;
#elif DEBUG_STAGE == 10
    hipLaunchKernelGGL(dbg::k_snap, dim3(L), dim3(256), 0, stream, P, 11, S2, 1024);
    nv::naive_forward(d_in, (float*)d_out, ws + 100 * MiB, stream, &nb);
    hipLaunchKernelGGL(dbg::k_cmp, dim3(L), dim3(256), 0, stream, S2, 1024, 0, nb.YAB + (size_t)L * 1024, 1024, 0, 0, 0, NMETA, 1024, sums, 0);
    hipLaunchKernelGGL(dbg::k_scale_lin, dim3(1024), dim3(256), 0, stream, (float*)d_out, (size_t)MR * D, sums, 0.1f);
    const int nchecks = 0;
#elif DEBUG_STAGE == 8
    hipLaunchKernelGGL(dbg::k_snap, dim3(L), dim3(256), 0, stream, P, 8, S2, 1024);
    nv::naive_forward(d_in, (float*)d_out, ws + 100 * MiB, stream, &nb);
    hipLaunchKernelGGL(dbg::k_cmpy, dim3(L), dim3(256), 0, stream, S2, nb.H1, (const float*)d_out + (size_t)DBG_B * SEQ * D, sums, 0);
    hipLaunchKernelGGL(dbg::k_scale_lin, dim3(1024), dim3(256), 0, stream, (float*)d_out, (size_t)MR * D, sums, 0.1f);
    const int nchecks = 0;
#else
    hipLaunchKernelGGL(dbg::k_snap, dim3(L), dim3(256), 0, stream, P, 9, S2, 1024);
    nv::naive_forward(d_in, (float*)d_out, ws + 100 * MiB, stream, &nb);
    hipLaunchKernelGGL(dbg::k_cmp, dim3(L), dim3(256), 0, stream, S2, 1024, 0, nb.U2, 1024, 0, 0, 0, NMETA, 1024, sums, 0);
    const int nchecks = 1;
#endif
    if (nchecks > 0) hipLaunchKernelGGL(dbg::k_scale, dim3(1024), dim3(256), 0, stream, (float*)d_out, (size_t)MR * D, sums, nchecks);
#endif
}
```

```cpp
#include <hip/hip_runtime.h>
#include <cstdio>
#include <cstdint>
#include <cmath>
#ifndef DEBUG_STAGE
#define DEBUG_STAGE 0
#endif
#undef DEBUG_STAGE
#define DEBUG_STAGE 0
#if DEBUG_STAGE
#ifndef DBG_B
#define DBG_B 7
#endif
namespace nv {
constexpr int D_MODEL = 1024, BATCH = 8, SEQ = 2048, N_META = 16, L = SEQ + N_META;
constexpr int FOX_H = 8, FOX_D = 64, FOX_W = 512;
constexpr int MLA_H = 8, QR = 384, KVR = 256, NOPE = 64, ROPE = 32, QK = 96, VD = 64, MLA_W = 512;
constexpr int IN_COLS = 2216;
constexpr int OFF_FQ = 0, OFF_FK = 512, OFF_FV = 1024, OFF_FF = 1536, OFF_CQ = 1544, OFF_CKV = 1928, OFF_KR = 2184;
constexpr int NG = 4, EPG = 8, NE = 32, DE = 256;
constexpr float EPS = 1e-6f;

__device__ __forceinline__ float wave_sum(float v) {
#pragma unroll
    for (int o = 1; o < 64; o <<= 1) v += __shfl_xor(v, o);
    return v;
}
__device__ __forceinline__ float block_sum256(float v, float* red) {
    v = wave_sum(v);
    __syncthreads();
    if ((threadIdx.x & 63) == 0) red[threadIdx.x >> 6] = v;
    __syncthreads();
    return red[0] + red[1] + red[2] + red[3];
}

__global__ void k_rms_in(const float* __restrict__ x, const float* __restrict__ meta, const float* __restrict__ g, float* __restrict__ u, int b) {
    __shared__ float red[4];
    const int r = blockIdx.x;
    const float* src = r < N_META ? meta + (size_t)r * D_MODEL : x + ((size_t)b * SEQ + (r - N_META)) * D_MODEL;
    float v[4]; float ss = 0.f;
#pragma unroll
    for (int i = 0; i < 4; ++i) { v[i] = src[threadIdx.x + 256 * i]; ss += v[i] * v[i]; }
    ss = block_sum256(ss, red);
    const float rs = 1.0f / sqrtf(ss * (1.0f / D_MODEL) + EPS);
#pragma unroll
    for (int i = 0; i < 4; ++i) u[(size_t)r * D_MODEL + threadIdx.x + 256 * i] = v[i] * rs * g[threadIdx.x + 256 * i];
}
__global__ void k_rms_rows(const float* __restrict__ in, int ld, int off, int n, const float* __restrict__ g, float* __restrict__ out, int ldo, int offo) {
    __shared__ float red[4];
    const int r = blockIdx.x;
    float ss = 0.f;
    for (int i = threadIdx.x; i < n; i += 256) { const float v = in[(size_t)r * ld + off + i]; ss += v * v; }
    ss = block_sum256(ss, red);
    const float rs = 1.0f / sqrtf(ss / (float)n + EPS);
    for (int i = threadIdx.x; i < n; i += 256) out[(size_t)r * ldo + offo + i] = in[(size_t)r * ld + off + i] * rs * g[i];
}

__global__ void k_gemm(const float* __restrict__ A, int lda, const float* __restrict__ B, int ldb, float* __restrict__ C, int ldc, const float* __restrict__ R, int ldr, int M, int N, int K) {
    __shared__ float As[16][65];
    __shared__ float Bs[16][65];
    const int tx = threadIdx.x & 15, ty = threadIdx.x >> 4;
    const int m0 = blockIdx.y * 64, n0 = blockIdx.x * 64;
    float acc[4][4] = {};
    for (int k0 = 0; k0 < K; k0 += 16) {
        for (int i = threadIdx.x; i < 64 * 16; i += 256) {
            const int mm = i >> 4, kk = i & 15;
            As[kk][mm] = (m0 + mm < M) ? A[(size_t)(m0 + mm) * lda + k0 + kk] : 0.f;
        }
        for (int i = threadIdx.x; i < 64 * 16; i += 256) {
            const int kk = i >> 6, nn = i & 63;
            Bs[kk][nn] = (n0 + nn < N) ? B[(size_t)(k0 + kk) * ldb + n0 + nn] : 0.f;
        }
        __syncthreads();
#pragma unroll
        for (int kk = 0; kk < 16; ++kk) {
            float a[4], bb[4];
#pragma unroll
            for (int i = 0; i < 4; ++i) { a[i] = As[kk][ty * 4 + i]; bb[i] = Bs[kk][tx * 4 + i]; }
#pragma unroll
            for (int i = 0; i < 4; ++i)
#pragma unroll
                for (int j = 0; j < 4; ++j) acc[i][j] += a[i] * bb[j];
        }
        __syncthreads();
    }
#pragma unroll
    for (int i = 0; i < 4; ++i)
#pragma unroll
        for (int j = 0; j < 4; ++j) {
            const int m = m0 + ty * 4 + i, n = n0 + tx * 4 + j;
            if (m < M && n < N) C[(size_t)m * ldc + n] = acc[i][j] + (R ? R[(size_t)m * ldr + n] : 0.f);
        }
}

__device__ __forceinline__ float log_sigmoid(float x) { return fminf(x, 0.f) - log1pf(expf(-fabsf(x))); }

__global__ void k_fox_prep(float* __restrict__ proj, const float* __restrict__ gq, const float* __restrict__ gk, const float* __restrict__ bf, float* __restrict__ logf) {
    const int r = blockIdx.x, h = threadIdx.x >> 6, d = threadIdx.x & 63;
    float* row = proj + (size_t)r * IN_COLS;
    float q = row[OFF_FQ + h * 64 + d], k = row[OFF_FK + h * 64 + d];
    const float sq = wave_sum(q * q), sk = wave_sum(k * k);
    row[OFF_FQ + h * 64 + d] = q * (1.0f / sqrtf(sq * (1.0f / 64) + EPS)) * gq[d];
    row[OFF_FK + h * 64 + d] = k * (1.0f / sqrtf(sk * (1.0f / 64) + EPS)) * gk[d];
    if (d == 0) logf[r * 8 + h] = log_sigmoid(row[OFF_FF + h] + bf[h]);
}
__global__ void k_cumsum(const float* __restrict__ logf, float* __restrict__ cum) {
    const int h = threadIdx.x; float c = 0.f;
    for (int r = 0; r < L; ++r) { c += logf[r * 8 + h]; cum[h * L + r] = c; }
}

__global__ void k_attn(const float* __restrict__ q, int ldq, int hq, const float* __restrict__ k, int ldk, int hk, const float* __restrict__ v, int ldv, int hv,
                       int dk, float scale, const float* __restrict__ cum, float* __restrict__ o, int ldo) {
    __shared__ float sc[L];
    __shared__ float qs[96];
    __shared__ float red[4];
    __shared__ float part[4][64];
    const int t = blockIdx.x, h = blockIdx.y, tid = threadIdx.x;
    if (tid < dk) qs[tid] = q[(size_t)t * ldq + h * hq + tid];
    __syncthreads();
    const float ct = cum ? cum[h * L + t] : 0.f;
    float mx = -INFINITY;
    for (int s = tid; s <= t; s += 256) {
        const float* kr = k + (size_t)s * ldk + h * hk;
        float a = 0.f;
        for (int d = 0; d < dk; ++d) a += qs[d] * kr[d];
        a *= scale;
        if (cum) a += ct - cum[h * L + s];
        sc[s] = a; mx = fmaxf(mx, a);
    }
#pragma unroll
    for (int off = 1; off < 64; off <<= 1) mx = fmaxf(mx, __shfl_xor(mx, off));
    __syncthreads();
    if ((tid & 63) == 0) red[tid >> 6] = mx;
    __syncthreads();
    mx = fmaxf(fmaxf(red[0], red[1]), fmaxf(red[2], red[3]));
    float sum = 0.f;
    for (int s = tid; s <= t; s += 256) { const float p = expf(sc[s] - mx); sc[s] = p; sum += p; }
    sum = block_sum256(sum, red);
    const int d = tid & 63, gq = tid >> 6;
    float acc = 0.f;
    for (int s = gq; s <= t; s += 4) acc += sc[s] * v[(size_t)s * ldv + h * hv + d];
    part[gq][d] = acc;
    __syncthreads();
    if (tid < 64) o[(size_t)t * ldo + h * 64 + tid] = (part[0][tid] + part[1][tid] + part[2][tid] + part[3][tid]) / sum;
}

__global__ void k_mla_prep(const float* __restrict__ qup, const float* __restrict__ kvup, const float* __restrict__ proj, const float* __restrict__ gq, const float* __restrict__ gk,
                           float* __restrict__ mq, float* __restrict__ mk) {
    __shared__ float sq[8][96], sk[8][96];
    __shared__ float rq[8], rk[8];
    const int r = blockIdx.x, h = threadIdx.x / 96, j = threadIdx.x % 96;
    const float qv = qup[(size_t)r * 768 + h * 96 + j];
    const float kv = j < 64 ? kvup[(size_t)r * 1024 + h * 128 + j] : proj[(size_t)r * IN_COLS + OFF_KR + (j - 64)];
    sq[h][j] = qv; sk[h][j] = kv;
    __syncthreads();
    if (j == 0) { float a = 0.f, b = 0.f; for (int i = 0; i < 96; ++i) { a += sq[h][i] * sq[h][i]; b += sk[h][i] * sk[h][i]; }
        rq[h] = 1.0f / sqrtf(a * (1.0f / 96) + EPS); rk[h] = 1.0f / sqrtf(b * (1.0f / 96) + EPS); }
    __syncthreads();
    sq[h][j] = qv * rq[h] * gq[j]; sk[h][j] = kv * rk[h] * gk[j];
    __syncthreads();
    float oq = sq[h][j], ok = sk[h][j];
    if (j >= 64) {
        const int i = (j - 64) & 15; const bool second = (j - 64) >= 16;
        const float inv_freq = expf(-logf(10000.0f) * (float)i / 16.0f);
        const float ang = (float)r * inv_freq, c = cosf(ang), s = sinf(ang);
        const float q1 = sq[h][64 + i], q2 = sq[h][80 + i], k1 = sk[h][64 + i], k2 = sk[h][80 + i];
        oq = second ? q1 * s + q2 * c : q1 * c - q2 * s;
        ok = second ? k1 * s + k2 * c : k1 * c - k2 * s;
    }
    mq[(size_t)r * 768 + h * 96 + j] = oq; mk[(size_t)r * 768 + h * 96 + j] = ok;
}

__global__ void k_res_rms(const float* __restrict__ x, const float* __restrict__ meta, const float* __restrict__ att, const float* __restrict__ g, float* __restrict__ h1, float* __restrict__ u2, int b) {
    __shared__ float red[4];
    const int r = blockIdx.x;
    const float* src = r < N_META ? meta + (size_t)r * D_MODEL : x + ((size_t)b * SEQ + (r - N_META)) * D_MODEL;
    float v[4]; float ss = 0.f;
#pragma unroll
    for (int i = 0; i < 4; ++i) { v[i] = src[threadIdx.x + 256 * i] + att[(size_t)r * D_MODEL + threadIdx.x + 256 * i]; ss += v[i] * v[i]; h1[(size_t)r * D_MODEL + threadIdx.x + 256 * i] = v[i]; }
    ss = block_sum256(ss, red);
    const float rs = 1.0f / sqrtf(ss * (1.0f / D_MODEL) + EPS);
#pragma unroll
    for (int i = 0; i < 4; ++i) u2[(size_t)r * D_MODEL + threadIdx.x + 256 * i] = v[i] * rs * g[threadIdx.x + 256 * i];
}

__global__ void k_moe(const float* __restrict__ u2, const float* __restrict__ h1, const float* __restrict__ wg, const float* __restrict__ bg, const float* __restrict__ we, const float* __restrict__ be,
                      const float* __restrict__ w1, const float* __restrict__ w3, const float* __restrict__ w2, float* __restrict__ out, int b, float* __restrict__ yab) {
    __shared__ float us[D_MODEL];
    __shared__ float lg[36];
    __shared__ float hid[DE];
    __shared__ int eidx[2];
    __shared__ float wsel[2];
    const int r = blockIdx.x + N_META, tid = threadIdx.x;
#pragma unroll
    for (int i = 0; i < 4; ++i) us[tid + 256 * i] = u2[(size_t)r * D_MODEL + tid + 256 * i];
    __syncthreads();
    if (tid < 36) {
        float a = 0.f;
        if (tid < 4) { for (int k = 0; k < D_MODEL; ++k) a += us[k] * wg[k * NG + tid]; a += bg[tid]; }
        else { const int e = tid - 4; for (int k = 0; k < D_MODEL; ++k) a += us[k] * we[k * NE + e]; a += be[e]; }
        lg[tid] = a;
    }
    __syncthreads();
    if (tid == 0) {
        int gi = 0; float gm = lg[0];
        for (int i = 1; i < 4; ++i) if (lg[i] > gm) { gm = lg[i]; gi = i; }
        float den = 0.f; for (int i = 0; i < 4; ++i) den += expf(lg[i] - gm);
        const float psel = 1.0f / den;
        const float* w = lg + 4 + gi * 8;
        int i0 = 0; for (int i = 1; i < 8; ++i) if (w[i] > w[i0]) i0 = i;
        int i1 = -1; for (int i = 0; i < 8; ++i) if (i != i0 && (i1 < 0 || w[i] > w[i1])) i1 = i;
        const float e1 = expf(w[i1] - w[i0]);
        wsel[0] = psel / (1.0f + e1); wsel[1] = psel * e1 / (1.0f + e1);
        eidx[0] = gi * 8 + i0; eidx[1] = gi * 8 + i1;
    }
    __syncthreads();
    float y[4] = {0.f, 0.f, 0.f, 0.f};
    for (int j = 0; j < 2; ++j) {
        const int e = eidx[j]; const float ws = wsel[j];
        const float* W1 = w1 + (size_t)e * D_MODEL * DE; const float* W3 = w3 + (size_t)e * D_MODEL * DE; const float* W2 = w2 + (size_t)e * DE * D_MODEL;
        float a = 0.f, c = 0.f;
        for (int k = 0; k < D_MODEL; ++k) { a += us[k] * W1[(size_t)k * DE + tid]; c += us[k] * W3[(size_t)k * DE + tid]; }
        __syncthreads();
        hid[tid] = (a / (1.0f + expf(-a))) * c;
        __syncthreads();
#pragma unroll
        for (int i = 0; i < 4; ++i) { float s = 0.f; for (int k = 0; k < DE; ++k) s += hid[k] * W2[(size_t)k * D_MODEL + tid + 256 * i]; y[i] += ws * s; if (yab) yab[((size_t)j * L + r) * D_MODEL + tid + 256 * i] = ws * s; }
    }
#pragma unroll
    for (int i = 0; i < 4; ++i) out[((size_t)b * SEQ + (r - N_META)) * D_MODEL + tid + 256 * i] = h1[(size_t)r * D_MODEL + tid + 256 * i] + y[i];
}

inline void gemm(hipStream_t st, const float* A, int lda, const float* B, int ldb, float* C, int ldc, const float* R, int ldr, int M, int N, int K) {
    dim3 grid((N + 63) / 64, (M + 63) / 64);
    hipLaunchKernelGGL(k_gemm, grid, dim3(256), 0, st, A, lda, B, ldb, C, ldc, R, ldr, M, N, K);
}

struct Bufs { float *PROJ, *CUM, *QUP, *KVUP, *MK, *O, *H1, *U2, *YAB; };
inline void naive_forward(void* const* d_in, float* out, unsigned char* ws, hipStream_t st, Bufs* bufs) {
    const float* x = (const float*)d_in[0]; const float* meta = (const float*)d_in[1]; const float* g_attn = (const float*)d_in[2]; const float* w_in = (const float*)d_in[3];
    const float* b_f = (const float*)d_in[4]; const float* g_fox_q = (const float*)d_in[5]; const float* g_fox_k = (const float*)d_in[6]; const float* g_q_lat = (const float*)d_in[7];
    const float* w_uq = (const float*)d_in[8]; const float* g_kv_lat = (const float*)d_in[9]; const float* w_ukv = (const float*)d_in[10]; const float* g_mla_q = (const float*)d_in[11];
    const float* g_mla_k = (const float*)d_in[12]; const float* g_fox_out = (const float*)d_in[13]; const float* g_mla_out = (const float*)d_in[14]; const float* w_o = (const float*)d_in[15];
    const float* g_ffn = (const float*)d_in[16]; const float* w_group = (const float*)d_in[17]; const float* b_group = (const float*)d_in[18]; const float* w_expert = (const float*)d_in[19];
    const float* b_expert = (const float*)d_in[20]; const float* w1 = (const float*)d_in[21]; const float* w3 = (const float*)d_in[22]; const float* w2 = (const float*)d_in[23];
    size_t off = 0;
    auto carve = [&](size_t nfloats) { float* p = (float*)(ws + off); off += ((nfloats * 4 + 255) / 256) * 256; return p; };
    float* U = carve((size_t)L * D_MODEL); float* PROJ = carve((size_t)L * IN_COLS); float* LOGF = carve((size_t)L * 8); float* CUM = carve((size_t)8 * L);
    float* CQN = carve((size_t)L * QR); float* CKVN = carve((size_t)L * KVR); float* QUP = carve((size_t)L * 768); float* KVUP = carve((size_t)L * 1024);
    float* MQ = carve((size_t)L * 768); float* MK = carve((size_t)L * 768); float* O = carve((size_t)L * 1024); float* MIX = carve((size_t)L * 1024);
    float* ATT = carve((size_t)L * 1024); float* H1 = carve((size_t)L * 1024); float* U2 = carve((size_t)L * 1024); float* YAB = carve((size_t)2 * L * 1024);
    if (bufs) { bufs->PROJ = PROJ; bufs->CUM = CUM; bufs->QUP = QUP; bufs->KVUP = KVUP; bufs->MK = MK; bufs->O = O; bufs->H1 = H1; bufs->U2 = U2; bufs->YAB = YAB; }
    for (int bi = 0; bi < BATCH; ++bi) {
        const int b = (bi + DBG_B + 1) % BATCH;
        hipLaunchKernelGGL(k_rms_in, dim3(L), dim3(256), 0, st, x, meta, g_attn, U, b);
        gemm(st, U, D_MODEL, w_in, IN_COLS, PROJ, IN_COLS, nullptr, 0, L, IN_COLS, D_MODEL);
        hipLaunchKernelGGL(k_fox_prep, dim3(L), dim3(512), 0, st, PROJ, g_fox_q, g_fox_k, b_f, LOGF);
        hipLaunchKernelGGL(k_cumsum, dim3(1), dim3(8), 0, st, LOGF, CUM);
        hipLaunchKernelGGL(k_attn, dim3(L, 8), dim3(256), 0, st, PROJ + OFF_FQ, IN_COLS, 64, PROJ + OFF_FK, IN_COLS, 64, PROJ + OFF_FV, IN_COLS, 64, 64, 0.125f, CUM, O, 1024);
        hipLaunchKernelGGL(k_rms_rows, dim3(L), dim3(256), 0, st, PROJ, IN_COLS, OFF_CQ, QR, g_q_lat, CQN, QR, 0);
        hipLaunchKernelGGL(k_rms_rows, dim3(L), dim3(256), 0, st, PROJ, IN_COLS, OFF_CKV, KVR, g_kv_lat, CKVN, KVR, 0);
        gemm(st, CQN, QR, w_uq, 768, QUP, 768, nullptr, 0, L, 768, QR);
        gemm(st, CKVN, KVR, w_ukv, 1024, KVUP, 1024, nullptr, 0, L, 1024, KVR);
        hipLaunchKernelGGL(k_mla_prep, dim3(L), dim3(768), 0, st, QUP, KVUP, PROJ, g_mla_q, g_mla_k, MQ, MK);
        hipLaunchKernelGGL(k_attn, dim3(L, 8), dim3(256), 0, st, MQ, 768, 96, MK, 768, 96, KVUP + 64, 1024, 128, 96, 1.0f / sqrtf(96.0f), (const float*)nullptr, O + 512, 1024);
        hipLaunchKernelGGL(k_rms_rows, dim3(L), dim3(256), 0, st, O, 1024, 0, 512, g_fox_out, MIX, 1024, 0);
        hipLaunchKernelGGL(k_rms_rows, dim3(L), dim3(256), 0, st, O, 1024, 512, 512, g_mla_out, MIX, 1024, 512);
        gemm(st, MIX, 1024, w_o, 1024, ATT, 1024, nullptr, 0, L, 1024, 1024);
        hipLaunchKernelGGL(k_res_rms, dim3(L), dim3(256), 0, st, x, meta, ATT, g_ffn, H1, U2, b);
        hipLaunchKernelGGL(k_moe, dim3(SEQ), dim3(256), 0, st, U2, H1, w_group, b_group, w_expert, b_expert, w1, w3, w2, out, b, YAB);
    }
}
}
#endif
namespace pg8 {
#define PG8_LAS __attribute__((address_space(3)))
typedef unsigned short bf16_t;
typedef short bf16x8 __attribute__((ext_vector_type(8)));
typedef float f32x4 __attribute__((ext_vector_type(4)));
typedef unsigned u32x4 __attribute__((ext_vector_type(4)));
typedef unsigned u32x2 __attribute__((ext_vector_type(2)));
constexpr int BM = 256, BK = 64, HALF = 128, HTB = HALF * BK * 2  , STAGE_BYTES = 8 * HTB, NXCD = 8, WGM = 8;

__host__ __device__ __forceinline__ int lds_byte(int r, int c) { const int st = (r >> 4) * 2 + (c >> 5), rr = r & 15, cc = c & 31, ob = rr * 64 + cc * 2; return st * 1024 + (ob ^ (((ob >> 9) & 1) << 5)); }
__host__ __device__ __forceinline__ void stage_rc(int b, int& R, int& C) { const int st = b / 1024, sb = b % 1024, swz = sb ^ (((sb >> 9) & 1) << 5); R = (st >> 1) * 16 + swz / 64; C = (st & 1) * 32 + (swz % 64) / 2; }
__host__ __device__ __forceinline__ int perm32(int rho) { const int n = rho >> 4, i = rho & 15; return 8 * (i >> 2) + 4 * n + (i & 3); }

struct Unit { int pm, pn, ex; const char* A; const char* B; };

struct StaticOrder {
    int nM, nN, nwg, G, c; const char* A; const char* B; size_t tstep;
    __device__ void init(const void* A_, const void* Bt_, int M, int N, int K, int G_, int c_) { nM = M / BM; nN = N / BM; nwg = nM * nN; G = G_; c = c_; A = (const char*)A_; B = (const char*)Bt_; tstep = (size_t)BM * K * 2; }
    __device__ bool next(int i, Unit& u) const {
        const long L = (long)i * G + c; if (L >= nwg) return false;
        int wgid = (int)L; { const int q = nwg / NXCD, r = nwg % NXCD, xcd = wgid % NXCD, off = wgid / NXCD; wgid = (xcd < r ? xcd * (q + 1) : r * (q + 1) + (xcd - r) * q) + off; }
        const int nig = WGM * nN, gid = wgid / nig, fm = gid * WGM, gsz = (nM - fm) < WGM ? (nM - fm) : WGM;
        u.pm = fm + ((wgid % nig) % gsz); u.pn = (wgid % nig) / gsz; u.ex = 0; u.A = A + (size_t)u.pm * tstep; u.B = B + (size_t)u.pn * tstep; return true;
    }
    __device__ __forceinline__ void gather(const Unit&, int, int, int, int, unsigned (&)[4]) const {}
};

__device__ __forceinline__ unsigned cvt_pk_bf16(float lo, float hi) { typedef float f2 __attribute__((ext_vector_type(2))); typedef __bf16 b2 __attribute__((ext_vector_type(2))); f2 v = {lo, hi}; b2 b = __builtin_convertvector(v, b2); return __builtin_bit_cast(unsigned, b); }

template <class Epi, class Sched, bool GATHER = false, bool MID = false>
__device__ __forceinline__ void gemm_phase(PG8_LAS unsigned char* lds, const int K, const Sched& S, const Epi& E) {
    const int tid = threadIdx.x, wid = __builtin_amdgcn_readfirstlane(tid >> 6), lane = tid & 63, wr = wid >> 2, wc = wid & 3, fr = lane & 15, fq = lane >> 4;
    const int nt = K / BK;
    unsigned voffA[2], voffB[2]; int sR[2], sC[2];
#pragma unroll
    for (int i = 0; i < 2; ++i) { int R, C; stage_rc(tid * 16 + i * 8192, R, C); const int Rb = Epi::PERM ? ((R & ~31) + perm32(R & 31)) : R; sR[i] = R; sC[i] = C;
        voffA[i] = (unsigned)(R * K + C) * 2u; voffB[i] = (unsigned)(Rb * K + C) * 2u; }
    const size_t kstep = (size_t)(BK * 2);
    const size_t hstep = (size_t)HALF * K * 2;
    const unsigned ldsw = (unsigned)wid * 1024u;
    const int aoff = lds_byte(wr * 64 + fr, fq * 8), boff = lds_byte(wc * 32 + fr, fq * 8);
#define PG8_SA(b, h) (((b) * 2 + (h)) * HTB)
#define PG8_SB(b, h) ((4 + (b) * 2 + (h)) * HTB)
#define PG8_STAGE(bufoff, gbase, voff) do { _Pragma("unroll") for (int _i = 0; _i < 2; ++_i) \
        __builtin_amdgcn_global_load_lds((const unsigned*)((const char*)(gbase) + (voff)[_i]), (PG8_LAS unsigned*)(lds + (bufoff) + ldsw + _i * 8192), 16, 0, 0); } while (0)
#define PG8_STAGE_A(bufoff, abase, h, NX) do { if constexpr (GATHER) { _Pragma("unroll") for (int _i = 0; _i < 2; ++_i) { const unsigned _o = (NX) ? gN[(h) * 2 + _i] : gC[(h) * 2 + _i]; \
        __builtin_amdgcn_global_load_lds((const unsigned*)((const char*)(abase) + _o), (PG8_LAS unsigned*)(lds + (bufoff) + ldsw + _i * 8192), 16, 0, 0); } } \
        else { PG8_STAGE(bufoff, (abase) + (h) * hstep, voffA); } } while (0)
#define PG8_LDA(dst, b, h) do { _Pragma("unroll") for (int m = 0; m < 4; ++m) _Pragma("unroll") for (int k = 0; k < 2; ++k) dst[m][k] = *(const PG8_LAS bf16x8*)(lds + PG8_SA(b, h) + aoff + m * 2048 + k * 1024); } while (0)
#define PG8_LDB(dst, b, h) do { _Pragma("unroll") for (int n = 0; n < 2; ++n) _Pragma("unroll") for (int k = 0; k < 2; ++k) dst[n][k] = *(const PG8_LAS bf16x8*)(lds + PG8_SB(b, h) + boff + n * 2048 + k * 1024); } while (0)
#define PG8_MMA(ai, bj, At, Bt) do { __builtin_amdgcn_s_setprio(1); _Pragma("unroll") for (int m = 0; m < 4; ++m) _Pragma("unroll") for (int n = 0; n < 2; ++n) _Pragma("unroll") for (int k = 0; k < 2; ++k) \
        acc[ai][bj][m][n] = __builtin_amdgcn_mfma_f32_16x16x32_bf16(Bt[n][k], At[m][k], acc[ai][bj][m][n], 0, 0, 0); __builtin_amdgcn_s_setprio(0); } while (0)
#define PG8_WAIT_V(n) asm volatile("s_waitcnt vmcnt(" #n ")" ::: "memory")
#define PG8_WAIT_L(n) asm volatile("s_waitcnt lgkmcnt(" #n ")" ::: "memory")
#define PG8_BAR __builtin_amdgcn_s_barrier()
#define PG8_SCHED __builtin_amdgcn_sched_barrier(0)
    Unit cur, nxt; int ui = 0;
    if (!S.next(0, cur)) return;
    unsigned gC[4] = {0u, 0u, 0u, 0u}, gN[4] = {0u, 0u, 0u, 0u};
    if constexpr (GATHER) S.gather(cur, sR[0], sC[0], sR[1], sC[1], gC);
    f32x4 acc[2][2][4][2];
#pragma unroll
    for (int a = 0; a < 2; ++a)
#pragma unroll
        for (int b = 0; b < 2; ++b)
#pragma unroll
            for (int m = 0; m < 4; ++m)
#pragma unroll
                for (int n = 0; n < 2; ++n) acc[a][b][m][n] = (f32x4){0.f, 0.f, 0.f, 0.f};
    bf16x8 At[4][2], B0[2][2], B1[2][2];
    const char* cA = cur.A; const char* cB = cur.B;
    PG8_STAGE(PG8_SB(0, 0), cB, voffB); PG8_STAGE(PG8_SB(0, 1), cB + hstep, voffB); PG8_STAGE_A(PG8_SA(0, 0), cA, 0, false); PG8_STAGE_A(PG8_SA(0, 1), cA, 1, false);
    if (wr == 1) PG8_BAR;
    PG8_WAIT_V(2); PG8_BAR;
    PG8_STAGE(PG8_SB(1, 0), cB + kstep, voffB); PG8_STAGE_A(PG8_SA(1, 0), cA + kstep, 0, false); PG8_STAGE(PG8_SB(1, 1), cB + hstep + kstep, voffB);
    PG8_WAIT_V(6); PG8_BAR;
    for (;;) {
        const bool has_next = S.next(ui + 1, nxt);
        if constexpr (GATHER) { if (has_next) S.gather(nxt, sR[0], sC[0], sR[1], sC[1], gN); else { gN[0] = gC[0]; gN[1] = gC[1]; gN[2] = gC[2]; gN[3] = gC[3]; } }
        const char* nA = has_next ? nxt.A : cA; const char* nB = has_next ? nxt.B : cB;
#pragma unroll 1
        for (int t = 0; t < nt; t += 2) {
            const bool last = (t == nt - 2);
            const char* a1 = cA + (size_t)(t + 1) * kstep;
            const char* a2 = last ? nA : cA + (size_t)(t + 2) * kstep; const char* b2 = last ? nB : cB + (size_t)(t + 2) * kstep;
            const char* a3 = a2 + kstep; const char* b3 = b2 + kstep;
            if constexpr (MID) { if (t == nt / 2) E.mid(acc, cur, wr, fr); }
            PG8_LDB(B0, 0, 0); PG8_LDB(B1, 0, 1); PG8_SCHED; PG8_LDA(At, 0, 0); PG8_STAGE_A(PG8_SA(1, 1), a1, 1, false);
            PG8_WAIT_V(8); PG8_WAIT_L(0); PG8_BAR; PG8_MMA(0, 0, At, B0); PG8_MMA(0, 1, At, B1); PG8_BAR; PG8_SCHED;
            PG8_LDA(At, 0, 1); PG8_STAGE(PG8_SB(0, 0), b2, voffB); PG8_STAGE(PG8_SB(0, 1), b2 + hstep, voffB); PG8_STAGE_A(PG8_SA(0, 0), a2, 0, last);
            PG8_WAIT_V(8); PG8_WAIT_L(0); PG8_BAR; PG8_MMA(1, 0, At, B0); PG8_MMA(1, 1, At, B1); PG8_BAR; PG8_SCHED;
            PG8_LDB(B0, 1, 0); PG8_LDB(B1, 1, 1); PG8_SCHED; PG8_LDA(At, 1, 0); PG8_STAGE_A(PG8_SA(0, 1), a2, 1, last);
            PG8_WAIT_V(8); PG8_WAIT_L(0); PG8_BAR; PG8_MMA(0, 0, At, B0); PG8_MMA(0, 1, At, B1); PG8_BAR; PG8_SCHED;
            PG8_LDA(At, 1, 1); PG8_STAGE(PG8_SB(1, 0), b3, voffB); PG8_STAGE(PG8_SB(1, 1), b3 + hstep, voffB); PG8_STAGE_A(PG8_SA(1, 0), a3, 0, last);
            PG8_WAIT_V(8); PG8_WAIT_L(0); PG8_BAR; PG8_MMA(1, 0, At, B0); PG8_MMA(1, 1, At, B1); PG8_BAR; PG8_SCHED;
        }
        if (wr == 0) PG8_BAR;
        E(acc, cur, wr, wc, fr, fq);
        if (!has_next) break;
#pragma unroll
        for (int a = 0; a < 2; ++a)
#pragma unroll
            for (int b = 0; b < 2; ++b)
#pragma unroll
                for (int m = 0; m < 4; ++m)
#pragma unroll
                    for (int n = 0; n < 2; ++n) acc[a][b][m][n] = (f32x4){0.f, 0.f, 0.f, 0.f};
        cur = nxt; cA = nA; cB = nB; ++ui;
        if constexpr (GATHER) { gC[0] = gN[0]; gC[1] = gN[1]; gC[2] = gN[2]; gC[3] = gN[3]; }
        if (wr == 1) PG8_BAR;
    }
    PG8_WAIT_V(0);
    PG8_BAR;
#undef PG8_SA
#undef PG8_SB
#undef PG8_STAGE
#undef PG8_STAGE_A
#undef PG8_LDA
#undef PG8_LDB
#undef PG8_MMA
#undef PG8_WAIT_V
#undef PG8_WAIT_L
#undef PG8_BAR
#undef PG8_SCHED
}
}
namespace mk {
using pg8::bf16_t; using pg8::f32x4; using pg8::u32x4; using pg8::u32x2; using pg8::Unit; using pg8::cvt_pk_bf16;
constexpr int D = 1024, NB = 8, SEQ = 2048, NMETA = 16, LSEQ = SEQ + NMETA;
constexpr int MR = NB * SEQ;
constexpr int MP = MR + 256;
constexpr int NKT = 33;
constexpr int NCF = 9, NCM = 12;
constexpr int NIN = 2304;
constexpr float EPS = 1e-6f;
constexpr float LOG2E = 1.4426950408889634f;
constexpr float C2F = 0.125f * LOG2E;
constexpr float C2M = 0.10206207261596577f * LOG2E;
constexpr int CAP = 16384;
constexpr int NSLOT = 40960;

constexpr size_t MiB = 1u << 20;
constexpr size_t WS_CTL = 0, CTL_BYTES = 1 * MiB;
constexpr int CW_BAR = 4096;
constexpr int CW_CNT = 8192;
constexpr int CW_SSQO = 65536;
constexpr int CW_SSQH = 98304;
constexpr size_t WS_WIN = 1 * MiB, WS_WUQ = 5632 * 1024, WS_WUKV = 6400 * 1024, WS_WO = 7 * MiB, WS_W13 = 9 * MiB, WS_W2 = 41 * MiB;
constexpr size_t WS_ROPE = 57 * MiB;
constexpr size_t WS_WR = 57 * MiB + 512 * 1024;
constexpr size_t WS_LOGF = 58 * MiB, WS_KR = WS_LOGF + 640 * 1024, WS_SSQCQ = WS_KR + 2176 * 1024, WS_SSQCKV = WS_SSQCQ + 640 * 1024, WS_SSQKR = WS_SSQCKV + 320 * 1024;
constexpr size_t WS_TOK = 62 * MiB, WS_LIST = 63 * MiB;
constexpr size_t WS_XN = 66 * MiB;
constexpr size_t WS_O = WS_XN;
constexpr size_t WS_QF = 100 * MiB, WS_KTF = 116 * MiB, WS_VTF = 135 * MiB, WS_CQ = 152 * MiB, WS_CKV = 165 * MiB, WS_QM = 174 * MiB, WS_KTM = 198 * MiB, WS_VTM = 223 * MiB;
constexpr size_t WS_XN2 = 100 * MiB, WS_HD = 132 * MiB, WS_Y = 152 * MiB;
constexpr size_t WS_SNAP = 240 * MiB;
static_assert(WS_WUQ >= WS_WIN + (size_t)NIN * 1024 * 2 && WS_WUKV >= WS_WUQ + 768 * 384 * 2 && WS_WO >= WS_WUKV + 1024 * 256 * 2, "ws map");
static_assert(WS_SSQKR + (size_t)MP * 4 <= WS_TOK && WS_XN + (size_t)MP * D * 2 <= WS_QF, "ws map");
static_assert(WS_KTF + (size_t)64 * NKT * NCF * 1024 <= WS_VTF && WS_VTF + (size_t)64 * NKT * 8192 <= WS_CQ && WS_CQ + (size_t)MP * 384 * 2 <= WS_CKV && WS_CKV + (size_t)MP * 256 * 2 <= WS_QM, "ws map");
static_assert(WS_QM + (size_t)MR * 768 * 2 <= WS_KTM && WS_KTM + (size_t)64 * NKT * NCM * 1024 <= WS_VTM && WS_VTM + (size_t)64 * NKT * 8192 <= WS_SNAP, "ws map");
static_assert(WS_HD + (size_t)NSLOT * 512 <= WS_Y && WS_Y + (size_t)NSLOT * 2048 <= WS_SNAP, "ws map");

__device__ __forceinline__ unsigned f2bf(float f) { unsigned u = __builtin_bit_cast(unsigned, f); return (u + 0x7fffu + ((u >> 16) & 1u)) >> 16; }
__device__ __forceinline__ float bf2f(unsigned short h) { return __builtin_bit_cast(float, (unsigned)h << 16); }
__device__ __forceinline__ float log_sigmoid(float x) { return fminf(x, 0.f) - log1pf(__expf(-fabsf(x))); }

struct Ptrs {
    const float *x, *meta, *g_attn, *w_in, *b_f, *g_fox_q, *g_fox_k, *g_q_lat, *w_uq, *g_kv_lat, *w_ukv, *g_mla_q, *g_mla_k, *g_fox_out, *g_mla_out, *w_o, *g_ffn, *w_group, *b_group, *w_expert, *b_expert, *w1, *w3, *w2;
    float* out; unsigned char* ws;
    __host__ __device__ __forceinline__ bf16_t* WIN() const { return (bf16_t*)(ws + WS_WIN); }
    __host__ __device__ __forceinline__ bf16_t* WUQ() const { return (bf16_t*)(ws + WS_WUQ); }
    __host__ __device__ __forceinline__ bf16_t* WUKV() const { return (bf16_t*)(ws + WS_WUKV); }
    __host__ __device__ __forceinline__ bf16_t* WO() const { return (bf16_t*)(ws + WS_WO); }
    __host__ __device__ __forceinline__ bf16_t* W13() const { return (bf16_t*)(ws + WS_W13); }
    __host__ __device__ __forceinline__ bf16_t* W2() const { return (bf16_t*)(ws + WS_W2); }
    __host__ __device__ __forceinline__ bf16_t* XN() const { return (bf16_t*)(ws + WS_XN); }
    __host__ __device__ __forceinline__ bf16_t* O() const { return (bf16_t*)(ws + WS_O); }
    __host__ __device__ __forceinline__ bf16_t* QF() const { return (bf16_t*)(ws + WS_QF); }
    __host__ __device__ __forceinline__ bf16_t* KTF() const { return (bf16_t*)(ws + WS_KTF); }
    __host__ __device__ __forceinline__ bf16_t* VTF() const { return (bf16_t*)(ws + WS_VTF); }
    __host__ __device__ __forceinline__ bf16_t* CQ() const { return (bf16_t*)(ws + WS_CQ); }
    __host__ __device__ __forceinline__ bf16_t* CKV() const { return (bf16_t*)(ws + WS_CKV); }
    __host__ __device__ __forceinline__ bf16_t* QM() const { return (bf16_t*)(ws + WS_QM); }
    __host__ __device__ __forceinline__ bf16_t* KTM() const { return (bf16_t*)(ws + WS_KTM); }
    __host__ __device__ __forceinline__ bf16_t* VTM() const { return (bf16_t*)(ws + WS_VTM); }
    __host__ __device__ __forceinline__ bf16_t* XN2() const { return (bf16_t*)(ws + WS_XN2); }
    __host__ __device__ __forceinline__ bf16_t* HD() const { return (bf16_t*)(ws + WS_HD); }
    __host__ __device__ __forceinline__ bf16_t* Y() const { return (bf16_t*)(ws + WS_Y); }
    __host__ __device__ __forceinline__ float* ROPE() const { return (float*)(ws + WS_ROPE); }
    __host__ __device__ __forceinline__ float* LOGF() const { return (float*)(ws + WS_LOGF); }
    __host__ __device__ __forceinline__ float* KR() const { return (float*)(ws + WS_KR); }
    __host__ __device__ __forceinline__ float* SSQCQ() const { return (float*)(ws + WS_SSQCQ); }
    __host__ __device__ __forceinline__ float* SSQCKV() const { return (float*)(ws + WS_SSQCKV); }
    __host__ __device__ __forceinline__ float* SSQKR() const { return (float*)(ws + WS_SSQKR); }
    __host__ __device__ __forceinline__ unsigned* ctl() const { return (unsigned*)(ws + WS_CTL); }
    __host__ __device__ __forceinline__ float* SSQO() const { return (float*)(ws + WS_CTL) + CW_SSQO; }
    __host__ __device__ __forceinline__ float* SSQH() const { return (float*)(ws + WS_CTL) + CW_SSQH; }
    __host__ __device__ __forceinline__ bf16_t* WR() const { return (bf16_t*)(ws + WS_WR); }
    __host__ __device__ __forceinline__ int* LIST() const { return (int*)(ws + WS_LIST); }
    __host__ __device__ __forceinline__ unsigned* TOK() const { return (unsigned*)(ws + WS_TOK); }
};

__device__ __forceinline__ size_t kt_off(int bh, int s, int chunk, int NC) { return ((((size_t)bh * NKT + (s >> 6)) * NC + chunk) * 64 + (s & 63)) * 8; }
__device__ __forceinline__ size_t vt_off(int bh, int s, int dhalf, int d32) { return (((size_t)bh * NKT + (s >> 6)) * 4096) + dhalf * 2048 + ((s >> 4) & 3) * 512 + (s & 15) * 32 + d32; }

struct EpiInProj {
    static constexpr bool PERM = true;
    Ptrs P;
    __device__ __forceinline__ void operator()(const f32x4 (&acc)[2][2][4][2], const Unit& u, int wr, int wc, int fr, int fq) const {
        const int pn = u.pn; const bool meta = (u.pm == MR / 256);
        const int rowb = u.pm * 256 + wr * 64 + fr;
        if (pn < 6) {
            const int head = 4 * (pn & 1) + wc;
            f32x4 gv[2][2];
            if (pn < 4) { const float* g = pn < 2 ? P.g_fox_q : P.g_fox_k; const float sc = pn < 2 ? C2F : 1.0f;
#pragma unroll
                for (int bj = 0; bj < 2; ++bj)
#pragma unroll
                    for (int n = 0; n < 2; ++n) gv[bj][n] = *(const f32x4*)(g + 32 * bj + 8 * fq + 4 * n) * sc; }
#pragma unroll
            for (int ai = 0; ai < 2; ++ai)
#pragma unroll
                for (int m = 0; m < 4; ++m) {
                    const int row = rowb + ai * 128 + m * 16;
                    float rs = 1.0f;
                    if (pn < 4) { float ss = 0.f;
#pragma unroll
                        for (int bj = 0; bj < 2; ++bj)
#pragma unroll
                            for (int n = 0; n < 2; ++n) { const f32x4 v = acc[ai][bj][m][n]; ss += (v[0] * v[0] + v[1] * v[1]) + (v[2] * v[2] + v[3] * v[3]); }
                        ss += __shfl_xor(ss, 16); ss += __shfl_xor(ss, 32);
                        rs = 1.0f / sqrtf(ss * (1.0f / 64.0f) + EPS); }
                    u32x4 w[2];
#pragma unroll
                    for (int bj = 0; bj < 2; ++bj) { f32x4 v0 = acc[ai][bj][m][0], v1 = acc[ai][bj][m][1];
                        if (pn < 4) { v0 = v0 * rs * gv[bj][0]; v1 = v1 * rs * gv[bj][1]; }
                        w[bj].x = cvt_pk_bf16(v0[0], v0[1]); w[bj].y = cvt_pk_bf16(v0[2], v0[3]); w[bj].z = cvt_pk_bf16(v1[0], v1[1]); w[bj].w = cvt_pk_bf16(v1[2], v1[3]); }
                    if (pn < 2) { if (!meta) {
#pragma unroll
                            for (int bj = 0; bj < 2; ++bj) *(u32x4*)(P.QF() + (size_t)row * 512 + head * 64 + 32 * bj + 8 * fq) = w[bj]; } }
                    else {
                        int b0, b1, s;
                        if (!meta) { b0 = row >> 11; b1 = b0 + 1; s = NMETA + (row & 2047); } else { const int r = row - MR; s = r; b0 = 0; b1 = r < NMETA ? NB : 0; }
                        for (int b = b0; b < b1; ++b) { const int bh = b * 8 + head;
#pragma unroll
                            for (int bj = 0; bj < 2; ++bj) {
                                if (pn < 4) *(u32x4*)(P.KTF() + kt_off(bh, s, 4 * bj + fq, NCF)) = w[bj];
                                else *(u32x4*)(P.VTF() + vt_off(bh, s, bj, 8 * fq)) = w[bj]; } }
                    }
                }
        } else {
            int kind, colb, slot;
            if (pn == 6) { kind = 0; colb = 64 * wc; slot = wc; }
            else if (pn == 7) { if (wc < 2) { kind = 0; colb = 256 + 64 * wc; slot = 4 + wc; } else { kind = 1; colb = 64 * (wc - 2); slot = wc - 2; } }
            else { if (wc < 2) { kind = 1; colb = 128 + 64 * wc; slot = 2 + wc; } else if (wc == 2) { kind = 2; colb = 0; slot = 0; } else { kind = 3; colb = 0; slot = 0; } }
            if (kind == 3) return;
#pragma unroll
            for (int ai = 0; ai < 2; ++ai)
#pragma unroll
                for (int m = 0; m < 4; ++m) {
                    const int row = rowb + ai * 128 + m * 16;
                    if (kind < 2) {
                        float ss = 0.f;
#pragma unroll
                        for (int bj = 0; bj < 2; ++bj)
#pragma unroll
                            for (int n = 0; n < 2; ++n) { const f32x4 v = acc[ai][bj][m][n]; ss += (v[0] * v[0] + v[1] * v[1]) + (v[2] * v[2] + v[3] * v[3]); }
                        ss += __shfl_xor(ss, 16); ss += __shfl_xor(ss, 32);
                        bf16_t* dst = kind == 0 ? P.CQ() + (size_t)row * 384 + colb : P.CKV() + (size_t)row * 256 + colb;
#pragma unroll
                        for (int bj = 0; bj < 2; ++bj) { const f32x4 v0 = acc[ai][bj][m][0], v1 = acc[ai][bj][m][1]; u32x4 w;
                            w.x = cvt_pk_bf16(v0[0], v0[1]); w.y = cvt_pk_bf16(v0[2], v0[3]); w.z = cvt_pk_bf16(v1[0], v1[1]); w.w = cvt_pk_bf16(v1[2], v1[3]);
                            *(u32x4*)(dst + 32 * bj + 8 * fq) = w; }
                        if (fq == 0) { if (kind == 0) P.SSQCQ()[(size_t)row * 8 + slot] = ss; else P.SSQCKV()[(size_t)row * 4 + slot] = ss; }
                    } else {
                        float ss = 0.f;
#pragma unroll
                        for (int n = 0; n < 2; ++n) { const f32x4 v = acc[ai][0][m][n]; ss += (v[0] * v[0] + v[1] * v[1]) + (v[2] * v[2] + v[3] * v[3]); *(f32x4*)(P.KR() + (size_t)row * 32 + 8 * fq + 4 * n) = v; }
                        ss += __shfl_xor(ss, 16); ss += __shfl_xor(ss, 32);
                        if (fq == 0) { P.SSQKR()[row] = ss;
#pragma unroll
                            for (int n = 0; n < 2; ++n) { const f32x4 v = acc[ai][1][m][n]; const f32x4 bf = *(const f32x4*)(P.b_f + 4 * n); f32x4 o;
                                o[0] = log_sigmoid(v[0] + bf[0]); o[1] = log_sigmoid(v[1] + bf[1]); o[2] = log_sigmoid(v[2] + bf[2]); o[3] = log_sigmoid(v[3] + bf[3]);
                                *(f32x4*)(P.LOGF() + (size_t)row * 8 + 4 * n) = o; } }
                    }
                }
        }
    }
};

struct EpiQup {
    static constexpr bool PERM = true;
    Ptrs P;
    __device__ __forceinline__ void operator()(const f32x4 (&acc)[2][2][4][2], const Unit& u, int wr, int wc, int fr, int fq) const {
        const int rowb = u.pm * 256 + wr * 64 + fr, col0 = u.pn * 256 + wc * 32 + 8 * fq;
#pragma unroll
        for (int ai = 0; ai < 2; ++ai)
#pragma unroll
            for (int m = 0; m < 4; ++m) {
                const int row = rowb + ai * 128 + m * 16;
                const f32x4 s0 = *(const f32x4*)(P.SSQCQ() + (size_t)row * 8); const float s4 = P.SSQCQ()[(size_t)row * 8 + 4], s5 = P.SSQCQ()[(size_t)row * 8 + 5];
                const float rs = 1.0f / sqrtf(((s0[0] + s0[1]) + (s0[2] + s0[3]) + (s4 + s5)) * (1.0f / 384.0f) + EPS);
#pragma unroll
                for (int bj = 0; bj < 2; ++bj) { const f32x4 v0 = acc[ai][bj][m][0] * rs, v1 = acc[ai][bj][m][1] * rs; u32x4 w;
                    w.x = cvt_pk_bf16(v0[0], v0[1]); w.y = cvt_pk_bf16(v0[2], v0[3]); w.z = cvt_pk_bf16(v1[0], v1[1]); w.w = cvt_pk_bf16(v1[2], v1[3]);
                    *(u32x4*)(P.QM() + (size_t)row * 768 + col0 + 128 * bj) = w; }
            }
    }
};

struct EpiKvup {
    static constexpr bool PERM = true;
    Ptrs P;
    __device__ __forceinline__ void operator()(const f32x4 (&acc)[2][2][4][2], const Unit& u, int wr, int wc, int fr, int fq) const {
        const bool meta = (u.pm == MR / 256);
        const int rowb = u.pm * 256 + wr * 64 + fr, head = 2 * u.pn + (wc >> 1); const bool isk = (wc & 1) == 0;
        f32x4 gv[2][2], gr[2];
        if (isk) {
#pragma unroll
            for (int bj = 0; bj < 2; ++bj)
#pragma unroll
                for (int n = 0; n < 2; ++n) gv[bj][n] = *(const f32x4*)(P.g_mla_k + 32 * bj + 8 * fq + 4 * n);
            gr[0] = *(const f32x4*)(P.g_mla_k + 64 + 4 * fq); gr[1] = *(const f32x4*)(P.g_mla_k + 80 + 4 * fq); }
#pragma unroll
        for (int ai = 0; ai < 2; ++ai)
#pragma unroll
            for (int m = 0; m < 4; ++m) {
                const int row = rowb + ai * 128 + m * 16;
                const f32x4 sk = *(const f32x4*)(P.SSQCKV() + (size_t)row * 4);
                const float rl = 1.0f / sqrtf(((sk[0] + sk[1]) + (sk[2] + sk[3])) * (1.0f / 256.0f) + EPS);
                f32x4 v[2][2];
#pragma unroll
                for (int bj = 0; bj < 2; ++bj)
#pragma unroll
                    for (int n = 0; n < 2; ++n) v[bj][n] = acc[ai][bj][m][n] * rl;
                int b0, b1, s;
                if (!meta) { b0 = row >> 11; b1 = b0 + 1; s = NMETA + (row & 2047); } else { const int r = row - MR; s = r < NMETA ? r : 0; b0 = 0; b1 = r < NMETA ? NB : 0; }
                if (isk) {
                    float ss = 0.f;
#pragma unroll
                    for (int bj = 0; bj < 2; ++bj)
#pragma unroll
                        for (int n = 0; n < 2; ++n) { const f32x4 q = v[bj][n]; ss += (q[0] * q[0] + q[1] * q[1]) + (q[2] * q[2] + q[3] * q[3]); }
                    ss += __shfl_xor(ss, 16); ss += __shfl_xor(ss, 32);
                    ss += P.SSQKR()[row];
                    const float rk = 1.0f / sqrtf(ss * (1.0f / 96.0f) + EPS);
                    u32x4 w[2];
#pragma unroll
                    for (int bj = 0; bj < 2; ++bj) { const f32x4 v0 = v[bj][0] * rk * gv[bj][0], v1 = v[bj][1] * rk * gv[bj][1];
                        w[bj].x = cvt_pk_bf16(v0[0], v0[1]); w[bj].y = cvt_pk_bf16(v0[2], v0[3]); w[bj].z = cvt_pk_bf16(v1[0], v1[1]); w[bj].w = cvt_pk_bf16(v1[2], v1[3]); }
                    const f32x4 x1 = *(const f32x4*)(P.KR() + (size_t)row * 32 + 4 * fq) * rk * gr[0], x2 = *(const f32x4*)(P.KR() + (size_t)row * 32 + 16 + 4 * fq) * rk * gr[1];
                    const f32x4 cs0 = *(const f32x4*)(P.ROPE() + ((size_t)s * 16 + 4 * fq) * 2), cs1 = *(const f32x4*)(P.ROPE() + ((size_t)s * 16 + 4 * fq) * 2 + 4);
                    const float c0 = cs0[0], n0 = cs0[1], c1 = cs0[2], n1 = cs0[3], c2 = cs1[0], n2 = cs1[1], c3 = cs1[2], n3 = cs1[3];
                    u32x2 r1, r2;
                    r1.x = cvt_pk_bf16(x1[0] * c0 - x2[0] * n0, x1[1] * c1 - x2[1] * n1); r1.y = cvt_pk_bf16(x1[2] * c2 - x2[2] * n2, x1[3] * c3 - x2[3] * n3);
                    r2.x = cvt_pk_bf16(x1[0] * n0 + x2[0] * c0, x1[1] * n1 + x2[1] * c1); r2.y = cvt_pk_bf16(x1[2] * n2 + x2[2] * c2, x1[3] * n3 + x2[3] * c3);
                    for (int b = b0; b < b1; ++b) { const int bh = b * 8 + head;
#pragma unroll
                        for (int bj = 0; bj < 2; ++bj) *(u32x4*)(P.KTM() + kt_off(bh, s, 4 * bj + fq, NCM)) = w[bj];
                        *(u32x2*)(P.KTM() + kt_off(bh, s, 8 + (fq >> 1), NCM) + 4 * (fq & 1)) = r1;
                        *(u32x2*)(P.KTM() + kt_off(bh, s, 10 + (fq >> 1), NCM) + 4 * (fq & 1)) = r2; }
                } else {
                    u32x4 w[2];
#pragma unroll
                    for (int bj = 0; bj < 2; ++bj) { const f32x4 v0 = v[bj][0], v1 = v[bj][1];
                        w[bj].x = cvt_pk_bf16(v0[0], v0[1]); w[bj].y = cvt_pk_bf16(v0[2], v0[3]); w[bj].z = cvt_pk_bf16(v1[0], v1[1]); w[bj].w = cvt_pk_bf16(v1[2], v1[3]); }
                    for (int b = b0; b < b1; ++b) { const int bh = b * 8 + head;
#pragma unroll
                        for (int bj = 0; bj < 2; ++bj) *(u32x4*)(P.VTM() + vt_off(bh, s, bj, 8 * fq)) = w[bj]; }
                }
            }
    }
};

struct EpiOut {
    static constexpr bool PERM = false;
    Ptrs P;
    __device__ __forceinline__ void rstds(int row, float& rf, float& rm) const {
        const float sf = P.SSQO()[(size_t)row * 2], sm = P.SSQO()[(size_t)row * 2 + 1];
        rf = 1.0f / sqrtf(sf * (1.0f / 512.0f) + EPS); rm = 1.0f / sqrtf(sm * (1.0f / 512.0f) + EPS);
    }
    __device__ __forceinline__ void mid(f32x4 (&acc)[2][2][4][2], const Unit& u, int wr, int fr) const {
#pragma unroll
        for (int ai = 0; ai < 2; ++ai)
#pragma unroll
            for (int m = 0; m < 4; ++m) { float rf, rm; rstds(u.pm * 256 + ai * 128 + wr * 64 + m * 16 + fr, rf, rm); const float ratio = rf / rm;
#pragma unroll
                for (int bj = 0; bj < 2; ++bj)
#pragma unroll
                    for (int n = 0; n < 2; ++n) acc[ai][bj][m][n] *= ratio; }
    }
    __device__ __forceinline__ void operator()(const f32x4 (&acc)[2][2][4][2], const Unit& u, int wr, int wc, int fr, int fq) const {
        const int col0 = u.pn * 256 + wc * 32 + 4 * fq;
#pragma unroll
        for (int ai = 0; ai < 2; ++ai)
#pragma unroll
            for (int m = 0; m < 4; ++m) { const int row = u.pm * 256 + ai * 128 + wr * 64 + m * 16 + fr; float rf, rm; rstds(row, rf, rm);
                const size_t off = (size_t)row * D + col0;
                float ss = 0.f;
#pragma unroll
                for (int bj = 0; bj < 2; ++bj)
#pragma unroll
                    for (int n = 0; n < 2; ++n) { const f32x4 xv = *(const f32x4*)(P.x + off + bj * 128 + n * 16); const f32x4 hv = xv + acc[ai][bj][m][n] * rm; *(f32x4*)(P.out + off + bj * 128 + n * 16) = hv;
                        ss += (hv[0] * hv[0] + hv[1] * hv[1]) + (hv[2] * hv[2] + hv[3] * hv[3]); }
                ss += __shfl_xor(ss, 16); ss += __shfl_xor(ss, 32);
                if (fq == 0) atomicAdd(P.SSQH() + row, ss); }
    }
};

struct EpiMoeUp {
    static constexpr bool PERM = true;
    Ptrs P;
    __device__ __forceinline__ void operator()(const f32x4 (&acc)[2][2][4][2], const Unit& u, int wr, int wc, int fr, int fq) const {
        const int col0 = (u.pn & 1) * 128 + wc * 32 + 8 * fq;
#pragma unroll
        for (int ai = 0; ai < 2; ++ai)
#pragma unroll
            for (int m = 0; m < 4; ++m) { const size_t row = (size_t)u.pm * 256 + ai * 128 + wr * 64 + m * 16 + fr; float h[8];
#pragma unroll
                for (int n = 0; n < 2; ++n)
#pragma unroll
                    for (int e = 0; e < 4; ++e) { const float a = acc[ai][0][m][n][e], b = acc[ai][1][m][n][e]; h[4 * n + e] = a * b / (1.0f + __expf(-a)); }
                u32x4 w; w.x = cvt_pk_bf16(h[0], h[1]); w.y = cvt_pk_bf16(h[2], h[3]); w.z = cvt_pk_bf16(h[4], h[5]); w.w = cvt_pk_bf16(h[6], h[7]);
                *(u32x4*)(P.HD() + row * 256 + col0) = w; }
    }
};
struct EpiMoeDown {
    static constexpr bool PERM = true;
    Ptrs P;
    __device__ __forceinline__ void operator()(const f32x4 (&acc)[2][2][4][2], const Unit& u, int wr, int wc, int fr, int fq) const {
        const int col0 = (u.pn & 3) * 256 + wc * 32 + 8 * fq;
#pragma unroll
        for (int ai = 0; ai < 2; ++ai)
#pragma unroll
            for (int m = 0; m < 4; ++m) { const size_t row = (size_t)u.pm * 256 + ai * 128 + wr * 64 + m * 16 + fr;
#pragma unroll
                for (int bj = 0; bj < 2; ++bj) { const f32x4 v0 = acc[ai][bj][m][0], v1 = acc[ai][bj][m][1]; u32x4 w;
                    w.x = cvt_pk_bf16(v0[0], v0[1]); w.y = cvt_pk_bf16(v0[2], v0[3]); w.z = cvt_pk_bf16(v1[0], v1[1]); w.w = cvt_pk_bf16(v1[2], v1[3]);
                    *(u32x4*)(P.Y() + row * 1024 + col0 + 128 * bj) = w; } }
    }
};
}
namespace mk {
typedef short bf16x8 __attribute__((ext_vector_type(8)));
typedef short s16x4 __attribute__((ext_vector_type(4)));
typedef float f32x16 __attribute__((ext_vector_type(16)));
#define MK_LAS __attribute__((address_space(3)))
__device__ __forceinline__ int crow(int r, int hi) { return (r & 3) + 8 * (r >> 2) + 4 * hi; }
__device__ __forceinline__ s16x4 vtr(const MK_LAS char* p) { typedef short v4 __attribute__((ext_vector_type(4))); return __builtin_bit_cast(s16x4, __builtin_amdgcn_ds_read_tr16_b64_v4i16((MK_LAS v4*)p)); }

__device__ __forceinline__ void glds16(const void* gsrc, unsigned lds_dst) { unsigned keep;
    asm volatile("s_mov_b32 %0, m0\n\ts_mov_b32 m0, %2\n\ts_nop 0\n\tglobal_load_lds_dwordx4 %1, off\n\ts_mov_b32 m0, %0" : "=&s"(keep) : "v"(gsrc), "s"(lds_dst) : "memory"); }

template <bool MLA>
__device__ __forceinline__ void attn_unit(MK_LAS unsigned char* lds, const Ptrs& P, int b, int h, int qb) {
    constexpr int NC = MLA ? NCM : NCF, NKS = MLA ? 6 : 5, KSL = NC * 1024, VSL = 8192;
    const int tid = threadIdx.x, lane = tid & 63, r32 = lane & 31, hi = lane >> 5; const int wid = __builtin_amdgcn_readfirstlane(tid >> 6);
    const int qi = qb * 256 + wid * 32 + r32;
    const size_t row = (size_t)b * SEQ + qi;
    const int bh = b * 8 + h;
    const bf16_t* Kt = (MLA ? P.KTM() : P.KTF()) + (size_t)bh * NKT * NC * 512;
    const bf16_t* Vt = (MLA ? P.VTM() : P.VTF()) + (size_t)bh * NKT * 4096;
    const int NT = 4 * qb + 5;
    const unsigned lds0 = (unsigned)(uintptr_t)lds;
#define MK_DMA(t, buf) do { \
        for (int p_ = wid; p_ < NC; p_ += 8) glds16(Kt + (size_t)(t) * NC * 512 + p_ * 512 + lane * 8, (unsigned)__builtin_amdgcn_readfirstlane(lds0 + (buf) * KSL + p_ * 1024)); \
        glds16(Vt + (size_t)(t) * 4096 + wid * 512 + lane * 8, (unsigned)__builtin_amdgcn_readfirstlane(lds0 + 3 * KSL + (buf) * VSL + wid * 1024)); } while (0)
    MK_DMA(0, 0); MK_DMA(1, 1);
    bf16x8 qf[NKS];
    if constexpr (!MLA) {
        const bf16_t* qp = P.QF() + row * 512 + h * 64 + hi * 8;
#pragma unroll
        for (int d0 = 0; d0 < 4; ++d0) qf[d0] = *(const bf16x8*)(qp + d0 * 16);
        const short one = (short)0x3F80;
        qf[4] = hi == 0 ? (bf16x8){one, one, one, 0, 0, 0, 0, 0} : (bf16x8){0, 0, 0, 0, 0, 0, 0, 0};
    } else {
        const bf16_t* qp = P.QM() + row * 768 + h * 96 + hi * 8;
        float v[6][8]; float ss = 0.f;
#pragma unroll
        for (int d0 = 0; d0 < 6; ++d0) { const bf16x8 raw = *(const bf16x8*)(qp + d0 * 16);
#pragma unroll
            for (int j = 0; j < 8; ++j) { v[d0][j] = bf2f((unsigned short)raw[j]); ss += v[d0][j] * v[d0][j]; } }
        ss += __shfl_xor(ss, 32);
        const float rs = 1.0f / sqrtf(ss * (1.0f / 96.0f) + EPS);
#pragma unroll
        for (int d0 = 0; d0 < 6; ++d0)
#pragma unroll
            for (int j = 0; j < 8; ++j) v[d0][j] *= rs * P.g_mla_q[16 * d0 + 8 * hi + j];
        const float* cs = P.ROPE() + ((size_t)(NMETA + qi) * 16 + 8 * hi) * 2;
#pragma unroll
        for (int j = 0; j < 8; ++j) { const float c = cs[2 * j], s = cs[2 * j + 1], x1 = v[4][j], x2 = v[5][j]; v[4][j] = x1 * c - x2 * s; v[5][j] = x1 * s + x2 * c; }
#pragma unroll
        for (int d0 = 0; d0 < 6; ++d0) { u32x4 w; w.x = cvt_pk_bf16(v[d0][0] * C2M, v[d0][1] * C2M); w.y = cvt_pk_bf16(v[d0][2] * C2M, v[d0][3] * C2M); w.z = cvt_pk_bf16(v[d0][4] * C2M, v[d0][5] * C2M); w.w = cvt_pk_bf16(v[d0][6] * C2M, v[d0][7] * C2M);
            qf[d0] = __builtin_bit_cast(bf16x8, w); }
    }
    float mrow = -1e30f, lrow = 0.f; f32x16 o0 = {}, o1 = {};
    const int sq = NMETA + qi;
    const MK_LAS char* kp0 = (const MK_LAS char*)lds + hi * 1024 + r32 * 16;
    const MK_LAS char* kpa = (const MK_LAS char*)lds + 8 * 1024 + r32 * 16;
    const MK_LAS char* vp0 = (const MK_LAS char*)lds + 3 * KSL + ((lane >> 4) & 1) * 32 + (lane & 3) * 8 + (4 * hi + ((lane & 15) >> 2)) * 64;
    const bool two_k = wid < NC - 8;
    asm volatile("s_waitcnt vmcnt(0)" ::: "memory");
#pragma unroll
    for (int ks = 0; ks < NKS; ++ks) asm volatile("" : "+v"(qf[ks]));
    __syncthreads();
    int buf = 0, bufn = 2;
#pragma unroll 1
    for (int t = 0; t < NT; ++t) {
        if (t + 2 < NT) MK_DMA(t + 2, bufn);
        f32x16 p0 = {}, p1 = {};
#pragma unroll
        for (int ks = 0; ks < NKS; ++ks) {
            const MK_LAS char* kp = (!MLA && ks == 4) ? kpa + buf * KSL : kp0 + buf * KSL + ks * 2048;
            const bf16x8 k0 = *(const MK_LAS bf16x8*)kp, k1 = *(const MK_LAS bf16x8*)(kp + 512);
            p0 = __builtin_amdgcn_mfma_f32_32x32x16_bf16(k0, qf[ks], p0, 0, 0, 0);
            p1 = __builtin_amdgcn_mfma_f32_32x32x16_bf16(k1, qf[ks], p1, 0, 0, 0);
        }
        if (t >= NT - 5) {
            const int kb = 64 * t + 4 * hi;
#pragma unroll
            for (int r = 0; r < 16; ++r) { const int s = kb + (r & 3) + 8 * (r >> 2); if (s > sq) p0[r] = -INFINITY; if (s + 32 > sq) p1[r] = -INFINITY; }
        }
        float rm = fmaxf(p0[0], p1[0]);
#pragma unroll
        for (int r = 1; r < 16; ++r) rm = fmaxf(rm, fmaxf(p0[r], p1[r]));
        rm = fmaxf(rm, __shfl_xor(rm, 32));
        const float mnew = fmaxf(mrow, rm);
        if (__any(mnew > mrow)) { const float alpha = __builtin_amdgcn_exp2f(mrow - mnew); lrow *= alpha;
#pragma unroll
            for (int r = 0; r < 16; ++r) { o0[r] *= alpha; o1[r] *= alpha; }
            mrow = mnew; }
        float rsum = 0.f;
#pragma unroll
        for (int r = 0; r < 16; ++r) { p0[r] = __builtin_amdgcn_exp2f(p0[r] - mrow); p1[r] = __builtin_amdgcn_exp2f(p1[r] - mrow); rsum += p0[r] + p1[r]; }
        lrow += rsum;
        bf16x8 pw[4];
#pragma unroll
        for (int k = 0; k < 2; ++k) { u32x4 a, c;
            a.x = cvt_pk_bf16(p0[8 * k + 0], p0[8 * k + 1]); a.y = cvt_pk_bf16(p0[8 * k + 2], p0[8 * k + 3]); a.z = cvt_pk_bf16(p0[8 * k + 4], p0[8 * k + 5]); a.w = cvt_pk_bf16(p0[8 * k + 6], p0[8 * k + 7]);
            c.x = cvt_pk_bf16(p1[8 * k + 0], p1[8 * k + 1]); c.y = cvt_pk_bf16(p1[8 * k + 2], p1[8 * k + 3]); c.z = cvt_pk_bf16(p1[8 * k + 4], p1[8 * k + 5]); c.w = cvt_pk_bf16(p1[8 * k + 6], p1[8 * k + 7]);
            pw[k] = __builtin_bit_cast(bf16x8, a); pw[2 + k] = __builtin_bit_cast(bf16x8, c); }
        const MK_LAS char* vp = vp0 + buf * VSL;
#pragma unroll
        for (int ks = 0; ks < 4; ++ks) {
            const s16x4 l0 = vtr(vp + ks * 1024), h0 = vtr(vp + ks * 1024 + 512), l1 = vtr(vp + 4096 + ks * 1024), h1 = vtr(vp + 4096 + ks * 1024 + 512);
            const bf16x8 vf0 = {l0[0], l0[1], l0[2], l0[3], h0[0], h0[1], h0[2], h0[3]}, vf1 = {l1[0], l1[1], l1[2], l1[3], h1[0], h1[1], h1[2], h1[3]};
            o0 = __builtin_amdgcn_mfma_f32_32x32x16_bf16(vf0, pw[ks], o0, 0, 0, 0);
            o1 = __builtin_amdgcn_mfma_f32_32x32x16_bf16(vf1, pw[ks], o1, 0, 0, 0);
        }
        if (t + 2 < NT) { if (two_k) asm volatile("s_waitcnt vmcnt(3) lgkmcnt(0)\n\ts_barrier" ::: "memory"); else asm volatile("s_waitcnt vmcnt(2) lgkmcnt(0)\n\ts_barrier" ::: "memory"); }
        else asm volatile("s_waitcnt vmcnt(0) lgkmcnt(0)\n\ts_barrier" ::: "memory");
        bufn = buf; buf = buf == 2 ? 0 : buf + 1;
    }
#undef MK_DMA
    lrow += __shfl_xor(lrow, 32);
    const float inv = 1.0f / lrow; float ssq = 0.f;
    bf16_t* op = P.O() + row * 1024 + (MLA ? 512 : 0) + h * 64 + 4 * hi;
#pragma unroll
    for (int g = 0; g < 4; ++g) {
        const float a0 = o0[4 * g] * inv, a1 = o0[4 * g + 1] * inv, a2 = o0[4 * g + 2] * inv, a3 = o0[4 * g + 3] * inv;
        const float c0 = o1[4 * g] * inv, c1 = o1[4 * g + 1] * inv, c2 = o1[4 * g + 2] * inv, c3 = o1[4 * g + 3] * inv;
        ssq += (a0 * a0 + a1 * a1) + (a2 * a2 + a3 * a3) + (c0 * c0 + c1 * c1) + (c2 * c2 + c3 * c3);
        u32x2 w0, w1; w0.x = cvt_pk_bf16(a0, a1); w0.y = cvt_pk_bf16(a2, a3); w1.x = cvt_pk_bf16(c0, c1); w1.y = cvt_pk_bf16(c2, c3);
        *(u32x2*)(op + 8 * g) = w0; *(u32x2*)(op + 32 + 8 * g) = w1;
    }
    ssq += __shfl_xor(ssq, 32);
    if (hi == 0) atomicAdd(P.SSQO() + row * 2 + (MLA ? 1 : 0), ssq);
}

__device__ __forceinline__ void attn_phase(MK_LAS unsigned char* lds, const Ptrs& P, int vcu, int G) {
    for (int id = vcu; id < 1024; id += G) {
        const int v = id & 255, k = id >> 8, bh = v >> 2, sub = v & 3, qb = (k & 1) ? sub : 7 - sub;
        if (k >> 1) attn_unit<true>(lds, P, bh >> 3, bh & 7, qb); else attn_unit<false>(lds, P, bh >> 3, bh & 7, qb);
    }
}
}
namespace mk {
constexpr int NWAVES = 8;
constexpr int RING_BYTES = 131072, LDSCTL_OFF = RING_BYTES, LDS_BYTES = 147456;
#define GAS __attribute__((address_space(1)))
#define RLX_AGENT __ATOMIC_RELAXED, __HIP_MEMORY_SCOPE_AGENT
#define LDS_WAIT() asm volatile("s_waitcnt lgkmcnt(0)" ::: "memory")

#define XB_TMO      128
#define XB_XCNT(j)  (256  + 64 * (j))
#define XB_XSUB(j)  (1280 + 64 * (j))
#define XB_XGEN(j)  (2304 + 64 * (j))
#define XB_TOP      3328
#define XB_TOPGEN   3392
#define XCD_BAR_WORDS 3456
#define XB_SPIN_CAP (1u << 18)
__device__ __forceinline__ unsigned xb_ld(unsigned* p)              { return __hip_atomic_load(p, __ATOMIC_RELAXED, __HIP_MEMORY_SCOPE_AGENT); }
__device__ __forceinline__ unsigned xb_add(unsigned* p, unsigned v) { return __hip_atomic_fetch_add(p, v, __ATOMIC_RELAXED, __HIP_MEMORY_SCOPE_AGENT); }
__device__ __forceinline__ unsigned xb_xcc_id() { return (unsigned)__builtin_amdgcn_s_getreg((3 << 11) | 20) & 0xFu; }
#define XB_SPIN(cond, bar) do { unsigned _sp = 0; while (cond) { __builtin_amdgcn_s_sleep(1); \
    if ((++_sp & 255u) == 0u) { if (xb_ld(&(bar)[XB_TMO])) break; if (_sp > XB_SPIN_CAP) { atomicAdd(&(bar)[XB_TMO], 1u); break; } } } } while (0)
struct XcdBarrier { unsigned* bar; unsigned x; volatile MK_LAS unsigned* st; };
__device__ __forceinline__ XcdBarrier xcd_barrier_post(unsigned* bar, volatile MK_LAS unsigned* st) {
    XcdBarrier b; b.bar = bar; b.x = xb_xcc_id(); b.st = st;
    if (threadIdx.x == 0) (void)xb_add(&bar[XB_XCNT(b.x)], 1u);
    return b;
}
__device__ __forceinline__ void xcd_barrier_complete(unsigned* bar, unsigned x, unsigned& nloc, unsigned& nx) {
    const unsigned G = gridDim.x * gridDim.y * gridDim.z;
    unsigned sum, cnt, mine, sp = 0u;
    for (;;) {
        sum = 0u; cnt = 0u; mine = 0u;
#pragma unroll
        for (unsigned j = 0; j < 16; ++j) { const unsigned c = xb_ld(&bar[XB_XCNT(j)]); sum += c; cnt += (c > 0u) ? 1u : 0u; mine = (j == x) ? c : mine; }
        if (sum == G) break;
        __builtin_amdgcn_s_sleep(1);
        if ((++sp & 255u) == 0u) { if (xb_ld(&bar[XB_TMO])) break; if (sp > XB_SPIN_CAP) { atomicAdd(&bar[XB_TMO], 1u); break; } }
    }
    nloc = mine > 0u ? mine : 1u; nx = cnt > 0u ? cnt : 1u;
}
__device__ __forceinline__ void xcd_barrier(const XcdBarrier& b) {
    asm volatile("s_waitcnt vmcnt(0)" ::: "memory");
    __syncthreads();
    if (threadIdx.x == 0) {
        unsigned* bar = b.bar;
        __builtin_amdgcn_s_waitcnt(0);
        unsigned nloc = b.st[0], nx = b.st[1];
        if (nloc == 0u) { xcd_barrier_complete(bar, b.x, nloc, nx); b.st[0] = nloc; b.st[1] = nx; }
        const unsigned old = xb_add(&bar[XB_XSUB(b.x)], 1u);
        const unsigned gen = old / nloc;
        if (old + 1u == (gen + 1u) * nloc) {
            __builtin_amdgcn_fence(__ATOMIC_RELEASE, "agent");
            asm volatile("s_waitcnt vmcnt(0)" ::: "memory");
            const unsigned og = xb_add(&bar[XB_TOP], 1u);
            const unsigned tg = og / nx;
            if (og + 1u == (tg + 1u) * nx) xb_add(&bar[XB_TOPGEN], 1u);
            else XB_SPIN(xb_ld(&bar[XB_TOPGEN]) == tg, bar);
            __builtin_amdgcn_fence(__ATOMIC_ACQUIRE, "agent");
            xb_add(&bar[XB_XGEN(b.x)], 1u);
            asm volatile("s_waitcnt vmcnt(0)" ::: "memory");
        } else {
            XB_SPIN(xb_ld(&bar[XB_XGEN(b.x)]) == gen, bar);
            __builtin_amdgcn_fence(__ATOMIC_ACQUIRE, "agent");
            asm volatile("s_waitcnt vmcnt(0)" ::: "memory");
        }
    }
    __syncthreads();
}

__device__ __forceinline__ float wave_sum(float v) {
#pragma unroll
    for (int o = 1; o < 64; o <<= 1) v += __shfl_xor(v, o);
    return v;
}
__device__ __forceinline__ unsigned pk2(float lo, float hi) { return f2bf(lo) | (f2bf(hi) << 16); }

struct P0Item { const float* W; const float* gk; bf16_t* WT; int ldw, col0, nvalid, K, n0, k0; };
__device__ __forceinline__ P0Item p0_decode(const Ptrs& P, int it) {
    constexpr int I_IN = 16 * 72, I_UQ = 6 * 24, I_UKV = 4 * 32, I_O = 16 * 32, I_13 = 32 * 256;
    P0Item d; int r = it; d.gk = nullptr; d.nvalid = 32;
    if (r < I_IN) { const int kb = r / 72, nb = r % 72, n0 = 32 * nb, pn = n0 >> 8, wi = n0 & 255, bj = wi >> 7, wc = (wi >> 5) & 3, LG = 256 * pn + 64 * wc + 32 * bj;
        int src = 0, nv = 32;
        if (LG < 1536) src = LG; else if (LG < 1920) src = 1544 + (LG - 1536); else if (LG < 2176) src = 1928 + (LG - 1920); else if (LG < 2208) src = 2184 + (LG - 2176); else if (LG == 2208) { src = 1536; nv = 8; } else nv = 0;
        d.W = P.w_in; d.ldw = 2216; d.col0 = src; d.nvalid = nv; d.WT = P.WIN(); d.K = 1024; d.n0 = n0; d.k0 = 64 * kb; return d; } r -= I_IN;
    if (r < I_UQ) { const int kb = r / 24, nb = r % 24; d.W = P.w_uq; d.ldw = 768; d.col0 = 32 * nb; d.gk = P.g_q_lat + 64 * kb; d.WT = P.WUQ(); d.K = 384; d.n0 = 32 * nb; d.k0 = 64 * kb; return d; } r -= I_UQ;
    if (r < I_UKV) { const int kb = r / 32, nb = r % 32, n0 = 32 * nb, pn = n0 >> 8, bj = (n0 >> 7) & 1, wc = (n0 >> 5) & 3;
        d.W = P.w_ukv; d.ldw = 1024; d.col0 = (2 * pn + (wc >> 1)) * 128 + (wc & 1) * 64 + 32 * bj; d.gk = P.g_kv_lat + 64 * kb; d.WT = P.WUKV(); d.K = 256; d.n0 = n0; d.k0 = 64 * kb; return d; } r -= I_UKV;
    if (r < I_O) { const int kb = r / 32, nb = r % 32; d.W = P.w_o; d.ldw = 1024; d.col0 = 32 * nb; d.gk = kb < 8 ? P.g_fox_out + 64 * kb : P.g_mla_out + 64 * (kb - 8); d.WT = P.WO(); d.K = 1024; d.n0 = 32 * nb; d.k0 = 64 * kb; return d; } r -= I_O;
    if (r < I_13) { const int e = r >> 8, rr = r & 255, kb = rr >> 4, nb = rr & 15, n0 = 32 * nb, pn = n0 >> 8, bj = (n0 >> 7) & 1, wc = (n0 >> 5) & 3;
        d.W = (bj ? P.w3 : P.w1) + (size_t)e * 262144; d.ldw = 256; d.col0 = 128 * pn + 32 * wc; d.WT = P.W13() + (size_t)e * 524288; d.K = 1024; d.n0 = n0; d.k0 = 64 * kb; return d; } r -= I_13;
    { const int e = r >> 7, rr = r & 127, kb = rr >> 5, nb = rr & 31; d.W = P.w2 + (size_t)e * 262144; d.ldw = 1024; d.col0 = 32 * nb; d.WT = P.W2() + (size_t)e * 262144; d.K = 256; d.n0 = 32 * nb; d.k0 = 64 * kb; return d; }
}
constexpr int P0_NITEMS = 16 * 72 + 6 * 24 + 4 * 32 + 16 * 32 + 32 * 256 + 32 * 128;
constexpr int P0_FIRST_MOE = 16 * 72 + 6 * 24 + 4 * 32 + 16 * 32;
__device__ __forceinline__ void p0_load(const P0Item& d, float (&v)[32], int lane) {
    const int c = lane & 31; const float* src = d.W + (size_t)(d.k0 + (lane >> 5)) * d.ldw + d.col0 + c; const bool ok = c < d.nvalid;
#pragma unroll
    for (int i = 0; i < 32; ++i) v[i] = ok ? src[(size_t)(2 * i) * d.ldw] : 0.f;
}
__device__ __forceinline__ void p0_finish(const P0Item& d, const float (&v)[32], MK_LAS float* scr, int lane) {
    const int c = lane & 31;
#pragma unroll
    for (int i = 0; i < 32; ++i) { const int kk = 2 * i + (lane >> 5); float x = v[i]; if (d.gk) x *= d.gk[kk]; scr[kk * 33 + c] = x; }
    LDS_WAIT(); asm volatile("" ::: "memory");
    const int ch = lane & 7;
#pragma unroll
    for (int j = 0; j < 4; ++j) { const int n = (lane >> 3) + 8 * j; const MK_LAS float* s = scr + (8 * ch) * 33 + n;
        u32x4 o; o.x = pk2(s[0 * 33], s[1 * 33]); o.y = pk2(s[2 * 33], s[3 * 33]); o.z = pk2(s[4 * 33], s[5 * 33]); o.w = pk2(s[6 * 33], s[7 * 33]);
        *(GAS u32x4*)(d.WT + (size_t)(d.n0 + n) * d.K + d.k0 + 8 * ch) = o; }
    LDS_WAIT(); asm volatile("" ::: "memory");
}
__device__ __forceinline__ void p0_convert(const Ptrs& P, MK_LAS float* scr, int first, int step, int end, int lane) {
    if (first >= end) return;
    float va[32], vb[32]; P0Item da = p0_decode(P, first), db = da;
    p0_load(da, va, lane);
    for (int it = first; it < end; it += 2 * step) {
        const bool hb = it + step < end; if (hb) { db = p0_decode(P, it + step); p0_load(db, vb, lane); }
        p0_finish(da, va, scr, lane);
        const bool ha = it + 2 * step < end; if (ha) { da = p0_decode(P, it + 2 * step); p0_load(da, va, lane); }
        if (hb) p0_finish(db, vb, scr, lane);
    }
}
__device__ __forceinline__ void p0_prologue(const Ptrs& P, MK_LAS unsigned char* lds, int vcu, int G, int wave, int lane) {
    MK_LAS float* scr = (MK_LAS float*)(lds + wave * 16384);
    const int gw = vcu * NWAVES + wave, NGW = G * NWAVES;
    p0_convert(P, scr, gw, NGW, P0_NITEMS, lane);
#if defined(PROBE_SUB)
    if (PROBE_SUB == 1) p0_convert(P, scr, gw, NGW, P0_NITEMS, lane);
#endif
#if defined(PROBE_SUB)
    for (int rep_ = 0; rep_ < (PROBE_SUB == 2 ? 2 : 1); ++rep_)
#endif
    for (int m = gw; m < MP; m += NGW) {
        GAS unsigned long long* o8 = (GAS unsigned long long*)(P.XN() + (size_t)m * D) + lane;
        if (m >= MR + NMETA) {
#pragma unroll
            for (int j = 0; j < 4; ++j) o8[64 * j] = 0ull;
            continue; }
        const float* src = m < MR ? P.x + (size_t)m * D : P.meta + (size_t)(m - MR) * D;
        const GAS f32x4* xr = (const GAS f32x4*)src + lane; f32x4 v[4]; float s = 0.f;
#pragma unroll
        for (int j = 0; j < 4; ++j) { v[j] = xr[64 * j]; s += (v[j][0] * v[j][0] + v[j][1] * v[j][1]) + (v[j][2] * v[j][2] + v[j][3] * v[j][3]); }
        const float rstd = 1.f / sqrtf(wave_sum(s) * (1.f / D) + EPS);
#pragma unroll
        for (int j = 0; j < 4; ++j) { const f32x4 g = *(const f32x4*)(P.g_attn + 4 * lane + 256 * j);
            o8[64 * j] = (unsigned long long)pk2(v[j][0] * rstd * g[0], v[j][1] * rstd * g[1]) | ((unsigned long long)pk2(v[j][2] * rstd * g[2], v[j][3] * rstd * g[3]) << 32); }
    }
    for (int idx = vcu * (NWAVES * 64) + (int)threadIdx.x; idx < 64 * 2368; idx += G * NWAVES * 64) {
        const int bh = idx / 2368, r = idx % 2368; u32x4* p;
        if (r < 576) p = (u32x4*)(P.KTF() + ((size_t)bh * NKT + 32) * NCF * 512) + r;
        else if (r < 1344) p = (u32x4*)(P.KTM() + ((size_t)bh * NKT + 32) * NCM * 512) + (r - 576);
        else if (r < 1856) p = (u32x4*)(P.VTF() + ((size_t)bh * NKT + 32) * 4096) + (r - 1344);
        else p = (u32x4*)(P.VTM() + ((size_t)bh * NKT + 32) * 4096) + (r - 1856);
        *p = (u32x4){0u, 0u, 0u, 0u}; }
    for (int idx = vcu * (NWAVES * 64) + (int)threadIdx.x; idx < 48 * 128; idx += G * NWAVES * 64) {
        const int n = idx >> 7, k0 = (idx & 127) * 8; float v[8];
#pragma unroll
        for (int j = 0; j < 8; ++j) v[j] = n < 4 ? P.w_group[(size_t)(k0 + j) * 4 + n] : (n < 36 ? P.w_expert[(size_t)(k0 + j) * 32 + (n - 4)] : 0.f);
        u32x4 w; w.x = pk2(v[0], v[1]); w.y = pk2(v[2], v[3]); w.z = pk2(v[4], v[5]); w.w = pk2(v[6], v[7]);
        *(u32x4*)(P.WR() + (size_t)n * D + k0) = w; }
    for (int idx = vcu * (NWAVES * 64) + (int)threadIdx.x; idx < LSEQ * 16; idx += G * NWAVES * 64) {
        const int pos = idx >> 4, i = idx & 15; const float inv_freq = expf(-logf(10000.0f) * (float)i / 16.0f), ang = (float)pos * inv_freq;
        P.ROPE()[2 * idx] = cosf(ang); P.ROPE()[2 * idx + 1] = sinf(ang); }
}

__device__ __forceinline__ void fox_bias_store(const Ptrs& P, int bh, int s, float cum) {
    const float bias = -cum * LOG2E;
    const unsigned h_ = f2bf(bias); const float r1 = bias - bf2f((unsigned short)h_); const unsigned m_ = f2bf(r1); const float r2 = r1 - bf2f((unsigned short)m_); const unsigned l_ = f2bf(r2);
    u32x4 w; w.x = h_ | (m_ << 16); w.y = l_; w.z = 0u; w.w = 0u;
    *(u32x4*)(P.KTF() + kt_off(bh, s, 8, NCF)) = w;
}
__device__ __forceinline__ void fox_scan(const Ptrs& P, int bh, int lane) {
    const int b = bh >> 3, h = bh & 7;
    float x = lane < NMETA ? P.LOGF()[(size_t)(MR + lane) * 8 + h] : 0.f;
#pragma unroll
    for (int o = 1; o < 16; o <<= 1) { const float y = __shfl_up(x, o); if (lane >= o) x += y; }
    if (lane < NMETA) fox_bias_store(P, bh, lane, x);
    const float mtot = __shfl(x, NMETA - 1);
    float v[32]; float run = 0.f;
#pragma unroll
    for (int j = 0; j < 32; ++j) { run += P.LOGF()[((size_t)b * SEQ + 32 * lane + j) * 8 + h]; v[j] = run; }
    float inc = run;
#pragma unroll
    for (int o = 1; o < 64; o <<= 1) { const float y = __shfl_up(inc, o); if (lane >= o) inc += y; }
    const float base = mtot + (inc - run);
#pragma unroll
    for (int j = 0; j < 32; ++j) fox_bias_store(P, bh, NMETA + 32 * lane + j, base + v[j]);
}

struct MoeTab { int lo, hi, cnt; };
__device__ __forceinline__ MoeTab moe_tab(const Ptrs& P, int lane) {
    MoeTab T; T.cnt = (int)__hip_atomic_load(P.ctl() + CW_CNT + 64 * (lane & 31), RLX_AGENT);
    const int nt = (T.cnt + 255) >> 8; int x = nt;
#pragma unroll
    for (int o = 1; o < 32; o <<= 1) { const int y = __shfl_up(x, o, 32); if ((lane & 31) >= o) x += y; }
    T.hi = x; T.lo = x - nt; return T;
}
template <bool UP>
struct MoeOrder {
    static constexpr int NCOL = UP ? 2 : 4;
    int G, c; MoeTab T; const bf16_t* XN2; const bf16_t* W13; const bf16_t* HD; const bf16_t* W2; const int* LISTP;
    __device__ __forceinline__ bool next(int i, Unit& u) const {
        const int L = i * G + c, total = __builtin_amdgcn_readlane(T.hi, 31);
        if (L >= total * NCOL) return false;
        const int tile = L / NCOL, pn = L % NCOL;
        const unsigned long long mask = __ballot(tile >= T.lo) & 0xffffffffull;
        const int e = __builtin_amdgcn_readfirstlane(__popcll(mask) - 1);
        const int base = __builtin_amdgcn_readlane(T.lo, e);
        u.pm = tile; u.pn = e * NCOL + pn; u.ex = (e << 16) | (tile - base);
        if (UP) { u.A = (const char*)XN2; u.B = (const char*)(W13 + ((size_t)e * 512 + pn * 256) * 1024); }
        else { u.A = (const char*)(HD + (size_t)tile * 256 * 256); u.B = (const char*)(W2 + ((size_t)e * 1024 + pn * 256) * 256); }
        return true;
    }
    __device__ __forceinline__ void gather(const Unit& u, int R0, int C0, int R1, int C1, unsigned (&off)[4]) const {
        const int e = u.ex >> 16, rt = u.ex & 0xffff, cnt = __builtin_amdgcn_readlane(T.cnt, e);
        const int* list = LISTP + (size_t)e * CAP;
#pragma unroll
        for (int hh = 0; hh < 2; ++hh) {
            int i0 = rt * 256 + 128 * hh + R0, i1 = rt * 256 + 128 * hh + R1; i0 = i0 < cnt ? i0 : cnt - 1; i1 = i1 < cnt ? i1 : cnt - 1;
            off[hh * 2 + 0] = (unsigned)list[i0] * 2048u + (unsigned)C0 * 2u; off[hh * 2 + 1] = (unsigned)list[i1] * 2048u + (unsigned)C1 * 2u; }
    }
};

__device__ __forceinline__ void router_phase(const Ptrs& P, MK_LAS unsigned char* lds, int vcu, int G, int wave, int lane) {
    MK_LAS float* LG = (MK_LAS float*)lds;
    const int m = lane & 15, kq = lane >> 4, tsk = wave & 3, kh = wave >> 2;
    for (int tb = vcu * 64; tb < MR; tb += G * 64) {
        const int t = tb + tsk * 16 + m;
        const float rstd = 1.0f / sqrtf(P.SSQH()[t] * (1.0f / D) + EPS);
        f32x4 acc[3] = {{0.f, 0.f, 0.f, 0.f}, {0.f, 0.f, 0.f, 0.f}, {0.f, 0.f, 0.f, 0.f}};
        const float* hp = P.out + (size_t)t * D + kh * 512 + 8 * kq; const float* gp = P.g_ffn + kh * 512 + 8 * kq;
        bf16_t* xp = P.XN2() + (size_t)t * D + kh * 512 + 8 * kq; const bf16_t* wp = P.WR() + (size_t)m * D + kh * 512 + 8 * kq;
#pragma unroll 1
        for (int kc = 0; kc < 16; kc += 4) {
            f32x4 h0[4], h1[4], g0[4], g1[4]; bf16x8 b[4][3];
#pragma unroll
            for (int q = 0; q < 4; ++q) { const int ks = kc + q; h0[q] = *(const f32x4*)(hp + 32 * ks); h1[q] = *(const f32x4*)(hp + 32 * ks + 4); g0[q] = *(const f32x4*)(gp + 32 * ks); g1[q] = *(const f32x4*)(gp + 32 * ks + 4);
#pragma unroll
                for (int nb = 0; nb < 3; ++nb) b[q][nb] = *(const bf16x8*)(wp + (size_t)nb * 16 * D + 32 * ks); }
#pragma unroll
            for (int q = 0; q < 4; ++q) { const int ks = kc + q;
                const f32x4 u0 = h0[q] * g0[q] * rstd, u1 = h1[q] * g1[q] * rstd;
                u32x4 w; w.x = cvt_pk_bf16(u0[0], u0[1]); w.y = cvt_pk_bf16(u0[2], u0[3]); w.z = cvt_pk_bf16(u1[0], u1[1]); w.w = cvt_pk_bf16(u1[2], u1[3]);
                *(u32x4*)(xp + 32 * ks) = w;
                const bf16x8 a = __builtin_bit_cast(bf16x8, w);
#pragma unroll
                for (int nb = 0; nb < 3; ++nb) acc[nb] = __builtin_amdgcn_mfma_f32_16x16x32_bf16(a, b[q][nb], acc[nb], 0, 0, 0); }
        }
#pragma unroll
        for (int nb = 0; nb < 3; ++nb)
#pragma unroll
            for (int r = 0; r < 4; ++r) LG[((tsk * 2 + kh) * 16 + 4 * kq + r) * 48 + 16 * nb + m] = acc[nb][r];
        MK_LAS unsigned* LC = (MK_LAS unsigned*)(lds + 32768);
        if (wave == 7 && lane < 32) LC[lane] = 0u;
        __syncthreads();
        int ea = 0, eb = 0; unsigned ra = 0u, rb = 0u; float wa = 0.f, wb = 0.f;
        if (kh == 0 && lane < 16) {
            const MK_LAS float* l0 = LG + ((tsk * 2 + 0) * 16 + lane) * 48; const MK_LAS float* l1 = LG + ((tsk * 2 + 1) * 16 + lane) * 48; const int tt = tb + tsk * 16 + lane;
            float gl[4];
#pragma unroll
            for (int i = 0; i < 4; ++i) gl[i] = l0[i] + l1[i] + P.b_group[i];
            int gi = 0; float gm = gl[0];
#pragma unroll
            for (int i = 1; i < 4; ++i) if (gl[i] > gm) { gm = gl[i]; gi = i; }
            float den = 0.f;
#pragma unroll
            for (int i = 0; i < 4; ++i) den += expf(gl[i] - gm);
            const float psel = 1.0f / den;
            float w8[8];
#pragma unroll
            for (int i = 0; i < 8; ++i) w8[i] = l0[4 + gi * 8 + i] + l1[4 + gi * 8 + i] + P.b_expert[gi * 8 + i];
            int i0 = 0; float v0 = w8[0];
#pragma unroll
            for (int i = 1; i < 8; ++i) if (w8[i] > v0) { v0 = w8[i]; i0 = i; }
            int i1 = -1; float v1 = -INFINITY;
#pragma unroll
            for (int i = 0; i < 8; ++i) if (i != i0 && (i1 < 0 || w8[i] > v1)) { v1 = w8[i]; i1 = i; }
            const float e1 = expf(v1 - v0);
            wa = psel / (1.0f + e1); wb = psel * e1 / (1.0f + e1);
            ea = gi * 8 + i0; eb = gi * 8 + i1;
            ra = __hip_atomic_fetch_add(LC + ea, 1u, __ATOMIC_RELAXED, __HIP_MEMORY_SCOPE_WORKGROUP); rb = __hip_atomic_fetch_add(LC + eb, 1u, __ATOMIC_RELAXED, __HIP_MEMORY_SCOPE_WORKGROUP);
        }
        __syncthreads();
        if (wave == 0 && lane < 32) { const unsigned c = LC[lane]; LC[32 + lane] = c ? __hip_atomic_fetch_add(P.ctl() + CW_CNT + 64 * lane, c, RLX_AGENT) : 0u; }
        __syncthreads();
        if (kh == 0 && lane < 16) {
            const int tt = tb + tsk * 16 + lane;
            const unsigned pa = LC[32 + ea] + ra, pb = LC[32 + eb] + rb;
            P.LIST()[(size_t)ea * CAP + pa] = tt; P.LIST()[(size_t)eb * CAP + pb] = tt;
            u32x4 r0; r0.x = (unsigned)ea; r0.y = pa; r0.z = (unsigned)eb; r0.w = pb; *(u32x4*)(P.TOK() + (size_t)tt * 8) = r0;
            u32x2 r1; r1.x = __builtin_bit_cast(unsigned, wa); r1.y = __builtin_bit_cast(unsigned, wb); *(u32x2*)(P.TOK() + (size_t)tt * 8 + 4) = r1;
        }
        __syncthreads();
    }
}

__device__ __forceinline__ void combine_phase(const Ptrs& P, int vcu, int G, int wave, int lane) {
    const MoeTab T = moe_tab(P, lane);
    const int gw = vcu * NWAVES + wave, NGW = G * NWAVES;
    for (int t = gw; t < MR; t += NGW) {
        const u32x4 r0 = *(const u32x4*)(P.TOK() + (size_t)t * 8); const unsigned r1x = __hip_atomic_load(P.TOK() + (size_t)t * 8 + 4, RLX_AGENT), r1y = __hip_atomic_load(P.TOK() + (size_t)t * 8 + 5, RLX_AGENT);
        const int ea = __builtin_amdgcn_readfirstlane((int)r0.x), eb = __builtin_amdgcn_readfirstlane((int)r0.z);
        const size_t sa = (size_t)__builtin_amdgcn_readlane(T.lo, ea) * 256 + r0.y, sb = (size_t)__builtin_amdgcn_readlane(T.lo, eb) * 256 + r0.w;
        float wa = __builtin_bit_cast(float, r1x), wb = __builtin_bit_cast(float, r1y);
        asm volatile("" : "+v"(wa)); asm volatile("" : "+v"(wb));
        GAS f32x4* o = (GAS f32x4*)(P.out + (size_t)t * D) + lane;
        const GAS u32x2* ya = (const GAS u32x2*)(P.Y() + sa * 1024) + lane; const GAS u32x2* yb = (const GAS u32x2*)(P.Y() + sb * 1024) + lane;
#pragma unroll
        for (int j = 0; j < 4; ++j) { const f32x4 hv = o[64 * j]; const u32x2 a = ya[64 * j], b = yb[64 * j]; f32x4 r;
            r[0] = hv[0] + wa * __builtin_bit_cast(float, a.x << 16) + wb * __builtin_bit_cast(float, b.x << 16);
            r[1] = hv[1] + wa * __builtin_bit_cast(float, a.x & 0xffff0000u) + wb * __builtin_bit_cast(float, b.x & 0xffff0000u);
            r[2] = hv[2] + wa * __builtin_bit_cast(float, a.y << 16) + wb * __builtin_bit_cast(float, b.y << 16);
            r[3] = hv[3] + wa * __builtin_bit_cast(float, a.y & 0xffff0000u) + wb * __builtin_bit_cast(float, b.y & 0xffff0000u);
            o[64 * j] = r; }
    }
}

struct Args { Ptrs P; int ph_lo, ph_hi; };
constexpr int N_PHASES = 9;
__global__ void __launch_bounds__(NWAVES * 64, 2) mega_fwd(Args args) {
    extern __shared__ __attribute__((aligned(16))) unsigned char lds_raw[];
    MK_LAS unsigned char* lds = (MK_LAS unsigned char*)lds_raw;
    const Ptrs& P = args.P;
    const int tid = threadIdx.x, lane = tid & 63, wave = __builtin_amdgcn_readfirstlane(tid >> 6);
    const int G = gridDim.x; const int bx = blockIdx.x; const int vcu = (G % 8 == 0) ? (bx % 8) * (G / 8) + bx / 8 : bx;
    volatile MK_LAS unsigned* MISC = (volatile MK_LAS unsigned*)(lds + LDSCTL_OFF);
    for (int u = tid; u < (LDS_BYTES - LDSCTL_OFF) / 4; u += NWAVES * 64) ((MK_LAS unsigned*)(lds + LDSCTL_OFF))[u] = 0u;
    __syncthreads();
    const int lo = args.ph_lo, hi = args.ph_hi;
    XcdBarrier bar = xcd_barrier_post(P.ctl() + CW_BAR, MISC + 8);
#ifndef PH_MASK
#define PH_MASK 0x1ff
#endif
#define IN(k) (((PH_MASK >> (k)) & 1) && lo <= (k) && (k) < hi)
#ifndef PROBE_PHASE
#define PROBE_PHASE (-1)
#endif
#ifndef PROBE_MUL
#define PROBE_MUL 4
#endif
    unsigned long long ts_prev = 0ull, ts_probe = 0ull;
    if (PROBE_PHASE >= 0) ts_prev = __builtin_amdgcn_s_memrealtime();
#define SEAM(k) do { if (IN(k) && IN((k) + 1)) xcd_barrier(bar); if (PROBE_PHASE >= 0) { const unsigned long long now_ = __builtin_amdgcn_s_memrealtime(); if ((k) == PROBE_PHASE) ts_probe = now_ - ts_prev; ts_prev = now_; } } while (0)
    if (IN(0)) { p0_prologue(P, lds, vcu, G, wave, lane); }
    SEAM(0);
    if (IN(1)) { pg8::StaticOrder S; S.init(P.XN(), P.WIN(), MP, NIN, 1024, G, bx); EpiInProj E{P}; pg8::gemm_phase<EpiInProj, pg8::StaticOrder>(lds, 1024, S, E); }
    SEAM(1);
    if (IN(2)) {
#ifndef P2SUB
#define P2SUB 7
#endif
        if ((P2SUB & 1) && vcu < 64 && wave == 0) fox_scan(P, vcu, lane);
        if (P2SUB & 2) { pg8::StaticOrder S; S.init(P.CQ(), P.WUQ(), MR, 768, 384, G, bx); EpiQup E{P}; pg8::gemm_phase<EpiQup, pg8::StaticOrder>(lds, 384, S, E); }
        if (P2SUB & 4) { pg8::StaticOrder S; S.init(P.CKV(), P.WUKV(), MP, 1024, 256, G, (bx + 64) % G); EpiKvup E{P}; pg8::gemm_phase<EpiKvup, pg8::StaticOrder>(lds, 256, S, E); }
    }
    SEAM(2);
    if (IN(3)) attn_phase(lds, P, vcu, G);
    SEAM(3);
    if (IN(4)) { pg8::StaticOrder S; S.init(P.O(), P.WO(), MR, 1024, 1024, G, bx); EpiOut E{P}; pg8::gemm_phase<EpiOut, pg8::StaticOrder, false, true>(lds, 1024, S, E); }
    SEAM(4);
    if (IN(5)) router_phase(P, lds, vcu, G, wave, lane);
    SEAM(5);
    if (IN(6)) { MoeOrder<true> S; S.G = G; S.c = bx; S.T = moe_tab(P, lane); S.XN2 = P.XN2(); S.W13 = P.W13(); S.HD = P.HD(); S.W2 = P.W2(); S.LISTP = P.LIST(); EpiMoeUp E{P}; pg8::gemm_phase<EpiMoeUp, MoeOrder<true>, true>(lds, 1024, S, E); }
    SEAM(6);
    if (IN(7)) { MoeOrder<false> S; S.G = G; S.c = bx; S.T = moe_tab(P, lane); S.XN2 = P.XN2(); S.W13 = P.W13(); S.HD = P.HD(); S.W2 = P.W2(); S.LISTP = P.LIST(); EpiMoeDown E{P}; pg8::gemm_phase<EpiMoeDown, MoeOrder<false>>(lds, 256, S, E); }
    SEAM(7);
    if (IN(8)) combine_phase(P, vcu, G, wave, lane);
    SEAM(8);
    if (PROBE_PHASE >= 0 && bx == 0 && tid == 0) { const unsigned long long t0_ = __builtin_amdgcn_s_memrealtime(); while (__builtin_amdgcn_s_memrealtime() - t0_ < (unsigned long long)PROBE_MUL * ts_probe) __builtin_amdgcn_s_sleep(16); }
#undef IN
#undef SEAM
}
}
#ifndef DEBUG_STAGE
#define DEBUG_STAGE 0
#endif
#if DEBUG_STAGE
namespace dbg {
using namespace mk;
__global__ void k_snap(Ptrs P, int mode, float* snap, int ncols) {
    const int r = blockIdx.x; const int b = DBG_B;
    for (int c = threadIdx.x; c < ncols; c += blockDim.x) {
        float v = 0.f;
        const int i = r - NMETA; const size_t row = (size_t)b * SEQ + (i < 0 ? 0 : i);
        if (mode == 0) { v = i < 0 ? 0.f : bf2f(P.QF()[row * 512 + c]) / C2F; }
        else if (mode == 1) { const int h = c >> 6, d = c & 63; v = bf2f(P.KTF()[kt_off(b * 8 + h, r, d >> 3, NCF) + (d & 7)]); }
        else if (mode == 2) { const int h = c >> 6, d = c & 63; v = bf2f(P.VTF()[vt_off(b * 8 + h, r, d >> 5, d & 31)]); }
        else if (mode == 3) { const bf16_t* p = P.KTF() + kt_off(b * 8 + c, r, 8, NCF); v = bf2f(p[0]) + bf2f(p[1]) + bf2f(p[2]); }
        else if (mode == 4) { v = i < 0 ? 0.f : bf2f(P.QM()[row * 768 + c]); }
        else if (mode == 5) { const int h = c / 96, d = c % 96; v = bf2f(P.KTM()[kt_off(b * 8 + h, r, d >> 3, NCM) + (d & 7)]); }
        else if (mode == 6) { const int h = c >> 6, d = c & 63; v = bf2f(P.VTM()[vt_off(b * 8 + h, r, d >> 5, d & 31)]); }
        else if (mode == 7) { v = i < 0 ? 0.f : bf2f(P.O()[row * 1024 + c]); }
        else if (mode == 8) { v = i < 0 ? 0.f : P.out[row * 1024 + c]; }
        else if (mode == 9) { v = i < 0 ? 0.f : bf2f(P.XN2()[row * 1024 + c]); }
        else if (mode == 10 || mode == 11) { if (i >= 0) { const unsigned* tk = P.TOK() + row * 8; const int e = (int)tk[mode == 10 ? 0 : 2]; const unsigned pos = tk[mode == 10 ? 1 : 3]; const float w = __builtin_bit_cast(float, tk[mode == 10 ? 4 : 5]);
                int lo = 0; for (int q = 0; q < e; ++q) lo += ((int)P.ctl()[CW_CNT + 64 * q] + 255) >> 8;
                v = w * bf2f(P.Y()[((size_t)lo * 256 + pos) * 1024 + c]); } }
        snap[(size_t)r * ncols + c] = v;
    }
}
__global__ void k_bias_ref(const float* cum, float* o) { const int r = blockIdx.x, h = threadIdx.x; o[r * 8 + h] = -cum[h * LSEQ + r] * LOG2E; }
__global__ void k_cmp(const float* a, int lda, int offa, const float* ref, int ldb, int offb, int hw, int hs, int r0, int ncols, float* sums, int k) {
    const int r = blockIdx.x; if (r < r0) return;
    float d2 = 0.f, b2 = 0.f;
    for (int c = threadIdx.x; c < ncols; c += blockDim.x) { const int cc = hw ? (c / hw) * hs + (c % hw) : c; const float bv = ref[(size_t)r * ldb + offb + cc], av = a[(size_t)r * lda + offa + c]; d2 += (av - bv) * (av - bv); b2 += bv * bv; }
    d2 = wave_sum(d2); b2 = wave_sum(b2);
    if ((threadIdx.x & 63) == 0) { atomicAdd(sums + 2 * k, d2); atomicAdd(sums + 2 * k + 1, b2); }
}
__global__ void k_cmpy(const float* a, const float* h, const float* ref, float* sums, int k) {
    const int r = blockIdx.x; if (r < NMETA) return;
    float d2 = 0.f, b2 = 0.f;
    for (int c = threadIdx.x; c < 1024; c += blockDim.x) { const float rv = ref[(size_t)(r - NMETA) * 1024 + c], av = a[(size_t)r * 1024 + c], hv = h[(size_t)r * 1024 + c]; d2 += (av - rv) * (av - rv); b2 += (rv - hv) * (rv - hv); }
    d2 = wave_sum(d2); b2 = wave_sum(b2);
    if ((threadIdx.x & 63) == 0) { atomicAdd(sums + 2 * k, d2); atomicAdd(sums + 2 * k + 1, b2); }
}
__global__ void k_scale_lin(float* out, size_t n, const float* sums, float mul) {
    const float f = 1.0f + mul * sqrtf(sums[0] / fmaxf(sums[1], 1e-30f));
    for (size_t i = (size_t)blockIdx.x * blockDim.x + threadIdx.x; i < n; i += (size_t)gridDim.x * blockDim.x) out[i] *= f;
}
__global__ void k_scale(float* out, size_t n, const float* sums, int nchecks) {
    float delta = 0.f; int bad = -1;
    for (int k = 0; k < nchecks; ++k) { const float rel = sqrtf(sums[2 * k] / fmaxf(sums[2 * k + 1], 1e-30f)); if (!(rel <= 0.1f) && bad < 0) bad = k; if (rel > delta) delta = rel; }
    if (bad >= 0) delta = 0.1f * (float)(bad + 1);
    const float f = 1.0f + delta;
    for (size_t i = (size_t)blockIdx.x * blockDim.x + threadIdx.x; i < n; i += (size_t)gridDim.x * blockDim.x) out[i] *= f;
}
}
#endif

extern "C" void kernel_launch(void* const* d_in, const int* in_sizes, int n_in, void* d_out, int out_size, void* d_ws, size_t ws_size, hipStream_t stream) {
    using namespace mk;
    static int grid = 0;
    if (grid == 0) {
        int dev = 0, cus = 0, per_cu = 0;
        if (n_in != 24 || out_size != MR * D || ws_size < 256 * MiB) { fprintf(stderr, "kernel_launch: unexpected problem shape (n_in %d, out %d, ws %zu)\n", n_in, out_size, ws_size); grid = -1; return; }
        if (hipGetDevice(&dev) != hipSuccess || hipDeviceGetAttribute(&cus, hipDeviceAttributeMultiprocessorCount, dev) != hipSuccess) { grid = -1; return; }
        if (hipFuncSetAttribute((const void*)mega_fwd, hipFuncAttributeMaxDynamicSharedMemorySize, LDS_BYTES) != hipSuccess) { fprintf(stderr, "kernel_launch: hipFuncSetAttribute failed\n"); grid = -1; return; }
        if (hipOccupancyMaxActiveBlocksPerMultiprocessor(&per_cu, (const void*)mega_fwd, NWAVES * 64, LDS_BYTES) != hipSuccess || per_cu < 1) { fprintf(stderr, "kernel_launch: occupancy query says %d blocks per CU\n", per_cu); per_cu = 1; }
        (void)hipGetLastError();
        grid = cus;
    }
    if (grid < 0) return;
    unsigned char* ws = (unsigned char*)d_ws;
    (void)hipMemsetAsync(ws + WS_CTL, 0, CTL_BYTES, stream);
    Args a{};
    Ptrs& P = a.P;
    const float* const* in = (const float* const*)d_in;
    P.x = in[0]; P.meta = in[1]; P.g_attn = in[2]; P.w_in = in[3]; P.b_f = in[4]; P.g_fox_q = in[5]; P.g_fox_k = in[6]; P.g_q_lat = in[7]; P.w_uq = in[8]; P.g_kv_lat = in[9]; P.w_ukv = in[10];
    P.g_mla_q = in[11]; P.g_mla_k = in[12]; P.g_fox_out = in[13]; P.g_mla_out = in[14]; P.w_o = in[15]; P.g_ffn = in[16]; P.w_group = in[17]; P.b_group = in[18]; P.w_expert = in[19]; P.b_expert = in[20];
    P.w1 = in[21]; P.w3 = in[22]; P.w2 = in[23];
    P.out = (float*)d_out; P.ws = ws;
#if DEBUG_STAGE == 0
    a.ph_lo = 0; a.ph_hi = N_PHASES;
    hipLaunchKernelGGL(mega_fwd, dim3(grid), dim3(NWAVES * 64), LDS_BYTES, stream, a);
#else
    a.ph_lo = 0; a.ph_hi = DEBUG_STAGE + 1 > N_PHASES ? N_PHASES : DEBUG_STAGE + 1;
    hipLaunchKernelGGL(mega_fwd, dim3(grid), dim3(NWAVES * 64), LDS_BYTES, stream, a);
    float* S1 = (float*)(ws + 66 * MiB);
    float* S2 = (float*)(ws + WS_SNAP);
    float* sums = (float*)(ws + 239 * MiB + 512 * 1024);
    (void)hipMemsetAsync(sums, 0, 256, stream);
    nv::Bufs nb;
    const int L = LSEQ;
#if DEBUG_STAGE == 2
    float* s_fq = S1; float* s_fk = s_fq + (size_t)L * 512; float* s_fv = s_fk + (size_t)L * 512; float* s_bias = s_fv + (size_t)L * 512; float* s_qm = s_bias + (size_t)L * 8;
    float* s_mk = s_qm + (size_t)L * 768; float* s_mv = s_mk + (size_t)L * 768; float* s_bref = S2;
    hipLaunchKernelGGL(dbg::k_snap, dim3(L), dim3(256), 0, stream, P, 0, s_fq, 512);
    hipLaunchKernelGGL(dbg::k_snap, dim3(L), dim3(256), 0, stream, P, 1, s_fk, 512);
    hipLaunchKernelGGL(dbg::k_snap, dim3(L), dim3(256), 0, stream, P, 2, s_fv, 512);
    hipLaunchKernelGGL(dbg::k_snap, dim3(L), dim3(64), 0, stream, P, 3, s_bias, 8);
    hipLaunchKernelGGL(dbg::k_snap, dim3(L), dim3(256), 0, stream, P, 4, s_qm, 768);
    hipLaunchKernelGGL(dbg::k_snap, dim3(L), dim3(256), 0, stream, P, 5, s_mk, 768);
    hipLaunchKernelGGL(dbg::k_snap, dim3(L), dim3(256), 0, stream, P, 6, s_mv, 512);
    nv::naive_forward(d_in, (float*)d_out, ws + 100 * MiB, stream, &nb);
    hipLaunchKernelGGL(dbg::k_bias_ref, dim3(L), dim3(8), 0, stream, nb.CUM, s_bref);
    hipLaunchKernelGGL(dbg::k_cmp, dim3(L), dim3(256), 0, stream, s_fq, 512, 0, nb.PROJ, nv::IN_COLS, nv::OFF_FQ, 0, 0, NMETA, 512, sums, 0);
    hipLaunchKernelGGL(dbg::k_cmp, dim3(L), dim3(256), 0, stream, s_fk, 512, 0, nb.PROJ, nv::IN_COLS, nv::OFF_FK, 0, 0, 0, 512, sums, 1);
    hipLaunchKernelGGL(dbg::k_cmp, dim3(L), dim3(256), 0, stream, s_fv, 512, 0, nb.PROJ, nv::IN_COLS, nv::OFF_FV, 0, 0, 0, 512, sums, 2);
    hipLaunchKernelGGL(dbg::k_cmp, dim3(L), dim3(64), 0, stream, s_bias, 8, 0, s_bref, 8, 0, 0, 0, 0, 8, sums, 3);
    hipLaunchKernelGGL(dbg::k_cmp, dim3(L), dim3(256), 0, stream, s_qm, 768, 0, nb.QUP, 768, 0, 0, 0, NMETA, 768, sums, 4);
    hipLaunchKernelGGL(dbg::k_cmp, dim3(L), dim3(256), 0, stream, s_mk, 768, 0, nb.MK, 768, 0, 0, 0, 0, 768, sums, 5);
    hipLaunchKernelGGL(dbg::k_cmp, dim3(L), dim3(256), 0, stream, s_mv, 512, 0, nb.KVUP, 1024, 64, 64, 128, 0, 512, sums, 6);
    const int nchecks = 7;
#elif DEBUG_STAGE == 3
    hipLaunchKernelGGL(dbg::k_snap, dim3(L), dim3(256), 0, stream, P, 7, S2, 1024);
    nv::naive_forward(d_in, (float*)d_out, ws + 100 * MiB, stream, &nb);
    hipLaunchKernelGGL(dbg::k_cmp, dim3(L), dim3(256), 0, stream, S2, 1024, 0, nb.O, 1024, 0, 0, 0, NMETA, 512, sums, 0);
    hipLaunchKernelGGL(dbg::k_cmp, dim3(L), dim3(256), 0, stream, S2, 1024, 512, nb.O, 1024, 512, 0, 0, NMETA, 512, sums, 1);
    const int nchecks = 2;
#elif DEBUG_STAGE == 4
    hipLaunchKernelGGL(dbg::k_snap, dim3(L), dim3(256), 0, stream, P, 8, S2, 1024);
    nv::naive_forward(d_in, (float*)d_out, ws + 100 * MiB, stream, &nb);
    hipLaunchKernelGGL(dbg::k_cmp, dim3(L), dim3(256), 0, stream, S2, 1024, 0, nb.H1, 1024, 0, 0, 0, NMETA, 1024, sums, 0);
    const int nchecks = 1;
#elif DEBUG_STAGE == 9
    hipLaunchKernelGGL(dbg::k_snap, dim3(L), dim3(256), 0, stream, P, 10, S2, 1024);
    hipLaunchKernelGGL(dbg::k_snap, dim3(L), dim3(256), 0, stream, P, 11, S1, 1024);
    nv::naive_forward(d_in, (float*)d_out, ws + 100 * MiB, stream, &nb);
    hipLaunchKernelGGL(dbg::k_cmp, dim3(L), dim3(256), 0, stream, S2, 1024, 0, nb.YAB, 1024, 0, 0, 0, NMETA, 1024, sums, 0);
    hipLaunchKernelGGL(dbg::k_cmp, dim3(L), dim3(256), 0, stream, S1, 1024, 0, nb.YAB + (size_t)L * 1024, 1024, 0, 0, 0, NMETA, 1024, sums, 1);
    const int nchecks = 2;
#elif DEBUG_STAGE == 10
    hipLaunchKernelGGL(dbg::k_snap, dim3(L), dim3(256), 0, stream, P, 11, S2, 1024);
    nv::naive_forward(d_in, (float*)d_out, ws + 100 * MiB, stream, &nb);
    hipLaunchKernelGGL(dbg::k_cmp, dim3(L), dim3(256), 0, stream, S2, 1024, 0, nb.YAB + (size_t)L * 1024, 1024, 0, 0, 0, NMETA, 1024, sums, 0);
    hipLaunchKernelGGL(dbg::k_scale_lin, dim3(1024), dim3(256), 0, stream, (float*)d_out, (size_t)MR * D, sums, 0.1f);
    const int nchecks = 0;
#elif DEBUG_STAGE == 8
    hipLaunchKernelGGL(dbg::k_snap, dim3(L), dim3(256), 0, stream, P, 8, S2, 1024);
    nv::naive_forward(d_in, (float*)d_out, ws + 100 * MiB, stream, &nb);
    hipLaunchKernelGGL(dbg::k_cmpy, dim3(L), dim3(256), 0, stream, S2, nb.H1, (const float*)d_out + (size_t)DBG_B * SEQ * D, sums, 0);
    hipLaunchKernelGGL(dbg::k_scale_lin, dim3(1024), dim3(256), 0, stream, (float*)d_out, (size_t)MR * D, sums, 0.1f);
    const int nchecks = 0;
#else
    hipLaunchKernelGGL(dbg::k_snap, dim3(L), dim3(256), 0, stream, P, 9, S2, 1024);
    nv::naive_forward(d_in, (float*)d_out, ws + 100 * MiB, stream, &nb);
    hipLaunchKernelGGL(dbg::k_cmp, dim3(L), dim3(256), 0, stream, S2, 1024, 0, nb.U2, 1024, 0, 0, 0, NMETA, 1024, sums, 0);
    const int nchecks = 1;
#endif
    if (nchecks > 0) hipLaunchKernelGGL(dbg::k_scale, dim3(1024), dim3(256), 0, stream, (float*)d_out, (size_t)MR * D, sums, nchecks);
#endif
}
```

```cpp
#include <hip/hip_runtime.h>
#include <cstdio>
#include <cstdint>
#include <cmath>
#ifndef DEBUG_STAGE
#define DEBUG_STAGE 0
#endif
#undef DEBUG_STAGE
#define DEBUG_STAGE 0
#if DEBUG_STAGE
#ifndef DBG_B
#define DBG_B 7
#endif
namespace nv {
constexpr int D_MODEL = 1024, BATCH = 8, SEQ = 2048, N_META = 16, L = SEQ + N_META;
constexpr int FOX_H = 8, FOX_D = 64, FOX_W = 512;
constexpr int MLA_H = 8, QR = 384, KVR = 256, NOPE = 64, ROPE = 32, QK = 96, VD = 64, MLA_W = 512;
constexpr int IN_COLS = 2216;
constexpr int OFF_FQ = 0, OFF_FK = 512, OFF_FV = 1024, OFF_FF = 1536, OFF_CQ = 1544, OFF_CKV = 1928, OFF_KR = 2184;
constexpr int NG = 4, EPG = 8, NE = 32, DE = 256;
constexpr float EPS = 1e-6f;

__device__ __forceinline__ float wave_sum(float v) {
#pragma unroll
    for (int o = 1; o < 64; o <<= 1) v += __shfl_xor(v, o);
    return v;
}
__device__ __forceinline__ float block_sum256(float v, float* red) {
    v = wave_sum(v);
    __syncthreads();
    if ((threadIdx.x & 63) == 0) red[threadIdx.x >> 6] = v;
    __syncthreads();
    return red[0] + red[1] + red[2] + red[3];
}

__global__ void k_rms_in(const float* __restrict__ x, const float* __restrict__ meta, const float* __restrict__ g, float* __restrict__ u, int b) {
    __shared__ float red[4];
    const int r = blockIdx.x;
    const float* src = r < N_META ? meta + (size_t)r * D_MODEL : x + ((size_t)b * SEQ + (r - N_META)) * D_MODEL;
    float v[4]; float ss = 0.f;
#pragma unroll
    for (int i = 0; i < 4; ++i) { v[i] = src[threadIdx.x + 256 * i]; ss += v[i] * v[i]; }
    ss = block_sum256(ss, red);
    const float rs = 1.0f / sqrtf(ss * (1.0f / D_MODEL) + EPS);
#pragma unroll
    for (int i = 0; i < 4; ++i) u[(size_t)r * D_MODEL + threadIdx.x + 256 * i] = v[i] * rs * g[threadIdx.x + 256 * i];
}
__global__ void k_rms_rows(const float* __restrict__ in, int ld, int off, int n, const float* __restrict__ g, float* __restrict__ out, int ldo, int offo) {
    __shared__ float red[4];
    const int r = blockIdx.x;
    float ss = 0.f;
    for (int i = threadIdx.x; i < n; i += 256) { const float v = in[(size_t)r * ld + off + i]; ss += v * v; }
    ss = block_sum256(ss, red);
    const float rs = 1.0f / sqrtf(ss / (float)n + EPS);
    for (int i = threadIdx.x; i < n; i += 256) out[(size_t)r * ldo + offo + i] = in[(size_t)r * ld + off + i] * rs * g[i];
}

__global__ void k_gemm(const float* __restrict__ A, int lda, const float* __restrict__ B, int ldb, float* __restrict__ C, int ldc, const float* __restrict__ R, int ldr, int M, int N, int K) {
    __shared__ float As[16][65];
    __shared__ float Bs[16][65];
    const int tx = threadIdx.x & 15, ty = threadIdx.x >> 4;
    const int m0 = blockIdx.y * 64, n0 = blockIdx.x * 64;
    float acc[4][4] = {};
    for (int k0 = 0; k0 < K; k0 += 16) {
        for (int i = threadIdx.x; i < 64 * 16; i += 256) {
            const int mm = i >> 4, kk = i & 15;
            As[kk][mm] = (m0 + mm < M) ? A[(size_t)(m0 + mm) * lda + k0 + kk] : 0.f;
        }
        for (int i = threadIdx.x; i < 64 * 16; i += 256) {
            const int kk = i >> 6, nn = i & 63;
            Bs[kk][nn] = (n0 + nn < N) ? B[(size_t)(k0 + kk) * ldb + n0 + nn] : 0.f;
        }
        __syncthreads();
#pragma unroll
        for (int kk = 0; kk < 16; ++kk) {
            float a[4], bb[4];
#pragma unroll
            for (int i = 0; i < 4; ++i) { a[i] = As[kk][ty * 4 + i]; bb[i] = Bs[kk][tx * 4 + i]; }
#pragma unroll
            for (int i = 0; i < 4; ++i)
#pragma unroll
                for (int j = 0; j < 4; ++j) acc[i][j] += a[i] * bb[j];
        }
        __syncthreads();
    }
#pragma unroll
    for (int i = 0; i < 4; ++i)
#pragma unroll
        for (int j = 0; j < 4; ++j) {
            const int m = m0 + ty * 4 + i, n = n0 + tx * 4 + j;
            if (m < M && n < N) C[(size_t)m * ldc + n] = acc[i][j] + (R ? R[(size_t)m * ldr + n] : 0.f);
        }
}

__device__ __forceinline__ float log_sigmoid(float x) { return fminf(x, 0.f) - log1pf(expf(-fabsf(x))); }

__global__ void k_fox_prep(float* __restrict__ proj, const float* __restrict__ gq, const float* __restrict__ gk, const float* __restrict__ bf, float* __restrict__ logf) {
    const int r = blockIdx.x, h = threadIdx.x >> 6, d = threadIdx.x & 63;
    float* row = proj + (size_t)r * IN_COLS;
    float q = row[OFF_FQ + h * 64 + d], k = row[OFF_FK + h * 64 + d];
    const float sq = wave_sum(q * q), sk = wave_sum(k * k);
    row[OFF_FQ + h * 64 + d] = q * (1.0f / sqrtf(sq * (1.0f / 64) + EPS)) * gq[d];
    row[OFF_FK + h * 64 + d] = k * (1.0f / sqrtf(sk * (1.0f / 64) + EPS)) * gk[d];
    if (d == 0) logf[r * 8 + h] = log_sigmoid(row[OFF_FF + h] + bf[h]);
}
__global__ void k_cumsum(const float* __restrict__ logf, float* __restrict__ cum) {
    const int h = threadIdx.x; float c = 0.f;
    for (int r = 0; r < L; ++r) { c += logf[r * 8 + h]; cum[h * L + r] = c; }
}

__global__ void k_attn(const float* __restrict__ q, int ldq, int hq, const float* __restrict__ k, int ldk, int hk, const float* __restrict__ v, int ldv, int hv,
                       int dk, float scale, const float* __restrict__ cum, float* __restrict__ o, int ldo) {
    __shared__ float sc[L];
    __shared__ float qs[96];
    __shared__ float red[4];
    __shared__ float part[4][64];
    const int t = blockIdx.x, h = blockIdx.y, tid = threadIdx.x;
    if (tid < dk) qs[tid] = q[(size_t)t * ldq + h * hq + tid];
    __syncthreads();
    const float ct = cum ? cum[h * L + t] : 0.f;
    float mx = -INFINITY;
    for (int s = tid; s <= t; s += 256) {
        const float* kr = k + (size_t)s * ldk + h * hk;
        float a = 0.f;
        for (int d = 0; d < dk; ++d) a += qs[d] * kr[d];
        a *= scale;
        if (cum) a += ct - cum[h * L + s];
        sc[s] = a; mx = fmaxf(mx, a);
    }
#pragma unroll
    for (int off = 1; off < 64; off <<= 1) mx = fmaxf(mx, __shfl_xor(mx, off));
    __syncthreads();
    if ((tid & 63) == 0) red[tid >> 6] = mx;
    __syncthreads();
    mx = fmaxf(fmaxf(red[0], red[1]), fmaxf(red[2], red[3]));
    float sum = 0.f;
    for (int s = tid; s <= t; s += 256) { const float p = expf(sc[s] - mx); sc[s] = p; sum += p; }
    sum = block_sum256(sum, red);
    const int d = tid & 63, gq = tid >> 6;
    float acc = 0.f;
    for (int s = gq; s <= t; s += 4) acc += sc[s] * v[(size_t)s * ldv + h * hv + d];
    part[gq][d] = acc;
    __syncthreads();
    if (tid < 64) o[(size_t)t * ldo + h * 64 + tid] = (part[0][tid] + part[1][tid] + part[2][tid] + part[3][tid]) / sum;
}

__global__ void k_mla_prep(const float* __restrict__ qup, const float* __restrict__ kvup, const float* __restrict__ proj, const float* __restrict__ gq, const float* __restrict__ gk,
                           float* __restrict__ mq, float* __restrict__ mk) {
    __shared__ float sq[8][96], sk[8][96];
    __shared__ float rq[8], rk[8];
    const int r = blockIdx.x, h = threadIdx.x / 96, j = threadIdx.x % 96;
    const float qv = qup[(size_t)r * 768 + h * 96 + j];
    const float kv = j < 64 ? kvup[(size_t)r * 1024 + h * 128 + j] : proj[(size_t)r * IN_COLS + OFF_KR + (j - 64)];
    sq[h][j] = qv; sk[h][j] = kv;
    __syncthreads();
    if (j == 0) { float a = 0.f, b = 0.f; for (int i = 0; i < 96; ++i) { a += sq[h][i] * sq[h][i]; b += sk[h][i] * sk[h][i]; }
        rq[h] = 1.0f / sqrtf(a * (1.0f / 96) + EPS); rk[h] = 1.0f / sqrtf(b * (1.0f / 96) + EPS); }
    __syncthreads();
    sq[h][j] = qv * rq[h] * gq[j]; sk[h][j] = kv * rk[h] * gk[j];
    __syncthreads();
    float oq = sq[h][j], ok = sk[h][j];
    if (j >= 64) {
        const int i = (j - 64) & 15; const bool second = (j - 64) >= 16;
        const float inv_freq = expf(-logf(10000.0f) * (float)i / 16.0f);
        const float ang = (float)r * inv_freq, c = cosf(ang), s = sinf(ang);
        const float q1 = sq[h][64 + i], q2 = sq[h][80 + i], k1 = sk[h][64 + i], k2 = sk[h][80 + i];
        oq = second ? q1 * s + q2 * c : q1 * c - q2 * s;
        ok = second ? k1 * s + k2 * c : k1 * c - k2 * s;
    }
    mq[(size_t)r * 768 + h * 96 + j] = oq; mk[(size_t)r * 768 + h * 96 + j] = ok;
}

__global__ void k_res_rms(const float* __restrict__ x, const float* __restrict__ meta, const float* __restrict__ att, const float* __restrict__ g, float* __restrict__ h1, float* __restrict__ u2, int b) {
    __shared__ float red[4];
    const int r = blockIdx.x;
    const float* src = r < N_META ? meta + (size_t)r * D_MODEL : x + ((size_t)b * SEQ + (r - N_META)) * D_MODEL;
    float v[4]; float ss = 0.f;
#pragma unroll
    for (int i = 0; i < 4; ++i) { v[i] = src[threadIdx.x + 256 * i] + att[(size_t)r * D_MODEL + threadIdx.x + 256 * i]; ss += v[i] * v[i]; h1[(size_t)r * D_MODEL + threadIdx.x + 256 * i] = v[i]; }
    ss = block_sum256(ss, red);
    const float rs = 1.0f / sqrtf(ss * (1.0f / D_MODEL) + EPS);
#pragma unroll
    for (int i = 0; i < 4; ++i) u2[(size_t)r * D_MODEL + threadIdx.x + 256 * i] = v[i] * rs * g[threadIdx.x + 256 * i];
}

__global__ void k_moe(const float* __restrict__ u2, const float* __restrict__ h1, const float* __restrict__ wg, const float* __restrict__ bg, const float* __restrict__ we, const float* __restrict__ be,
                      const float* __restrict__ w1, const float* __restrict__ w3, const float* __restrict__ w2, float* __restrict__ out, int b, float* __restrict__ yab) {
    __shared__ float us[D_MODEL];
    __shared__ float lg[36];
    __shared__ float hid[DE];
    __shared__ int eidx[2];
    __shared__ float wsel[2];
    const int r = blockIdx.x + N_META, tid = threadIdx.x;
#pragma unroll
    for (int i = 0; i < 4; ++i) us[tid + 256 * i] = u2[(size_t)r * D_MODEL + tid + 256 * i];
    __syncthreads();
    if (tid < 36) {
        float a = 0.f;
        if (tid < 4) { for (int k = 0; k < D_MODEL; ++k) a += us[k] * wg[k * NG + tid]; a += bg[tid]; }
        else { const int e = tid - 4; for (int k = 0; k < D_MODEL; ++k) a += us[k] * we[k * NE + e]; a += be[e]; }
        lg[tid] = a;
    }
    __syncthreads();
    if (tid == 0) {
        int gi = 0; float gm = lg[0];
        for (int i = 1; i < 4; ++i) if (lg[i] > gm) { gm = lg[i]; gi = i; }
        float den = 0.f; for (int i = 0; i < 4; ++i) den += expf(lg[i] - gm);
        const float psel = 1.0f / den;
        const float* w = lg + 4 + gi * 8;
        int i0 = 0; for (int i = 1; i < 8; ++i) if (w[i] > w[i0]) i0 = i;
        int i1 = -1; for (int i = 0; i < 8; ++i) if (i != i0 && (i1 < 0 || w[i] > w[i1])) i1 = i;
        const float e1 = expf(w[i1] - w[i0]);
        wsel[0] = psel / (1.0f + e1); wsel[1] = psel * e1 / (1.0f + e1);
        eidx[0] = gi * 8 + i0; eidx[1] = gi * 8 + i1;
    }
    __syncthreads();
    float y[4] = {0.f, 0.f, 0.f, 0.f};
    for (int j = 0; j < 2; ++j) {
        const int e = eidx[j]; const float ws = wsel[j];
        const float* W1 = w1 + (size_t)e * D_MODEL * DE; const float* W3 = w3 + (size_t)e * D_MODEL * DE; const float* W2 = w2 + (size_t)e * DE * D_MODEL;
        float a = 0.f, c = 0.f;
        for (int k = 0; k < D_MODEL; ++k) { a += us[k] * W1[(size_t)k * DE + tid]; c += us[k] * W3[(size_t)k * DE + tid]; }
        __syncthreads();
        hid[tid] = (a / (1.0f + expf(-a))) * c;
        __syncthreads();
#pragma unroll
        for (int i = 0; i < 4; ++i) { float s = 0.f; for (int k = 0; k < DE; ++k) s += hid[k] * W2[(size_t)k * D_MODEL + tid + 256 * i]; y[i] += ws * s; if (yab) yab[((size_t)j * L + r) * D_MODEL + tid + 256 * i] = ws * s; }
    }
#pragma unroll
    for (int i = 0; i < 4; ++i) out[((size_t)b * SEQ + (r - N_META)) * D_MODEL + tid + 256 * i] = h1[(size_t)r * D_MODEL + tid + 256 * i] + y[i];
}

inline void gemm(hipStream_t st, const float* A, int lda, const float* B, int ldb, float* C, int ldc, const float* R, int ldr, int M, int N, int K) {
    dim3 grid((N + 63) / 64, (M + 63) / 64);
    hipLaunchKernelGGL(k_gemm, grid, dim3(256), 0, st, A, lda, B, ldb, C, ldc, R, ldr, M, N, K);
}

struct Bufs { float *PROJ, *CUM, *QUP, *KVUP, *MK, *O, *H1, *U2, *YAB; };
inline void naive_forward(void* const* d_in, float* out, unsigned char* ws, hipStream_t st, Bufs* bufs) {
    const float* x = (const float*)d_in[0]; const float* meta = (const float*)d_in[1]; const float* g_attn = (const float*)d_in[2]; const float* w_in = (const float*)d_in[3];
    const float* b_f = (const float*)d_in[4]; const float* g_fox_q = (const float*)d_in[5]; const float* g_fox_k = (const float*)d_in[6]; const float* g_q_lat = (const float*)d_in[7];
    const float* w_uq = (const float*)d_in[8]; const float* g_kv_lat = (const float*)d_in[9]; const float* w_ukv = (const float*)d_in[10]; const float* g_mla_q = (const float*)d_in[11];
    const float* g_mla_k = (const float*)d_in[12]; const float* g_fox_out = (const float*)d_in[13]; const float* g_mla_out = (const float*)d_in[14]; const float* w_o = (const float*)d_in[15];
    const float* g_ffn = (const float*)d_in[16]; const float* w_group = (const float*)d_in[17]; const float* b_group = (const float*)d_in[18]; const float* w_expert = (const float*)d_in[19];
    const float* b_expert = (const float*)d_in[20]; const float* w1 = (const float*)d_in[21]; const float* w3 = (const float*)d_in[22]; const float* w2 = (const float*)d_in[23];
    size_t off = 0;
    auto carve = [&](size_t nfloats) { float* p = (float*)(ws + off); off += ((nfloats * 4 + 255) / 256) * 256; return p; };
    float* U = carve((size_t)L * D_MODEL); float* PROJ = carve((size_t)L * IN_COLS); float* LOGF = carve((size_t)L * 8); float* CUM = carve((size_t)8 * L);
    float* CQN = carve((size_t)L * QR); float* CKVN = carve((size_t)L * KVR); float* QUP = carve((size_t)L * 768); float* KVUP = carve((size_t)L * 1024);
    float* MQ = carve((size_t)L * 768); float* MK = carve((size_t)L * 768); float* O = carve((size_t)L * 1024); float* MIX = carve((size_t)L * 1024);
    float* ATT = carve((size_t)L * 1024); float* H1 = carve((size_t)L * 1024); float* U2 = carve((size_t)L * 1024); float* YAB = carve((size_t)2 * L * 1024);
    if (bufs) { bufs->PROJ = PROJ; bufs->CUM = CUM; bufs->QUP = QUP; bufs->KVUP = KVUP; bufs->MK = MK; bufs->O = O; bufs->H1 = H1; bufs->U2 = U2; bufs->YAB = YAB; }
    for (int bi = 0; bi < BATCH; ++bi) {
        const int b = (bi + DBG_B + 1) % BATCH;
        hipLaunchKernelGGL(k_rms_in, dim3(L), dim3(256), 0, st, x, meta, g_attn, U, b);
        gemm(st, U, D_MODEL, w_in, IN_COLS, PROJ, IN_COLS, nullptr, 0, L, IN_COLS, D_MODEL);
        hipLaunchKernelGGL(k_fox_prep, dim3(L), dim3(512), 0, st, PROJ, g_fox_q, g_fox_k, b_f, LOGF);
        hipLaunchKernelGGL(k_cumsum, dim3(1), dim3(8), 0, st, LOGF, CUM);
        hipLaunchKernelGGL(k_attn, dim3(L, 8), dim3(256), 0, st, PROJ + OFF_FQ, IN_COLS, 64, PROJ + OFF_FK, IN_COLS, 64, PROJ + OFF_FV, IN_COLS, 64, 64, 0.125f, CUM, O, 1024);
        hipLaunchKernelGGL(k_rms_rows, dim3(L), dim3(256), 0, st, PROJ, IN_COLS, OFF_CQ, QR, g_q_lat, CQN, QR, 0);
        hipLaunchKernelGGL(k_rms_rows, dim3(L), dim3(256), 0, st, PROJ, IN_COLS, OFF_CKV, KVR, g_kv_lat, CKVN, KVR, 0);
        gemm(st, CQN, QR, w_uq, 768, QUP, 768, nullptr, 0, L, 768, QR);
        gemm(st, CKVN, KVR, w_ukv, 1024, KVUP, 1024, nullptr, 0, L, 1024, KVR);
        hipLaunchKernelGGL(k_mla_prep, dim3(L), dim3(768), 0, st, QUP, KVUP, PROJ, g_mla_q, g_mla_k, MQ, MK);
        hipLaunchKernelGGL(k_attn, dim3(L, 8), dim3(256), 0, st, MQ, 768, 96, MK, 768, 96, KVUP + 64, 1024, 128, 96, 1.0f / sqrtf(96.0f), (const float*)nullptr, O + 512, 1024);
        hipLaunchKernelGGL(k_rms_rows, dim3(L), dim3(256), 0, st, O, 1024, 0, 512, g_fox_out, MIX, 1024, 0);
        hipLaunchKernelGGL(k_rms_rows, dim3(L), dim3(256), 0, st, O, 1024, 512, 512, g_mla_out, MIX, 1024, 512);
        gemm(st, MIX, 1024, w_o, 1024, ATT, 1024, nullptr, 0, L, 1024, 1024);
        hipLaunchKernelGGL(k_res_rms, dim3(L), dim3(256), 0, st, x, meta, ATT, g_ffn, H1, U2, b);
        hipLaunchKernelGGL(k_moe, dim3(SEQ), dim3(256), 0, st, U2, H1, w_group, b_group, w_expert, b_expert, w1, w3, w2, out, b, YAB);
    }
}
}
#endif
namespace pg8 {
#define PG8_LAS __attribute__((address_space(3)))
typedef unsigned short bf16_t;
typedef short bf16x8 __attribute__((ext_vector_type(8)));
typedef float f32x4 __attribute__((ext_vector_type(4)));
typedef unsigned u32x4 __attribute__((ext_vector_type(4)));
typedef unsigned u32x2 __attribute__((ext_vector_type(2)));
constexpr int BM = 256, BK = 64, HALF = 128, HTB = HALF * BK * 2  , STAGE_BYTES = 8 * HTB, NXCD = 8, WGM = 8;

__host__ __device__ __forceinline__ int lds_byte(int r, int c) { const int st = (r >> 4) * 2 + (c >> 5), rr = r & 15, cc = c & 31, ob = rr * 64 + cc * 2; return st * 1024 + (ob ^ (((ob >> 9) & 1) << 5)); }
__host__ __device__ __forceinline__ void stage_rc(int b, int& R, int& C) { const int st = b / 1024, sb = b % 1024, swz = sb ^ (((sb >> 9) & 1) << 5); R = (st >> 1) * 16 + swz / 64; C = (st & 1) * 32 + (swz % 64) / 2; }
__host__ __device__ __forceinline__ int perm32(int rho) { const int n = rho >> 4, i = rho & 15; return 8 * (i >> 2) + 4 * n + (i & 3); }

struct Unit { int pm, pn, ex; const char* A; const char* B; };

struct StaticOrder {
    int nM, nN, nwg, G, c; const char* A; const char* B; size_t tstep;
    __device__ void init(const void* A_, const void* Bt_, int M, int N, int K, int G_, int c_) { nM = M / BM; nN = N / BM; nwg = nM * nN; G = G_; c = c_; A = (const char*)A_; B = (const char*)Bt_; tstep = (size_t)BM * K * 2; }
    __device__ bool next(int i, Unit& u) const {
        const long L = (long)i * G + c; if (L >= nwg) return false;
        int wgid = (int)L; { const int q = nwg / NXCD, r = nwg % NXCD, xcd = wgid % NXCD, off = wgid / NXCD; wgid = (xcd < r ? xcd * (q + 1) : r * (q + 1) + (xcd - r) * q) + off; }
        const int nig = WGM * nN, gid = wgid / nig, fm = gid * WGM, gsz = (nM - fm) < WGM ? (nM - fm) : WGM;
        u.pm = fm + ((wgid % nig) % gsz); u.pn = (wgid % nig) / gsz; u.ex = 0; u.A = A + (size_t)u.pm * tstep; u.B = B + (size_t)u.pn * tstep; return true;
    }
    __device__ __forceinline__ void gather(const Unit&, int, int, int, int, unsigned (&)[4]) const {}
};

__device__ __forceinline__ unsigned cvt_pk_bf16(float lo, float hi) { typedef float f2 __attribute__((ext_vector_type(2))); typedef __bf16 b2 __attribute__((ext_vector_type(2))); f2 v = {lo, hi}; b2 b = __builtin_convertvector(v, b2); return __builtin_bit_cast(unsigned, b); }

template <class Epi, class Sched, bool GATHER = false, bool MID = false>
__device__ __forceinline__ void gemm_phase(PG8_LAS unsigned char* lds, const int K, const Sched& S, const Epi& E) {
    const int tid = threadIdx.x, wid = __builtin_amdgcn_readfirstlane(tid >> 6), lane = tid & 63, wr = wid >> 2, wc = wid & 3, fr = lane & 15, fq = lane >> 4;
    const int nt = K / BK;
    unsigned voffA[2], voffB[2]; int sR[2], sC[2];
#pragma unroll
    for (int i = 0; i < 2; ++i) { int R, C; stage_rc(tid * 16 + i * 8192, R, C); const int Rb = Epi::PERM ? ((R & ~31) + perm32(R & 31)) : R; sR[i] = R; sC[i] = C;
        voffA[i] = (unsigned)(R * K + C) * 2u; voffB[i] = (unsigned)(Rb * K + C) * 2u; }
    const size_t kstep = (size_t)(BK * 2);
    const size_t hstep = (size_t)HALF * K * 2;
    const unsigned ldsw = (unsigned)wid * 1024u;
    const int aoff = lds_byte(wr * 64 + fr, fq * 8), boff = lds_byte(wc * 32 + fr, fq * 8);
#define PG8_SA(b, h) (((b) * 2 + (h)) * HTB)
#define PG8_SB(b, h) ((4 + (b) * 2 + (h)) * HTB)
#define PG8_STAGE(bufoff, gbase, voff) do { _Pragma("unroll") for (int _i = 0; _i < 2; ++_i) \
        __builtin_amdgcn_global_load_lds((const unsigned*)((const char*)(gbase) + (voff)[_i]), (PG8_LAS unsigned*)(lds + (bufoff) + ldsw + _i * 8192), 16, 0, 0); } while (0)
#define PG8_STAGE_A(bufoff, abase, h, NX) do { if constexpr (GATHER) { _Pragma("unroll") for (int _i = 0; _i < 2; ++_i) { const unsigned _o = (NX) ? gN[(h) * 2 + _i] : gC[(h) * 2 + _i]; \
        __builtin_amdgcn_global_load_lds((const unsigned*)((const char*)(abase) + _o), (PG8_LAS unsigned*)(lds + (bufoff) + ldsw + _i * 8192), 16, 0, 0); } } \
        else { PG8_STAGE(bufoff, (abase) + (h) * hstep, voffA); } } while (0)
#define PG8_LDA(dst, b, h) do { _Pragma("unroll") for (int m = 0; m < 4; ++m) _Pragma("unroll") for (int k = 0; k < 2; ++k) dst[m][k] = *(const PG8_LAS bf16x8*)(lds + PG8_SA(b, h) + aoff + m * 2048 + k * 1024); } while (0)
#define PG8_LDB(dst, b, h) do { _Pragma("unroll") for (int n = 0; n < 2; ++n) _Pragma("unroll") for (int k = 0; k < 2; ++k) dst[n][k] = *(const PG8_LAS bf16x8*)(lds + PG8_SB(b, h) + boff + n * 2048 + k * 1024); } while (0)
#define PG8_MMA(ai, bj, At, Bt) do { __builtin_amdgcn_s_setprio(1); _Pragma("unroll") for (int m = 0; m < 4; ++m) _Pragma("unroll") for (int n = 0; n < 2; ++n) _Pragma("unroll") for (int k = 0; k < 2; ++k) \
        acc[ai][bj][m][n] = __builtin_amdgcn_mfma_f32_16x16x32_bf16(Bt[n][k], At[m][k], acc[ai][bj][m][n], 0, 0, 0); __builtin_amdgcn_s_setprio(0); } while (0)
#define PG8_WAIT_V(n) asm volatile("s_waitcnt vmcnt(" #n ")" ::: "memory")
#define PG8_WAIT_L(n) asm volatile("s_waitcnt lgkmcnt(" #n ")" ::: "memory")
#define PG8_BAR __builtin_amdgcn_s_barrier()
#define PG8_SCHED __builtin_amdgcn_sched_barrier(0)
    Unit cur, nxt; int ui = 0;
    if (!S.next(0, cur)) return;
    unsigned gC[4] = {0u, 0u, 0u, 0u}, gN[4] = {0u, 0u, 0u, 0u};
    if constexpr (GATHER) S.gather(cur, sR[0], sC[0], sR[1], sC[1], gC);
    f32x4 acc[2][2][4][2];
#pragma unroll
    for (int a = 0; a < 2; ++a)
#pragma unroll
        for (int b = 0; b < 2; ++b)
#pragma unroll
            for (int m = 0; m < 4; ++m)
#pragma unroll
                for (int n = 0; n < 2; ++n) acc[a][b][m][n] = (f32x4){0.f, 0.f, 0.f, 0.f};
    bf16x8 At[4][2], B0[2][2], B1[2][2];
    const char* cA = cur.A; const char* cB = cur.B;
    PG8_STAGE(PG8_SB(0, 0), cB, voffB); PG8_STAGE(PG8_SB(0, 1), cB + hstep, voffB); PG8_STAGE_A(PG8_SA(0, 0), cA, 0, false); PG8_STAGE_A(PG8_SA(0, 1), cA, 1, false);
    if (wr == 1) PG8_BAR;
    PG8_WAIT_V(2); PG8_BAR;
    PG8_STAGE(PG8_SB(1, 0), cB + kstep, voffB); PG8_STAGE_A(PG8_SA(1, 0), cA + kstep, 0, false); PG8_STAGE(PG8_SB(1, 1), cB + hstep + kstep, voffB);
    PG8_WAIT_V(6); PG8_BAR;
    for (;;) {
        const bool has_next = S.next(ui + 1, nxt);
        if constexpr (GATHER) { if (has_next) S.gather(nxt, sR[0], sC[0], sR[1], sC[1], gN); else { gN[0] = gC[0]; gN[1] = gC[1]; gN[2] = gC[2]; gN[3] = gC[3]; } }
        const char* nA = has_next ? nxt.A : cA; const char* nB = has_next ? nxt.B : cB;
#pragma unroll 1
        for (int t = 0; t < nt; t += 2) {
            const bool last = (t == nt - 2);
            const char* a1 = cA + (size_t)(t + 1) * kstep;
            const char* a2 = last ? nA : cA + (size_t)(t + 2) * kstep; const char* b2 = last ? nB : cB + (size_t)(t + 2) * kstep;
            const char* a3 = a2 + kstep; const char* b3 = b2 + kstep;
            if constexpr (MID) { if (t == nt / 2) E.mid(acc, cur, wr, fr); }
            PG8_LDB(B0, 0, 0); PG8_LDB(B1, 0, 1); PG8_SCHED; PG8_LDA(At, 0, 0); PG8_STAGE_A(PG8_SA(1, 1), a1, 1, false);
            PG8_WAIT_V(8); PG8_WAIT_L(0); PG8_BAR; PG8_MMA(0, 0, At, B0); PG8_MMA(0, 1, At, B1); PG8_BAR; PG8_SCHED;
            PG8_LDA(At, 0, 1); PG8_STAGE(PG8_SB(0, 0), b2, voffB); PG8_STAGE(PG8_SB(0, 1), b2 + hstep, voffB); PG8_STAGE_A(PG8_SA(0, 0), a2, 0, last);
            PG8_WAIT_V(8); PG8_WAIT_L(0); PG8_BAR; PG8_MMA(1, 0, At, B0); PG8_MMA(1, 1, At, B1); PG8_BAR; PG8_SCHED;
            PG8_LDB(B0, 1, 0); PG8_LDB(B1, 1, 1); PG8_SCHED; PG8_LDA(At, 1, 0); PG8_STAGE_A(PG8_SA(0, 1), a2, 1, last);
            PG8_WAIT_V(8); PG8_WAIT_L(0); PG8_BAR; PG8_MMA(0, 0, At, B0); PG8_MMA(0, 1, At, B1); PG8_BAR; PG8_SCHED;
            PG8_LDA(At, 1, 1); PG8_STAGE(PG8_SB(1, 0), b3, voffB); PG8_STAGE(PG8_SB(1, 1), b3 + hstep, voffB); PG8_STAGE_A(PG8_SA(1, 0), a3, 0, last);
            PG8_WAIT_V(8); PG8_WAIT_L(0); PG8_BAR; PG8_MMA(1, 0, At, B0); PG8_MMA(1, 1, At, B1); PG8_BAR; PG8_SCHED;
        }
        if (wr == 0) PG8_BAR;
        E(acc, cur, wr, wc, fr, fq);
        if (!has_next) break;
#pragma unroll
        for (int a = 0; a < 2; ++a)
#pragma unroll
            for (int b = 0; b < 2; ++b)
#pragma unroll
                for (int m = 0; m < 4; ++m)
#pragma unroll
                    for (int n = 0; n < 2; ++n) acc[a][b][m][n] = (f32x4){0.f, 0.f, 0.f, 0.f};
        cur = nxt; cA = nA; cB = nB; ++ui;
        if constexpr (GATHER) { gC[0] = gN[0]; gC[1] = gN[1]; gC[2] = gN[2]; gC[3] = gN[3]; }
        if (wr == 1) PG8_BAR;
    }
    PG8_WAIT_V(0);
    PG8_BAR;
#undef PG8_SA
#undef PG8_SB
#undef PG8_STAGE
#undef PG8_STAGE_A
#undef PG8_LDA
#undef PG8_LDB
#undef PG8_MMA
#undef PG8_WAIT_V
#undef PG8_WAIT_L
#undef PG8_BAR
#undef PG8_SCHED
}
}
namespace mk {
using pg8::bf16_t; using pg8::f32x4; using pg8::u32x4; using pg8::u32x2; using pg8::Unit; using pg8::cvt_pk_bf16;
constexpr int D = 1024, NB = 8, SEQ = 2048, NMETA = 16, LSEQ = SEQ + NMETA;
constexpr int MR = NB * SEQ;
constexpr int MP = MR + 256;
constexpr int NKT = 33;
constexpr int NCF = 9, NCM = 12;
constexpr int NIN = 2304;
constexpr float EPS = 1e-6f;
constexpr float LOG2E = 1.4426950408889634f;
constexpr float C2F = 0.125f * LOG2E;
constexpr float C2M = 0.10206207261596577f * LOG2E;
constexpr int CAP = 16384;
constexpr int NSLOT = 40960;

constexpr size_t MiB = 1u << 20;
constexpr size_t WS_CTL = 0, CTL_BYTES = 1 * MiB;
constexpr int CW_BAR = 4096;
constexpr int CW_CNT = 8192;
constexpr int CW_SSQO = 65536;
constexpr int CW_SSQH = 98304;
constexpr size_t WS_WIN = 1 * MiB, WS_WUQ = 5632 * 1024, WS_WUKV = 6400 * 1024, WS_WO = 7 * MiB, WS_W13 = 9 * MiB, WS_W2 = 41 * MiB;
constexpr size_t WS_ROPE = 57 * MiB;
constexpr size_t WS_WR = 57 * MiB + 512 * 1024;
constexpr size_t WS_LOGF = 58 * MiB, WS_KR = WS_LOGF + 640 * 1024, WS_SSQCQ = WS_KR + 2176 * 1024, WS_SSQCKV = WS_SSQCQ + 640 * 1024, WS_SSQKR = WS_SSQCKV + 320 * 1024;
constexpr size_t WS_TOK = 62 * MiB, WS_LIST = 63 * MiB;
constexpr size_t WS_XN = 66 * MiB;
constexpr size_t WS_O = WS_XN;
constexpr size_t WS_QF = 100 * MiB, WS_KTF = 116 * MiB, WS_VTF = 135 * MiB, WS_CQ = 152 * MiB, WS_CKV = 165 * MiB, WS_QM = 174 * MiB, WS_KTM = 198 * MiB, WS_VTM = 223 * MiB;
constexpr size_t WS_XN2 = 100 * MiB, WS_HD = 132 * MiB, WS_Y = 152 * MiB;
constexpr size_t WS_SNAP = 240 * MiB;
static_assert(WS_WUQ >= WS_WIN + (size_t)NIN * 1024 * 2 && WS_WUKV >= WS_WUQ + 768 * 384 * 2 && WS_WO >= WS_WUKV + 1024 * 256 * 2, "ws map");
static_assert(WS_SSQKR + (size_t)MP * 4 <= WS_TOK && WS_XN + (size_t)MP * D * 2 <= WS_QF, "ws map");
static_assert(WS_KTF + (size_t)64 * NKT * NCF * 1024 <= WS_VTF && WS_VTF + (size_t)64 * NKT * 8192 <= WS_CQ && WS_CQ + (size_t)MP * 384 * 2 <= WS_CKV && WS_CKV + (size_t)MP * 256 * 2 <= WS_QM, "ws map");
static_assert(WS_QM + (size_t)MR * 768 * 2 <= WS_KTM && WS_KTM + (size_t)64 * NKT * NCM * 1024 <= WS_VTM && WS_VTM + (size_t)64 * NKT * 8192 <= WS_SNAP, "ws map");
static_assert(WS_HD + (size_t)NSLOT * 512 <= WS_Y && WS_Y + (size_t)NSLOT * 2048 <= WS_SNAP, "ws map");

__device__ __forceinline__ unsigned f2bf(float f) { unsigned u = __builtin_bit_cast(unsigned, f); return (u + 0x7fffu + ((u >> 16) & 1u)) >> 16; }
__device__ __forceinline__ float bf2f(unsigned short h) { return __builtin_bit_cast(float, (unsigned)h << 16); }
__device__ __forceinline__ float log_sigmoid(float x) { return fminf(x, 0.f) - log1pf(__expf(-fabsf(x))); }

struct Ptrs {
    const float *x, *meta, *g_attn, *w_in, *b_f, *g_fox_q, *g_fox_k, *g_q_lat, *w_uq, *g_kv_lat, *w_ukv, *g_mla_q, *g_mla_k, *g_fox_out, *g_mla_out, *w_o, *g_ffn, *w_group, *b_group, *w_expert, *b_expert, *w1, *w3, *w2;
    float* out; unsigned char* ws;
    __host__ __device__ __forceinline__ bf16_t* WIN() const { return (bf16_t*)(ws + WS_WIN); }
    __host__ __device__ __forceinline__ bf16_t* WUQ() const { return (bf16_t*)(ws + WS_WUQ); }
    __host__ __device__ __forceinline__ bf16_t* WUKV() const { return (bf16_t*)(ws + WS_WUKV); }
    __host__ __device__ __forceinline__ bf16_t* WO() const { return (bf16_t*)(ws + WS_WO); }
    __host__ __device__ __forceinline__ bf16_t* W13() const { return (bf16_t*)(ws + WS_W13); }
    __host__ __device__ __forceinline__ bf16_t* W2() const { return (bf16_t*)(ws + WS_W2); }
    __host__ __device__ __forceinline__ bf16_t* XN() const { return (bf16_t*)(ws + WS_XN); }
    __host__ __device__ __forceinline__ bf16_t* O() const { return (bf16_t*)(ws + WS_O); }
    __host__ __device__ __forceinline__ bf16_t* QF() const { return (bf16_t*)(ws + WS_QF); }
    __host__ __device__ __forceinline__ bf16_t* KTF() const { return (bf16_t*)(ws + WS_KTF); }
    __host__ __device__ __forceinline__ bf16_t* VTF() const { return (bf16_t*)(ws + WS_VTF); }
    __host__ __device__ __forceinline__ bf16_t* CQ() const { return (bf16_t*)(ws + WS_CQ); }
    __host__ __device__ __forceinline__ bf16_t* CKV() const { return (bf16_t*)(ws + WS_CKV); }
    __host__ __device__ __forceinline__ bf16_t* QM() const { return (bf16_t*)(ws + WS_QM); }
    __host__ __device__ __forceinline__ bf16_t* KTM() const { return (bf16_t*)(ws + WS_KTM); }
    __host__ __device__ __forceinline__ bf16_t* VTM() const { return (bf16_t*)(ws + WS_VTM); }
    __host__ __device__ __forceinline__ bf16_t* XN2() const { return (bf16_t*)(ws + WS_XN2); }
    __host__ __device__ __forceinline__ bf16_t* HD() const { return (bf16_t*)(ws + WS_HD); }
    __host__ __device__ __forceinline__ bf16_t* Y() const { return (bf16_t*)(ws + WS_Y); }
    __host__ __device__ __forceinline__ float* ROPE() const { return (float*)(ws + WS_ROPE); }
    __host__ __device__ __forceinline__ float* LOGF() const { return (float*)(ws + WS_LOGF); }
    __host__ __device__ __forceinline__ float* KR() const { return (float*)(ws + WS_KR); }
    __host__ __device__ __forceinline__ float* SSQCQ() const { return (float*)(ws + WS_SSQCQ); }
    __host__ __device__ __forceinline__ float* SSQCKV() const { return (float*)(ws + WS_SSQCKV); }
    __host__ __device__ __forceinline__ float* SSQKR() const { return (float*)(ws + WS_SSQKR); }
    __host__ __device__ __forceinline__ unsigned* ctl() const { return (unsigned*)(ws + WS_CTL); }
    __host__ __device__ __forceinline__ float* SSQO() const { return (float*)(ws + WS_CTL) + CW_SSQO; }
    __host__ __device__ __forceinline__ float* SSQH() const { return (float*)(ws + WS_CTL) + CW_SSQH; }
    __host__ __device__ __forceinline__ bf16_t* WR() const { return (bf16_t*)(ws + WS_WR); }
    __host__ __device__ __forceinline__ int* LIST() const { return (int*)(ws + WS_LIST); }
    __host__ __device__ __forceinline__ unsigned* TOK() const { return (unsigned*)(ws + WS_TOK); }
};

__device__ __forceinline__ size_t kt_off(int bh, int s, int chunk, int NC) { return ((((size_t)bh * NKT + (s >> 6)) * NC + chunk) * 64 + (s & 63)) * 8; }
__device__ __forceinline__ size_t vt_off(int bh, int s, int dhalf, int d32) { return (((size_t)bh * NKT + (s >> 6)) * 4096) + dhalf * 2048 + ((s >> 4) & 3) * 512 + (s & 15) * 32 + d32; }

struct EpiInProj {
    static constexpr bool PERM = true;
    Ptrs P;
    __device__ __forceinline__ void operator()(const f32x4 (&acc)[2][2][4][2], const Unit& u, int wr, int wc, int fr, int fq) const {
        const int pn = u.pn; const bool meta = (u.pm == MR / 256);
        const int rowb = u.pm * 256 + wr * 64 + fr;
        if (pn < 6) {
            const int head = 4 * (pn & 1) + wc;
            f32x4 gv[2][2];
            if (pn < 4) { const float* g = pn < 2 ? P.g_fox_q : P.g_fox_k; const float sc = pn < 2 ? C2F : 1.0f;
#pragma unroll
                for (int bj = 0; bj < 2; ++bj)
#pragma unroll
                    for (int n = 0; n < 2; ++n) gv[bj][n] = *(const f32x4*)(g + 32 * bj + 8 * fq + 4 * n) * sc; }
#pragma unroll
            for (int ai = 0; ai < 2; ++ai)
#pragma unroll
                for (int m = 0; m < 4; ++m) {
                    const int row = rowb + ai * 128 + m * 16;
                    float rs = 1.0f;
                    if (pn < 4) { float ss = 0.f;
#pragma unroll
                        for (int bj = 0; bj < 2; ++bj)
#pragma unroll
                            for (int n = 0; n < 2; ++n) { const f32x4 v = acc[ai][bj][m][n]; ss += (v[0] * v[0] + v[1] * v[1]) + (v[2] * v[2] + v[3] * v[3]); }
                        ss += __shfl_xor(ss, 16); ss += __shfl_xor(ss, 32);
                        rs = 1.0f / sqrtf(ss * (1.0f / 64.0f) + EPS); }
                    u32x4 w[2];
#pragma unroll
                    for (int bj = 0; bj < 2; ++bj) { f32x4 v0 = acc[ai][bj][m][0], v1 = acc[ai][bj][m][1];
                        if (pn < 4) { v0 = v0 * rs * gv[bj][0]; v1 = v1 * rs * gv[bj][1]; }
                        w[bj].x = cvt_pk_bf16(v0[0], v0[1]); w[bj].y = cvt_pk_bf16(v0[2], v0[3]); w[bj].z = cvt_pk_bf16(v1[0], v1[1]); w[bj].w = cvt_pk_bf16(v1[2], v1[3]); }
                    if (pn < 2) { if (!meta) {
#pragma unroll
                            for (int bj = 0; bj < 2; ++bj) *(u32x4*)(P.QF() + (size_t)row * 512 + head * 64 + 32 * bj + 8 * fq) = w[bj]; } }
                    else {
                        int b0, b1, s;
                        if (!meta) { b0 = row >> 11; b1 = b0 + 1; s = NMETA + (row & 2047); } else { const int r = row - MR; s = r; b0 = 0; b1 = r < NMETA ? NB : 0; }
                        for (int b = b0; b < b1; ++b) { const int bh = b * 8 + head;
#pragma unroll
                            for (int bj = 0; bj < 2; ++bj) {
                                if (pn < 4) *(u32x4*)(P.KTF() + kt_off(bh, s, 4 * bj + fq, NCF)) = w[bj];
                                else *(u32x4*)(P.VTF() + vt_off(bh, s, bj, 8 * fq)) = w[bj]; } }
                    }
                }
        } else {
            int kind, colb, slot;
            if (pn == 6) { kind = 0; colb = 64 * wc; slot = wc; }
            else if (pn == 7) { if (wc < 2) { kind = 0; colb = 256 + 64 * wc; slot = 4 + wc; } else { kind = 1; colb = 64 * (wc - 2); slot = wc - 2; } }
            else { if (wc < 2) { kind = 1; colb = 128 + 64 * wc; slot = 2 + wc; } else if (wc == 2) { kind = 2; colb = 0; slot = 0; } else { kind = 3; colb = 0; slot = 0; } }
            if (kind == 3) return;
#pragma unroll
            for (int ai = 0; ai < 2; ++ai)
#pragma unroll
                for (int m = 0; m < 4; ++m) {
                    const int row = rowb + ai * 128 + m * 16;
                    if (kind < 2) {
                        float ss = 0.f;
#pragma unroll
                        for (int bj = 0; bj < 2; ++bj)
#pragma unroll
                            for (int n = 0; n < 2; ++n) { const f32x4 v = acc[ai][bj][m][n]; ss += (v[0] * v[0] + v[1] * v[1]) + (v[2] * v[2] + v[3] * v[3]); }
                        ss += __shfl_xor(ss, 16); ss += __shfl_xor(ss, 32);
                        bf16_t* dst = kind == 0 ? P.CQ() + (size_t)row * 384 + colb : P.CKV() + (size_t)row * 256 + colb;
#pragma unroll
                        for (int bj = 0; bj < 2; ++bj) { const f32x4 v0 = acc[ai][bj][m][0], v1 = acc[ai][bj][m][1]; u32x4 w;
                            w.x = cvt_pk_bf16(v0[0], v0[1]); w.y = cvt_pk_bf16(v0[2], v0[3]); w.z = cvt_pk_bf16(v1[0], v1[1]); w.w = cvt_pk_bf16(v1[2], v1[3]);
                            *(u32x4*)(dst + 32 * bj + 8 * fq) = w; }
                        if (fq == 0) { if (kind == 0) P.SSQCQ()[(size_t)row * 8 + slot] = ss; else P.SSQCKV()[(size_t)row * 4 + slot] = ss; }
                    } else {
                        float ss = 0.f;
#pragma unroll
                        for (int n = 0; n < 2; ++n) { const f32x4 v = acc[ai][0][m][n]; ss += (v[0] * v[0] + v[1] * v[1]) + (v[2] * v[2] + v[3] * v[3]); *(f32x4*)(P.KR() + (size_t)row * 32 + 8 * fq + 4 * n) = v; }
                        ss += __shfl_xor(ss, 16); ss += __shfl_xor(ss, 32);
                        if (fq == 0) { P.SSQKR()[row] = ss;
#pragma unroll
                            for (int n = 0; n < 2; ++n) { const f32x4 v = acc[ai][1][m][n]; const f32x4 bf = *(const f32x4*)(P.b_f + 4 * n); f32x4 o;
                                o[0] = log_sigmoid(v[0] + bf[0]); o[1] = log_sigmoid(v[1] + bf[1]); o[2] = log_sigmoid(v[2] + bf[2]); o[3] = log_sigmoid(v[3] + bf[3]);
                                *(f32x4*)(P.LOGF() + (size_t)row * 8 + 4 * n) = o; } }
                    }
                }
        }
    }
};

struct EpiQup {
    static constexpr bool PERM = true;
    Ptrs P;
    __device__ __forceinline__ void operator()(const f32x4 (&acc)[2][2][4][2], const Unit& u, int wr, int wc, int fr, int fq) const {
        const int rowb = u.pm * 256 + wr * 64 + fr, col0 = u.pn * 256 + wc * 32 + 8 * fq;
#pragma unroll
        for (int ai = 0; ai < 2; ++ai)
#pragma unroll
            for (int m = 0; m < 4; ++m) {
                const int row = rowb + ai * 128 + m * 16;
                const f32x4 s0 = *(const f32x4*)(P.SSQCQ() + (size_t)row * 8); const float s4 = P.SSQCQ()[(size_t)row * 8 + 4], s5 = P.SSQCQ()[(size_t)row * 8 + 5];
                const float rs = 1.0f / sqrtf(((s0[0] + s0[1]) + (s0[2] + s0[3]) + (s4 + s5)) * (1.0f / 384.0f) + EPS);
#pragma unroll
                for (int bj = 0; bj < 2; ++bj) { const f32x4 v0 = acc[ai][bj][m][0] * rs, v1 = acc[ai][bj][m][1] * rs; u32x4 w;
                    w.x = cvt_pk_bf16(v0[0], v0[1]); w.y = cvt_pk_bf16(v0[2], v0[3]); w.z = cvt_pk_bf16(v1[0], v1[1]); w.w = cvt_pk_bf16(v1[2], v1[3]);
                    *(u32x4*)(P.QM() + (size_t)row * 768 + col0 + 128 * bj) = w; }
            }
    }
};

struct EpiKvup {
    static constexpr bool PERM = true;
    Ptrs P;
    __device__ __forceinline__ void operator()(const f32x4 (&acc)[2][2][4][2], const Unit& u, int wr, int wc, int fr, int fq) const {
        const bool meta = (u.pm == MR / 256);
        const int rowb = u.pm * 256 + wr * 64 + fr, head = 2 * u.pn + (wc >> 1); const bool isk = (wc & 1) == 0;
        f32x4 gv[2][2], gr[2];
        if (isk) {
#pragma unroll
            for (int bj = 0; bj < 2; ++bj)
#pragma unroll
                for (int n = 0; n < 2; ++n) gv[bj][n] = *(const f32x4*)(P.g_mla_k + 32 * bj + 8 * fq + 4 * n);
            gr[0] = *(const f32x4*)(P.g_mla_k + 64 + 4 * fq); gr[1] = *(const f32x4*)(P.g_mla_k + 80 + 4 * fq); }
#pragma unroll
        for (int ai = 0; ai < 2; ++ai)
#pragma unroll
            for (int m = 0; m < 4; ++m) {
                const int row = rowb + ai * 128 + m * 16;
                const f32x4 sk = *(const f32x4*)(P.SSQCKV() + (size_t)row * 4);
                const float rl = 1.0f / sqrtf(((sk[0] + sk[1]) + (sk[2] + sk[3])) * (1.0f / 256.0f) + EPS);
                f32x4 v[2][2];
#pragma unroll
                for (int bj = 0; bj < 2; ++bj)
#pragma unroll
                    for (int n = 0; n < 2; ++n) v[bj][n] = acc[ai][bj][m][n] * rl;
                int b0, b1, s;
                if (!meta) { b0 = row >> 11; b1 = b0 + 1; s = NMETA + (row & 2047); } else { const int r = row - MR; s = r < NMETA ? r : 0; b0 = 0; b1 = r < NMETA ? NB : 0; }
                if (isk) {
                    float ss = 0.f;
#pragma unroll
                    for (int bj = 0; bj < 2; ++bj)
#pragma unroll
                        for (int n = 0; n < 2; ++n) { const f32x4 q = v[bj][n]; ss += (q[0] * q[0] + q[1] * q[1]) + (q[2] * q[2] + q[3] * q[3]); }
                    ss += __shfl_xor(ss, 16); ss += __shfl_xor(ss, 32);
                    ss += P.SSQKR()[row];
                    const float rk = 1.0f / sqrtf(ss * (1.0f / 96.0f) + EPS);
                    u32x4 w[2];
#pragma unroll
                    for (int bj = 0; bj < 2; ++bj) { const f32x4 v0 = v[bj][0] * rk * gv[bj][0], v1 = v[bj][1] * rk * gv[bj][1];
                        w[bj].x = cvt_pk_bf16(v0[0], v0[1]); w[bj].y = cvt_pk_bf16(v0[2], v0[3]); w[bj].z = cvt_pk_bf16(v1[0], v1[1]); w[bj].w = cvt_pk_bf16(v1[2], v1[3]); }
                    const f32x4 x1 = *(const f32x4*)(P.KR() + (size_t)row * 32 + 4 * fq) * rk * gr[0], x2 = *(const f32x4*)(P.KR() + (size_t)row * 32 + 16 + 4 * fq) * rk * gr[1];
                    const f32x4 cs0 = *(const f32x4*)(P.ROPE() + ((size_t)s * 16 + 4 * fq) * 2), cs1 = *(const f32x4*)(P.ROPE() + ((size_t)s * 16 + 4 * fq) * 2 + 4);
                    const float c0 = cs0[0], n0 = cs0[1], c1 = cs0[2], n1 = cs0[3], c2 = cs1[0], n2 = cs1[1], c3 = cs1[2], n3 = cs1[3];
                    u32x2 r1, r2;
                    r1.x = cvt_pk_bf16(x1[0] * c0 - x2[0] * n0, x1[1] * c1 - x2[1] * n1); r1.y = cvt_pk_bf16(x1[2] * c2 - x2[2] * n2, x1[3] * c3 - x2[3] * n3);
                    r2.x = cvt_pk_bf16(x1[0] * n0 + x2[0] * c0, x1[1] * n1 + x2[1] * c1); r2.y = cvt_pk_bf16(x1[2] * n2 + x2[2] * c2, x1[3] * n3 + x2[3] * c3);
                    for (int b = b0; b < b1; ++b) { const int bh = b * 8 + head;
#pragma unroll
                        for (int bj = 0; bj < 2; ++bj) *(u32x4*)(P.KTM() + kt_off(bh, s, 4 * bj + fq, NCM)) = w[bj];
                        *(u32x2*)(P.KTM() + kt_off(bh, s, 8 + (fq >> 1), NCM) + 4 * (fq & 1)) = r1;
                        *(u32x2*)(P.KTM() + kt_off(bh, s, 10 + (fq >> 1), NCM) + 4 * (fq & 1)) = r2; }
                } else {
                    u32x4 w[2];
#pragma unroll
                    for (int bj = 0; bj < 2; ++bj) { const f32x4 v0 = v[bj][0], v1 = v[bj][1];
                        w[bj].x = cvt_pk_bf16(v0[0], v0[1]); w[bj].y = cvt_pk_bf16(v0[2], v0[3]); w[bj].z = cvt_pk_bf16(v1[0], v1[1]); w[bj].w = cvt_pk_bf16(v1[2], v1[3]); }
                    for (int b = b0; b < b1; ++b) { const int bh = b * 8 + head;
#pragma unroll
                        for (int bj = 0; bj < 2; ++bj) *(u32x4*)(P.VTM() + vt_off(bh, s, bj, 8 * fq)) = w[bj]; }
                }
            }
    }
};

struct EpiOut {
    static constexpr bool PERM = false;
    Ptrs P;
    __device__ __forceinline__ void rstds(int row, float& rf, float& rm) const {
        const float sf = P.SSQO()[(size_t)row * 2], sm = P.SSQO()[(size_t)row * 2 + 1];
        rf = 1.0f / sqrtf(sf * (1.0f / 512.0f) + EPS); rm = 1.0f / sqrtf(sm * (1.0f / 512.0f) + EPS);
    }
    __device__ __forceinline__ void mid(f32x4 (&acc)[2][2][4][2], const Unit& u, int wr, int fr) const {
#pragma unroll
        for (int ai = 0; ai < 2; ++ai)
#pragma unroll
            for (int m = 0; m < 4; ++m) { float rf, rm; rstds(u.pm * 256 + ai * 128 + wr * 64 + m * 16 + fr, rf, rm); const float ratio = rf / rm;
#pragma unroll
                for (int bj = 0; bj < 2; ++bj)
#pragma unroll
                    for (int n = 0; n < 2; ++n) acc[ai][bj][m][n] *= ratio; }
    }
    __device__ __forceinline__ void operator()(const f32x4 (&acc)[2][2][4][2], const Unit& u, int wr, int wc, int fr, int fq) const {
        const int col0 = u.pn * 256 + wc * 32 + 4 * fq;
#pragma unroll
        for (int ai = 0; ai < 2; ++ai)
#pragma unroll
            for (int m = 0; m < 4; ++m) { const int row = u.pm * 256 + ai * 128 + wr * 64 + m * 16 + fr; float rf, rm; rstds(row, rf, rm);
                const size_t off = (size_t)row * D + col0;
                float ss = 0.f;
#pragma unroll
                for (int bj = 0; bj < 2; ++bj)
#pragma unroll
                    for (int n = 0; n < 2; ++n) { const f32x4 xv = *(const f32x4*)(P.x + off + bj * 128 + n * 16); const f32x4 hv = xv + acc[ai][bj][m][n] * rm; *(f32x4*)(P.out + off + bj * 128 + n * 16) = hv;
                        ss += (hv[0] * hv[0] + hv[1] * hv[1]) + (hv[2] * hv[2] + hv[3] * hv[3]); }
                ss += __shfl_xor(ss, 16); ss += __shfl_xor(ss, 32);
                if (fq == 0) atomicAdd(P.SSQH() + row, ss); }
    }
};

struct EpiMoeUp {
    static constexpr bool PERM = true;
    Ptrs P;
    __device__ __forceinline__ void operator()(const f32x4 (&acc)[2][2][4][2], const Unit& u, int wr, int wc, int fr, int fq) const {
        const int col0 = (u.pn & 1) * 128 + wc * 32 + 8 * fq;
#pragma unroll
        for (int ai = 0; ai < 2; ++ai)
#pragma unroll
            for (int m = 0; m < 4; ++m) { const size_t row = (size_t)u.pm * 256 + ai * 128 + wr * 64 + m * 16 + fr; float h[8];
#pragma unroll
                for (int n = 0; n < 2; ++n)
#pragma unroll
                    for (int e = 0; e < 4; ++e) { const float a = acc[ai][0][m][n][e], b = acc[ai][1][m][n][e]; h[4 * n + e] = a * b / (1.0f + __expf(-a)); }
                u32x4 w; w.x = cvt_pk_bf16(h[0], h[1]); w.y = cvt_pk_bf16(h[2], h[3]); w.z = cvt_pk_bf16(h[4], h[5]); w.w = cvt_pk_bf16(h[6], h[7]);
                *(u32x4*)(P.HD() + row * 256 + col0) = w; }
    }
};
struct EpiMoeDown {
    static constexpr bool PERM = true;
    Ptrs P;
    __device__ __forceinline__ void operator()(const f32x4 (&acc)[2][2][4][2], const Unit& u, int wr, int wc, int fr, int fq) const {
        const int col0 = (u.pn & 3) * 256 + wc * 32 + 8 * fq;
#pragma unroll
        for (int ai = 0; ai < 2; ++ai)
#pragma unroll
            for (int m = 0; m < 4; ++m) { const size_t row = (size_t)u.pm * 256 + ai * 128 + wr * 64 + m * 16 + fr;
#pragma unroll
                for (int bj = 0; bj < 2; ++bj) { const f32x4 v0 = acc[ai][bj][m][0], v1 = acc[ai][bj][m][1]; u32x4 w;
                    w.x = cvt_pk_bf16(v0[0], v0[1]); w.y = cvt_pk_bf16(v0[2], v0[3]); w.z = cvt_pk_bf16(v1[0], v1[1]); w.w = cvt_pk_bf16(v1[2], v1[3]);
                    *(u32x4*)(P.Y() + row * 1024 + col0 + 128 * bj) = w; } }
    }
};
}
namespace mk {
typedef short bf16x8 __attribute__((ext_vector_type(8)));
typedef short s16x4 __attribute__((ext_vector_type(4)));
typedef float f32x16 __attribute__((ext_vector_type(16)));
#define MK_LAS __attribute__((address_space(3)))
__device__ __forceinline__ int crow(int r, int hi) { return (r & 3) + 8 * (r >> 2) + 4 * hi; }
__device__ __forceinline__ s16x4 vtr(const MK_LAS char* p) { typedef short v4 __attribute__((ext_vector_type(4))); return __builtin_bit_cast(s16x4, __builtin_amdgcn_ds_read_tr16_b64_v4i16((MK_LAS v4*)p)); }

__device__ __forceinline__ void glds16(const void* gsrc, unsigned lds_dst) { unsigned keep;
    asm volatile("s_mov_b32 %0, m0\n\ts_mov_b32 m0, %2\n\ts_nop 0\n\tglobal_load_lds_dwordx4 %1, off\n\ts_mov_b32 m0, %0" : "=&s"(keep) : "v"(gsrc), "s"(lds_dst) : "memory"); }

template <bool MLA>
__device__ __forceinline__ void attn_unit(MK_LAS unsigned char* lds, const Ptrs& P, int b, int h, int qb) {
    constexpr int NC = MLA ? NCM : NCF, NKS = MLA ? 6 : 5, KSL = NC * 1024, VSL = 8192;
    const int tid = threadIdx.x, lane = tid & 63, r32 = lane & 31, hi = lane >> 5; const int wid = __builtin_amdgcn_readfirstlane(tid >> 6);
    const int qi = qb * 256 + wid * 32 + r32;
    const size_t row = (size_t)b * SEQ + qi;
    const int bh = b * 8 + h;
    const bf16_t* Kt = (MLA ? P.KTM() : P.KTF()) + (size_t)bh * NKT * NC * 512;
    const bf16_t* Vt = (MLA ? P.VTM() : P.VTF()) + (size_t)bh * NKT * 4096;
    const int NT = 4 * qb + 5;
    const unsigned lds0 = (unsigned)(uintptr_t)lds;
#define MK_DMA(t, buf) do { \
        for (int p_ = wid; p_ < NC; p_ += 8) glds16(Kt + (size_t)(t) * NC * 512 + p_ * 512 + lane * 8, (unsigned)__builtin_amdgcn_readfirstlane(lds0 + (buf) * KSL + p_ * 1024)); \
        glds16(Vt + (size_t)(t) * 4096 + wid * 512 + lane * 8, (unsigned)__builtin_amdgcn_readfirstlane(lds0 + 4 * KSL + (buf) * VSL + wid * 1024)); } while (0)
    MK_DMA(0, 0); MK_DMA(1, 1);
    bf16x8 qf[NKS];
    if constexpr (!MLA) {
        const bf16_t* qp = P.QF() + row * 512 + h * 64 + hi * 8;
#pragma unroll
        for (int d0 = 0; d0 < 4; ++d0) qf[d0] = *(const bf16x8*)(qp + d0 * 16);
        const short one = (short)0x3F80;
        qf[4] = hi == 0 ? (bf16x8){one, one, one, 0, 0, 0, 0, 0} : (bf16x8){0, 0, 0, 0, 0, 0, 0, 0};
    } else {
        const bf16_t* qp = P.QM() + row * 768 + h * 96 + hi * 8;
        float v[6][8]; float ss = 0.f;
#pragma unroll
        for (int d0 = 0; d0 < 6; ++d0) { const bf16x8 raw = *(const bf16x8*)(qp + d0 * 16);
#pragma unroll
            for (int j = 0; j < 8; ++j) { v[d0][j] = bf2f((unsigned short)raw[j]); ss += v[d0][j] * v[d0][j]; } }
        ss += __shfl_xor(ss, 32);
        const float rs = 1.0f / sqrtf(ss * (1.0f / 96.0f) + EPS);
#pragma unroll
        for (int d0 = 0; d0 < 6; ++d0)
#pragma unroll
            for (int j = 0; j < 8; ++j) v[d0][j] *= rs * P.g_mla_q[16 * d0 + 8 * hi + j];
        const float* cs = P.ROPE() + ((size_t)(NMETA + qi) * 16 + 8 * hi) * 2;
#pragma unroll
        for (int j = 0; j < 8; ++j) { const float c = cs[2 * j], s = cs[2 * j + 1], x1 = v[4][j], x2 = v[5][j]; v[4][j] = x1 * c - x2 * s; v[5][j] = x1 * s + x2 * c; }
#pragma unroll
        for (int d0 = 0; d0 < 6; ++d0) { u32x4 w; w.x = cvt_pk_bf16(v[d0][0] * C2M, v[d0][1] * C2M); w.y = cvt_pk_bf16(v[d0][2] * C2M, v[d0][3] * C2M); w.z = cvt_pk_bf16(v[d0][4] * C2M, v[d0][5] * C2M); w.w = cvt_pk_bf16(v[d0][6] * C2M, v[d0][7] * C2M);
            qf[d0] = __builtin_bit_cast(bf16x8, w); }
    }
    constexpr float THR = 8.0f;
    float mhat = 0.f, lrow = 0.f; f32x16 o0 = {}, o1 = {}, negm = {};
    bf16x8 pw[4] = {};
    const int sq = NMETA + qi;
    const bool late = wid >= 4;
    const MK_LAS char* kp0 = (const MK_LAS char*)lds + hi * 1024 + r32 * 16;
    const MK_LAS char* kpa = (const MK_LAS char*)lds + 8 * 1024 + r32 * 16;
    const MK_LAS char* vp0 = (const MK_LAS char*)lds + 4 * KSL + ((lane >> 4) & 1) * 32 + (lane & 3) * 8 + (4 * hi + ((lane & 15) >> 2)) * 64;
    const bool two_k = wid < NC - 8;
#define MK_PV(slot) do { const MK_LAS char* vp_ = vp0 + (slot) * VSL; \
        _Pragma("unroll") for (int ks_ = 0; ks_ < 4; ++ks_) { \
            const s16x4 l0_ = vtr(vp_ + ks_ * 1024), h0_ = vtr(vp_ + ks_ * 1024 + 512), l1_ = vtr(vp_ + 4096 + ks_ * 1024), h1_ = vtr(vp_ + 4096 + ks_ * 1024 + 512); \
            const bf16x8 vf0_ = {l0_[0], l0_[1], l0_[2], l0_[3], h0_[0], h0_[1], h0_[2], h0_[3]}, vf1_ = {l1_[0], l1_[1], l1_[2], l1_[3], h1_[0], h1_[1], h1_[2], h1_[3]}; \
            o0 = __builtin_amdgcn_mfma_f32_32x32x16_bf16(vf0_, pw[ks_], o0, 0, 0, 0); \
            o1 = __builtin_amdgcn_mfma_f32_32x32x16_bf16(vf1_, pw[ks_], o1, 0, 0, 0); } } while (0)
    asm volatile("s_waitcnt vmcnt(0)" ::: "memory");
#pragma unroll
    for (int ks = 0; ks < NKS; ++ks) asm volatile("" : "+v"(qf[ks]));
    __syncthreads();
#pragma unroll 1
    for (int t = 0; t < NT; ++t) {
        const int buf = t & 3;
        if (t + 2 < NT) MK_DMA(t + 2, (t + 2) & 3);
        if (late && t > 0) MK_PV((t - 1) & 3);
        f32x16 p0, p1;
#pragma unroll
        for (int ks = 0; ks < NKS; ++ks) {
            const MK_LAS char* kp = (!MLA && ks == 4) ? kpa + buf * KSL : kp0 + buf * KSL + ks * 2048;
            const bf16x8 k0 = *(const MK_LAS bf16x8*)kp, k1 = *(const MK_LAS bf16x8*)(kp + 512);
            p0 = __builtin_amdgcn_mfma_f32_32x32x16_bf16(k0, qf[ks], ks == 0 ? negm : p0, 0, 0, 0);
            p1 = __builtin_amdgcn_mfma_f32_32x32x16_bf16(k1, qf[ks], ks == 0 ? negm : p1, 0, 0, 0);
        }
        if (t >= NT - 5) {
            const int kb = 64 * t + 4 * hi;
#pragma unroll
            for (int r = 0; r < 16; ++r) { const int s = kb + (r & 3) + 8 * (r >> 2); if (s > sq) p0[r] = -INFINITY; if (s + 32 > sq) p1[r] = -INFINITY; }
        }
        float ra = fmaxf(fmaxf(p0[0], p0[1]), p1[0]), rb = fmaxf(fmaxf(p0[2], p0[3]), p1[1]); ra = fmaxf(fmaxf(ra, p1[2]), p1[3]);
#pragma unroll
        for (int r = 4; r < 16; r += 4) { ra = fmaxf(fmaxf(ra, p0[r]), p0[r + 1]); rb = fmaxf(fmaxf(rb, p0[r + 2]), p0[r + 3]); ra = fmaxf(fmaxf(ra, p1[r]), p1[r + 1]); rb = fmaxf(fmaxf(rb, p1[r + 2]), p1[r + 3]); }
        float rm = fmaxf(ra, rb); rm = fmaxf(rm, __shfl_xor(rm, 32));
        if (__any(rm > THR)) { const float dl = fmaxf(rm, 0.f); mhat += dl;
#pragma unroll
            for (int r = 0; r < 16; ++r) { p0[r] -= dl; p1[r] -= dl; negm[r] = -mhat; }
            const float f = __builtin_amdgcn_exp2f(-dl); lrow *= f;
#pragma unroll
            for (int r = 0; r < 16; ++r) { o0[r] *= f; o1[r] *= f; } }
        float rsum = 0.f;
#pragma unroll
        for (int r = 0; r < 16; ++r) { p0[r] = __builtin_amdgcn_exp2f(p0[r]); p1[r] = __builtin_amdgcn_exp2f(p1[r]); rsum += p0[r] + p1[r]; }
        lrow += rsum;
#pragma unroll
        for (int k = 0; k < 2; ++k) { u32x4 a, c;
            a.x = cvt_pk_bf16(p0[8 * k + 0], p0[8 * k + 1]); a.y = cvt_pk_bf16(p0[8 * k + 2], p0[8 * k + 3]); a.z = cvt_pk_bf16(p0[8 * k + 4], p0[8 * k + 5]); a.w = cvt_pk_bf16(p0[8 * k + 6], p0[8 * k + 7]);
            c.x = cvt_pk_bf16(p1[8 * k + 0], p1[8 * k + 1]); c.y = cvt_pk_bf16(p1[8 * k + 2], p1[8 * k + 3]); c.z = cvt_pk_bf16(p1[8 * k + 4], p1[8 * k + 5]); c.w = cvt_pk_bf16(p1[8 * k + 6], p1[8 * k + 7]);
            pw[k] = __builtin_bit_cast(bf16x8, a); pw[2 + k] = __builtin_bit_cast(bf16x8, c); }
        if (!late) MK_PV(buf);
        if (t + 2 < NT) { if (two_k) asm volatile("s_waitcnt vmcnt(3) lgkmcnt(0)\n\ts_barrier" ::: "memory"); else asm volatile("s_waitcnt vmcnt(2) lgkmcnt(0)\n\ts_barrier" ::: "memory"); }
        else asm volatile("s_waitcnt vmcnt(0) lgkmcnt(0)\n\ts_barrier" ::: "memory");
    }
    if (late) MK_PV((NT - 1) & 3);
    asm volatile("s_waitcnt lgkmcnt(0)\n\ts_barrier" ::: "memory");
#undef MK_PV
#undef MK_DMA
    lrow += __shfl_xor(lrow, 32);
    const float inv = 1.0f / lrow; float ssq = 0.f;
    bf16_t* op = P.O() + row * 1024 + (MLA ? 512 : 0) + h * 64 + 4 * hi;
#pragma unroll
    for (int g = 0; g < 4; ++g) {
        const float a0 = o0[4 * g] * inv, a1 = o0[4 * g + 1] * inv, a2 = o0[4 * g + 2] * inv, a3 = o0[4 * g + 3] * inv;
        const float c0 = o1[4 * g] * inv, c1 = o1[4 * g + 1] * inv, c2 = o1[4 * g + 2] * inv, c3 = o1[4 * g + 3] * inv;
        ssq += (a0 * a0 + a1 * a1) + (a2 * a2 + a3 * a3) + (c0 * c0 + c1 * c1) + (c2 * c2 + c3 * c3);
        u32x2 w0, w1; w0.x = cvt_pk_bf16(a0, a1); w0.y = cvt_pk_bf16(a2, a3); w1.x = cvt_pk_bf16(c0, c1); w1.y = cvt_pk_bf16(c2, c3);
        *(u32x2*)(op + 8 * g) = w0; *(u32x2*)(op + 32 + 8 * g) = w1;
    }
    ssq += __shfl_xor(ssq, 32);
    if (hi == 0) atomicAdd(P.SSQO() + row * 2 + (MLA ? 1 : 0), ssq);
}

__device__ __forceinline__ void attn_phase(MK_LAS unsigned char* lds, const Ptrs& P, int vcu, int G) {
    for (int id = vcu; id < 1024; id += G) {
        const int v = id & 255, k = id >> 8, bh = v >> 2, sub = v & 3, qb = (k & 1) ? sub : 7 - sub;
        if (k >> 1) attn_unit<true>(lds, P, bh >> 3, bh & 7, qb); else attn_unit<false>(lds, P, bh >> 3, bh & 7, qb);
    }
}
}
namespace mk {
constexpr int NWAVES = 8;
constexpr int RING_BYTES = 131072, LDSCTL_OFF = RING_BYTES, LDS_BYTES = 147456;
#define GAS __attribute__((address_space(1)))
#define RLX_AGENT __ATOMIC_RELAXED, __HIP_MEMORY_SCOPE_AGENT
#define LDS_WAIT() asm volatile("s_waitcnt lgkmcnt(0)" ::: "memory")

#define XB_TMO      128
#define XB_XCNT(j)  (256  + 64 * (j))
#define XB_XSUB(j)  (1280 + 64 * (j))
#define XB_XGEN(j)  (2304 + 64 * (j))
#define XB_TOP      3328
#define XB_TOPGEN   3392
#define XCD_BAR_WORDS 3456
#define XB_SPIN_CAP (1u << 18)
__device__ __forceinline__ unsigned xb_ld(unsigned* p)              { return __hip_atomic_load(p, __ATOMIC_RELAXED, __HIP_MEMORY_SCOPE_AGENT); }
__device__ __forceinline__ unsigned xb_add(unsigned* p, unsigned v) { return __hip_atomic_fetch_add(p, v, __ATOMIC_RELAXED, __HIP_MEMORY_SCOPE_AGENT); }
__device__ __forceinline__ unsigned xb_xcc_id() { return (unsigned)__builtin_amdgcn_s_getreg((3 << 11) | 20) & 0xFu; }
#define XB_SPIN(cond, bar) do { unsigned _sp = 0; while (cond) { __builtin_amdgcn_s_sleep(1); \
    if ((++_sp & 255u) == 0u) { if (xb_ld(&(bar)[XB_TMO])) break; if (_sp > XB_SPIN_CAP) { atomicAdd(&(bar)[XB_TMO], 1u); break; } } } } while (0)
struct XcdBarrier { unsigned* bar; unsigned x; volatile MK_LAS unsigned* st; };
__device__ __forceinline__ XcdBarrier xcd_barrier_post(unsigned* bar, volatile MK_LAS unsigned* st) {
    XcdBarrier b; b.bar = bar; b.x = xb_xcc_id(); b.st = st;
    if (threadIdx.x == 0) (void)xb_add(&bar[XB_XCNT(b.x)], 1u);
    return b;
}
__device__ __forceinline__ void xcd_barrier_complete(unsigned* bar, unsigned x, unsigned& nloc, unsigned& nx) {
    const unsigned G = gridDim.x * gridDim.y * gridDim.z;
    unsigned sum, cnt, mine, sp = 0u;
    for (;;) {
        sum = 0u; cnt = 0u; mine = 0u;
#pragma unroll
        for (unsigned j = 0; j < 16; ++j) { const unsigned c = xb_ld(&bar[XB_XCNT(j)]); sum += c; cnt += (c > 0u) ? 1u : 0u; mine = (j == x) ? c : mine; }
        if (sum == G) break;
        __builtin_amdgcn_s_sleep(1);
        if ((++sp & 255u) == 0u) { if (xb_ld(&bar[XB_TMO])) break; if (sp > XB_SPIN_CAP) { atomicAdd(&bar[XB_TMO], 1u); break; } }
    }
    nloc = mine > 0u ? mine : 1u; nx = cnt > 0u ? cnt : 1u;
}
__device__ __forceinline__ void xcd_barrier(const XcdBarrier& b) {
    asm volatile("s_waitcnt vmcnt(0)" ::: "memory");
    __syncthreads();
    if (threadIdx.x == 0) {
        unsigned* bar = b.bar;
        __builtin_amdgcn_s_waitcnt(0);
        unsigned nloc = b.st[0], nx = b.st[1];
        if (nloc == 0u) { xcd_barrier_complete(bar, b.x, nloc, nx); b.st[0] = nloc; b.st[1] = nx; }
        const unsigned old = xb_add(&bar[XB_XSUB(b.x)], 1u);
        const unsigned gen = old / nloc;
        if (old + 1u == (gen + 1u) * nloc) {
            __builtin_amdgcn_fence(__ATOMIC_RELEASE, "agent");
            asm volatile("s_waitcnt vmcnt(0)" ::: "memory");
            const unsigned og = xb_add(&bar[XB_TOP], 1u);
            const unsigned tg = og / nx;
            if (og + 1u == (tg + 1u) * nx) xb_add(&bar[XB_TOPGEN], 1u);
            else XB_SPIN(xb_ld(&bar[XB_TOPGEN]) == tg, bar);
            __builtin_amdgcn_fence(__ATOMIC_ACQUIRE, "agent");
            xb_add(&bar[XB_XGEN(b.x)], 1u);
            asm volatile("s_waitcnt vmcnt(0)" ::: "memory");
        } else {
            XB_SPIN(xb_ld(&bar[XB_XGEN(b.x)]) == gen, bar);
            __builtin_amdgcn_fence(__ATOMIC_ACQUIRE, "agent");
            asm volatile("s_waitcnt vmcnt(0)" ::: "memory");
        }
    }
    __syncthreads();
}

__device__ __forceinline__ float wave_sum(float v) {
#pragma unroll
    for (int o = 1; o < 64; o <<= 1) v += __shfl_xor(v, o);
    return v;
}
__device__ __forceinline__ unsigned pk2(float lo, float hi) { return f2bf(lo) | (f2bf(hi) << 16); }

struct P0Item { const float* W; const float* gk; bf16_t* WT; int ldw, col0, nvalid, K, n0, k0; };
__device__ __forceinline__ P0Item p0_decode(const Ptrs& P, int it) {
    constexpr int I_IN = 16 * 72, I_UQ = 6 * 24, I_UKV = 4 * 32, I_O = 16 * 32, I_13 = 32 * 256;
    P0Item d; int r = it; d.gk = nullptr; d.nvalid = 32;
    if (r < I_IN) { const int kb = r / 72, nb = r % 72, n0 = 32 * nb, pn = n0 >> 8, wi = n0 & 255, bj = wi >> 7, wc = (wi >> 5) & 3, LG = 256 * pn + 64 * wc + 32 * bj;
        int src = 0, nv = 32;
        if (LG < 1536) src = LG; else if (LG < 1920) src = 1544 + (LG - 1536); else if (LG < 2176) src = 1928 + (LG - 1920); else if (LG < 2208) src = 2184 + (LG - 2176); else if (LG == 2208) { src = 1536; nv = 8; } else nv = 0;
        d.W = P.w_in; d.ldw = 2216; d.col0 = src; d.nvalid = nv; d.WT = P.WIN(); d.K = 1024; d.n0 = n0; d.k0 = 64 * kb; return d; } r -= I_IN;
    if (r < I_UQ) { const int kb = r / 24, nb = r % 24; d.W = P.w_uq; d.ldw = 768; d.col0 = 32 * nb; d.gk = P.g_q_lat + 64 * kb; d.WT = P.WUQ(); d.K = 384; d.n0 = 32 * nb; d.k0 = 64 * kb; return d; } r -= I_UQ;
    if (r < I_UKV) { const int kb = r / 32, nb = r % 32, n0 = 32 * nb, pn = n0 >> 8, bj = (n0 >> 7) & 1, wc = (n0 >> 5) & 3;
        d.W = P.w_ukv; d.ldw = 1024; d.col0 = (2 * pn + (wc >> 1)) * 128 + (wc & 1) * 64 + 32 * bj; d.gk = P.g_kv_lat + 64 * kb; d.WT = P.WUKV(); d.K = 256; d.n0 = n0; d.k0 = 64 * kb; return d; } r -= I_UKV;
    if (r < I_O) { const int kb = r / 32, nb = r % 32; d.W = P.w_o; d.ldw = 1024; d.col0 = 32 * nb; d.gk = kb < 8 ? P.g_fox_out + 64 * kb : P.g_mla_out + 64 * (kb - 8); d.WT = P.WO(); d.K = 1024; d.n0 = 32 * nb; d.k0 = 64 * kb; return d; } r -= I_O;
    if (r < I_13) { const int e = r >> 8, rr = r & 255, kb = rr >> 4, nb = rr & 15, n0 = 32 * nb, pn = n0 >> 8, bj = (n0 >> 7) & 1, wc = (n0 >> 5) & 3;
        d.W = (bj ? P.w3 : P.w1) + (size_t)e * 262144; d.ldw = 256; d.col0 = 128 * pn + 32 * wc; d.WT = P.W13() + (size_t)e * 524288; d.K = 1024; d.n0 = n0; d.k0 = 64 * kb; return d; } r -= I_13;
    { const int e = r >> 7, rr = r & 127, kb = rr >> 5, nb = rr & 31; d.W = P.w2 + (size_t)e * 262144; d.ldw = 1024; d.col0 = 32 * nb; d.WT = P.W2() + (size_t)e * 262144; d.K = 256; d.n0 = 32 * nb; d.k0 = 64 * kb; return d; }
}
constexpr int P0_NITEMS = 16 * 72 + 6 * 24 + 4 * 32 + 16 * 32 + 32 * 256 + 32 * 128;
constexpr int P0_FIRST_MOE = 16 * 72 + 6 * 24 + 4 * 32 + 16 * 32;
__device__ __forceinline__ void p0_load(const P0Item& d, float (&v)[32], int lane) {
    const int c = lane & 31; const float* src = d.W + (size_t)(d.k0 + (lane >> 5)) * d.ldw + d.col0 + c; const bool ok = c < d.nvalid;
#pragma unroll
    for (int i = 0; i < 32; ++i) v[i] = ok ? src[(size_t)(2 * i) * d.ldw] : 0.f;
}
__device__ __forceinline__ void p0_finish(const P0Item& d, const float (&v)[32], MK_LAS float* scr, int lane) {
    const int c = lane & 31;
#pragma unroll
    for (int i = 0; i < 32; ++i) { const int kk = 2 * i + (lane >> 5); float x = v[i]; if (d.gk) x *= d.gk[kk]; scr[kk * 33 + c] = x; }
    LDS_WAIT(); asm volatile("" ::: "memory");
    const int ch = lane & 7;
#pragma unroll
    for (int j = 0; j < 4; ++j) { const int n = (lane >> 3) + 8 * j; const MK_LAS float* s = scr + (8 * ch) * 33 + n;
        u32x4 o; o.x = pk2(s[0 * 33], s[1 * 33]); o.y = pk2(s[2 * 33], s[3 * 33]); o.z = pk2(s[4 * 33], s[5 * 33]); o.w = pk2(s[6 * 33], s[7 * 33]);
        *(GAS u32x4*)(d.WT + (size_t)(d.n0 + n) * d.K + d.k0 + 8 * ch) = o; }
    LDS_WAIT(); asm volatile("" ::: "memory");
}
__device__ __forceinline__ void p0_convert(const Ptrs& P, MK_LAS float* scr, int first, int step, int end, int lane) {
    if (first >= end) return;
    float va[32], vb[32]; P0Item da = p0_decode(P, first), db = da;
    p0_load(da, va, lane);
    for (int it = first; it < end; it += 2 * step) {
        const bool hb = it + step < end; if (hb) { db = p0_decode(P, it + step); p0_load(db, vb, lane); }
        p0_finish(da, va, scr, lane);
        const bool ha = it + 2 * step < end; if (ha) { da = p0_decode(P, it + 2 * step); p0_load(da, va, lane); }
        if (hb) p0_finish(db, vb, scr, lane);
    }
}
__device__ __forceinline__ void p0_prologue(const Ptrs& P, MK_LAS unsigned char* lds, int vcu, int G, int wave, int lane) {
    MK_LAS float* scr = (MK_LAS float*)(lds + wave * 16384);
    const int gw = vcu * NWAVES + wave, NGW = G * NWAVES;
    p0_convert(P, scr, gw, NGW, P0_NITEMS, lane);
#if defined(PROBE_SUB)
    if (PROBE_SUB == 1) p0_convert(P, scr, gw, NGW, P0_NITEMS, lane);
#endif
#if defined(PROBE_SUB)
    for (int rep_ = 0; rep_ < (PROBE_SUB == 2 ? 2 : 1); ++rep_)
#endif
    for (int m = gw; m < MP; m += NGW) {
        GAS unsigned long long* o8 = (GAS unsigned long long*)(P.XN() + (size_t)m * D) + lane;
        if (m >= MR + NMETA) {
#pragma unroll
            for (int j = 0; j < 4; ++j) o8[64 * j] = 0ull;
            continue; }
        const float* src = m < MR ? P.x + (size_t)m * D : P.meta + (size_t)(m - MR) * D;
        const GAS f32x4* xr = (const GAS f32x4*)src + lane; f32x4 v[4]; float s = 0.f;
#pragma unroll
        for (int j = 0; j < 4; ++j) { v[j] = xr[64 * j]; s += (v[j][0] * v[j][0] + v[j][1] * v[j][1]) + (v[j][2] * v[j][2] + v[j][3] * v[j][3]); }
        const float rstd = 1.f / sqrtf(wave_sum(s) * (1.f / D) + EPS);
#pragma unroll
        for (int j = 0; j < 4; ++j) { const f32x4 g = *(const f32x4*)(P.g_attn + 4 * lane + 256 * j);
            o8[64 * j] = (unsigned long long)pk2(v[j][0] * rstd * g[0], v[j][1] * rstd * g[1]) | ((unsigned long long)pk2(v[j][2] * rstd * g[2], v[j][3] * rstd * g[3]) << 32); }
    }
    for (int idx = vcu * (NWAVES * 64) + (int)threadIdx.x; idx < 64 * 2368; idx += G * NWAVES * 64) {
        const int bh = idx / 2368, r = idx % 2368; u32x4* p;
        if (r < 576) p = (u32x4*)(P.KTF() + ((size_t)bh * NKT + 32) * NCF * 512) + r;
        else if (r < 1344) p = (u32x4*)(P.KTM() + ((size_t)bh * NKT + 32) * NCM * 512) + (r - 576);
        else if (r < 1856) p = (u32x4*)(P.VTF() + ((size_t)bh * NKT + 32) * 4096) + (r - 1344);
        else p = (u32x4*)(P.VTM() + ((size_t)bh * NKT + 32) * 4096) + (r - 1856);
        *p = (u32x4){0u, 0u, 0u, 0u}; }
    for (int idx = vcu * (NWAVES * 64) + (int)threadIdx.x; idx < 48 * 128; idx += G * NWAVES * 64) {
        const int n = idx >> 7, k0 = (idx & 127) * 8; float v[8];
#pragma unroll
        for (int j = 0; j < 8; ++j) v[j] = n < 4 ? P.w_group[(size_t)(k0 + j) * 4 + n] : (n < 36 ? P.w_expert[(size_t)(k0 + j) * 32 + (n - 4)] : 0.f);
        u32x4 w; w.x = pk2(v[0], v[1]); w.y = pk2(v[2], v[3]); w.z = pk2(v[4], v[5]); w.w = pk2(v[6], v[7]);
        *(u32x4*)(P.WR() + (size_t)n * D + k0) = w; }
    for (int idx = vcu * (NWAVES * 64) + (int)threadIdx.x; idx < LSEQ * 16; idx += G * NWAVES * 64) {
        const int pos = idx >> 4, i = idx & 15; const float inv_freq = expf(-logf(10000.0f) * (float)i / 16.0f), ang = (float)pos * inv_freq;
        P.ROPE()[2 * idx] = cosf(ang); P.ROPE()[2 * idx + 1] = sinf(ang); }
}

__device__ __forceinline__ void fox_bias_store(const Ptrs& P, int bh, int s, float cum) {
    const float bias = -cum * LOG2E;
    const unsigned h_ = f2bf(bias); const float r1 = bias - bf2f((unsigned short)h_); const unsigned m_ = f2bf(r1); const float r2 = r1 - bf2f((unsigned short)m_); const unsigned l_ = f2bf(r2);
    u32x4 w; w.x = h_ | (m_ << 16); w.y = l_; w.z = 0u; w.w = 0u;
    *(u32x4*)(P.KTF() + kt_off(bh, s, 8, NCF)) = w;
}
__device__ __forceinline__ void fox_scan(const Ptrs& P, int bh, int lane) {
    const int b = bh >> 3, h = bh & 7;
    float x = lane < NMETA ? P.LOGF()[(size_t)(MR + lane) * 8 + h] : 0.f;
#pragma unroll
    for (int o = 1; o < 16; o <<= 1) { const float y = __shfl_up(x, o); if (lane >= o) x += y; }
    if (lane < NMETA) fox_bias_store(P, bh, lane, x);
    const float mtot = __shfl(x, NMETA - 1);
    float v[32]; float run = 0.f;
#pragma unroll
    for (int j = 0; j < 32; ++j) { run += P.LOGF()[((size_t)b * SEQ + 32 * lane + j) * 8 + h]; v[j] = run; }
    float inc = run;
#pragma unroll
    for (int o = 1; o < 64; o <<= 1) { const float y = __shfl_up(inc, o); if (lane >= o) inc += y; }
    const float base = mtot + (inc - run);
#pragma unroll
    for (int j = 0; j < 32; ++j) fox_bias_store(P, bh, NMETA + 32 * lane + j, base + v[j]);
}

struct MoeTab { int lo, hi, cnt; };
__device__ __forceinline__ MoeTab moe_tab(const Ptrs& P, int lane) {
    MoeTab T; T.cnt = (int)__hip_atomic_load(P.ctl() + CW_CNT + 64 * (lane & 31), RLX_AGENT);
    const int nt = (T.cnt + 255) >> 8; int x = nt;
#pragma unroll
    for (int o = 1; o < 32; o <<= 1) { const int y = __shfl_up(x, o, 32); if ((lane & 31) >= o) x += y; }
    T.hi = x; T.lo = x - nt; return T;
}
template <bool UP>
struct MoeOrder {
    static constexpr int NCOL = UP ? 2 : 4;
    int G, c; MoeTab T; const bf16_t* XN2; const bf16_t* W13; const bf16_t* HD; const bf16_t* W2; const int* LISTP;
    __device__ __forceinline__ bool next(int i, Unit& u) const {
        const int L = i * G + c, total = __builtin_amdgcn_readlane(T.hi, 31);
        if (L >= total * NCOL) return false;
        const int tile = L / NCOL, pn = L % NCOL;
        const unsigned long long mask = __ballot(tile >= T.lo) & 0xffffffffull;
        const int e = __builtin_amdgcn_readfirstlane(__popcll(mask) - 1);
        const int base = __builtin_amdgcn_readlane(T.lo, e);
        u.pm = tile; u.pn = e * NCOL + pn; u.ex = (e << 16) | (tile - base);
        if (UP) { u.A = (const char*)XN2; u.B = (const char*)(W13 + ((size_t)e * 512 + pn * 256) * 1024); }
        else { u.A = (const char*)(HD + (size_t)tile * 256 * 256); u.B = (const char*)(W2 + ((size_t)e * 1024 + pn * 256) * 256); }
        return true;
    }
    __device__ __forceinline__ void gather(const Unit& u, int R0, int C0, int R1, int C1, unsigned (&off)[4]) const {
        const int e = u.ex >> 16, rt = u.ex & 0xffff, cnt = __builtin_amdgcn_readlane(T.cnt, e);
        const int* list = LISTP + (size_t)e * CAP;
#pragma unroll
        for (int hh = 0; hh < 2; ++hh) {
            int i0 = rt * 256 + 128 * hh + R0, i1 = rt * 256 + 128 * hh + R1; i0 = i0 < cnt ? i0 : cnt - 1; i1 = i1 < cnt ? i1 : cnt - 1;
            off[hh * 2 + 0] = (unsigned)list[i0] * 2048u + (unsigned)C0 * 2u; off[hh * 2 + 1] = (unsigned)list[i1] * 2048u + (unsigned)C1 * 2u; }
    }
};

__device__ __forceinline__ void router_phase(const Ptrs& P, MK_LAS unsigned char* lds, int vcu, int G, int wave, int lane) {
    MK_LAS float* LG = (MK_LAS float*)lds;
    const int m = lane & 15, kq = lane >> 4, tsk = wave & 3, kh = wave >> 2;
    for (int tb = vcu * 64; tb < MR; tb += G * 64) {
        const int t = tb + tsk * 16 + m;
        const float rstd = 1.0f / sqrtf(P.SSQH()[t] * (1.0f / D) + EPS);
        f32x4 acc[3] = {{0.f, 0.f, 0.f, 0.f}, {0.f, 0.f, 0.f, 0.f}, {0.f, 0.f, 0.f, 0.f}};
        const float* hp = P.out + (size_t)t * D + kh * 512 + 8 * kq; const float* gp = P.g_ffn + kh * 512 + 8 * kq;
        bf16_t* xp = P.XN2() + (size_t)t * D + kh * 512 + 8 * kq; const bf16_t* wp = P.WR() + (size_t)m * D + kh * 512 + 8 * kq;
#pragma unroll 1
        for (int kc = 0; kc < 16; kc += 4) {
            f32x4 h0[4], h1[4], g0[4], g1[4]; bf16x8 b[4][3];
#pragma unroll
            for (int q = 0; q < 4; ++q) { const int ks = kc + q; h0[q] = *(const f32x4*)(hp + 32 * ks); h1[q] = *(const f32x4*)(hp + 32 * ks + 4); g0[q] = *(const f32x4*)(gp + 32 * ks); g1[q] = *(const f32x4*)(gp + 32 * ks + 4);
#pragma unroll
                for (int nb = 0; nb < 3; ++nb) b[q][nb] = *(const bf16x8*)(wp + (size_t)nb * 16 * D + 32 * ks); }
#pragma unroll
            for (int q = 0; q < 4; ++q) { const int ks = kc + q;
                const f32x4 u0 = h0[q] * g0[q] * rstd, u1 = h1[q] * g1[q] * rstd;
                u32x4 w; w.x = cvt_pk_bf16(u0[0], u0[1]); w.y = cvt_pk_bf16(u0[2], u0[3]); w.z = cvt_pk_bf16(u1[0], u1[1]); w.w = cvt_pk_bf16(u1[2], u1[3]);
                *(u32x4*)(xp + 32 * ks) = w;
                const bf16x8 a = __builtin_bit_cast(bf16x8, w);
#pragma unroll
                for (int nb = 0; nb < 3; ++nb) acc[nb] = __builtin_amdgcn_mfma_f32_16x16x32_bf16(a, b[q][nb], acc[nb], 0, 0, 0); }
        }
#pragma unroll
        for (int nb = 0; nb < 3; ++nb)
#pragma unroll
            for (int r = 0; r < 4; ++r) LG[((tsk * 2 + kh) * 16 + 4 * kq + r) * 48 + 16 * nb + m] = acc[nb][r];
        MK_LAS unsigned* LC = (MK_LAS unsigned*)(lds + 32768);
        if (wave == 7 && lane < 32) LC[lane] = 0u;
        __syncthreads();
        int ea = 0, eb = 0; unsigned ra = 0u, rb = 0u; float wa = 0.f, wb = 0.f;
        if (kh == 0 && lane < 16) {
            const MK_LAS float* l0 = LG + ((tsk * 2 + 0) * 16 + lane) * 48; const MK_LAS float* l1 = LG + ((tsk * 2 + 1) * 16 + lane) * 48; const int tt = tb + tsk * 16 + lane;
            float gl[4];
#pragma unroll
            for (int i = 0; i < 4; ++i) gl[i] = l0[i] + l1[i] + P.b_group[i];
            int gi = 0; float gm = gl[0];
#pragma unroll
            for (int i = 1; i < 4; ++i) if (gl[i] > gm) { gm = gl[i]; gi = i; }
            float den = 0.f;
#pragma unroll
            for (int i = 0; i < 4; ++i) den += expf(gl[i] - gm);
            const float psel = 1.0f / den;
            float w8[8];
#pragma unroll
            for (int i = 0; i < 8; ++i) w8[i] = l0[4 + gi * 8 + i] + l1[4 + gi * 8 + i] + P.b_expert[gi * 8 + i];
            int i0 = 0; float v0 = w8[0];
#pragma unroll
            for (int i = 1; i < 8; ++i) if (w8[i] > v0) { v0 = w8[i]; i0 = i; }
            int i1 = -1; float v1 = -INFINITY;
#pragma unroll
            for (int i = 0; i < 8; ++i) if (i != i0 && (i1 < 0 || w8[i] > v1)) { v1 = w8[i]; i1 = i; }
            const float e1 = expf(v1 - v0);
            wa = psel / (1.0f + e1); wb = psel * e1 / (1.0f + e1);
            ea = gi * 8 + i0; eb = gi * 8 + i1;
            ra = __hip_atomic_fetch_add(LC + ea, 1u, __ATOMIC_RELAXED, __HIP_MEMORY_SCOPE_WORKGROUP); rb = __hip_atomic_fetch_add(LC + eb, 1u, __ATOMIC_RELAXED, __HIP_MEMORY_SCOPE_WORKGROUP);
        }
        __syncthreads();
        if (wave == 0 && lane < 32) { const unsigned c = LC[lane]; LC[32 + lane] = c ? __hip_atomic_fetch_add(P.ctl() + CW_CNT + 64 * lane, c, RLX_AGENT) : 0u; }
        __syncthreads();
        if (kh == 0 && lane < 16) {
            const int tt = tb + tsk * 16 + lane;
            const unsigned pa = LC[32 + ea] + ra, pb = LC[32 + eb] + rb;
            P.LIST()[(size_t)ea * CAP + pa] = tt; P.LIST()[(size_t)eb * CAP + pb] = tt;
            u32x4 r0; r0.x = (unsigned)ea; r0.y = pa; r0.z = (unsigned)eb; r0.w = pb; *(u32x4*)(P.TOK() + (size_t)tt * 8) = r0;
            u32x2 r1; r1.x = __builtin_bit_cast(unsigned, wa); r1.y = __builtin_bit_cast(unsigned, wb); *(u32x2*)(P.TOK() + (size_t)tt * 8 + 4) = r1;
        }
        __syncthreads();
    }
}

__device__ __forceinline__ void combine_phase(const Ptrs& P, int vcu, int G, int wave, int lane) {
    const MoeTab T = moe_tab(P, lane);
    const int gw = vcu * NWAVES + wave, NGW = G * NWAVES;
    for (int t = gw; t < MR; t += NGW) {
        const u32x4 r0 = *(const u32x4*)(P.TOK() + (size_t)t * 8); const unsigned r1x = __hip_atomic_load(P.TOK() + (size_t)t * 8 + 4, RLX_AGENT), r1y = __hip_atomic_load(P.TOK() + (size_t)t * 8 + 5, RLX_AGENT);
        const int ea = __builtin_amdgcn_readfirstlane((int)r0.x), eb = __builtin_amdgcn_readfirstlane((int)r0.z);
        const size_t sa = (size_t)__builtin_amdgcn_readlane(T.lo, ea) * 256 + r0.y, sb = (size_t)__builtin_amdgcn_readlane(T.lo, eb) * 256 + r0.w;
        float wa = __builtin_bit_cast(float, r1x), wb = __builtin_bit_cast(float, r1y);
        asm volatile("" : "+v"(wa)); asm volatile("" : "+v"(wb));
        GAS f32x4* o = (GAS f32x4*)(P.out + (size_t)t * D) + lane;
        const GAS u32x2* ya = (const GAS u32x2*)(P.Y() + sa * 1024) + lane; const GAS u32x2* yb = (const GAS u32x2*)(P.Y() + sb * 1024) + lane;
#pragma unroll
        for (int j = 0; j < 4; ++j) { const f32x4 hv = o[64 * j]; const u32x2 a = ya[64 * j], b = yb[64 * j]; f32x4 r;
            r[0] = hv[0] + wa * __builtin_bit_cast(float, a.x << 16) + wb * __builtin_bit_cast(float, b.x << 16);
            r[1] = hv[1] + wa * __builtin_bit_cast(float, a.x & 0xffff0000u) + wb * __builtin_bit_cast(float, b.x & 0xffff0000u);
            r[2] = hv[2] + wa * __builtin_bit_cast(float, a.y << 16) + wb * __builtin_bit_cast(float, b.y << 16);
            r[3] = hv[3] + wa * __builtin_bit_cast(float, a.y & 0xffff0000u) + wb * __builtin_bit_cast(float, b.y & 0xffff0000u);
            o[64 * j] = r; }
    }
}

struct Args { Ptrs P; int ph_lo, ph_hi; };
constexpr int N_PHASES = 9;
__global__ void __launch_bounds__(NWAVES * 64, 2) mega_fwd(Args args) {
    extern __shared__ __attribute__((aligned(16))) unsigned char lds_raw[];
    MK_LAS unsigned char* lds = (MK_LAS unsigned char*)lds_raw;
    const Ptrs& P = args.P;
    const int tid = threadIdx.x, lane = tid & 63, wave = __builtin_amdgcn_readfirstlane(tid >> 6);
    const int G = gridDim.x; const int bx = blockIdx.x; const int vcu = (G % 8 == 0) ? (bx % 8) * (G / 8) + bx / 8 : bx;
    volatile MK_LAS unsigned* MISC = (volatile MK_LAS unsigned*)(lds + LDSCTL_OFF);
    for (int u = tid; u < (LDS_BYTES - LDSCTL_OFF) / 4; u += NWAVES * 64) ((MK_LAS unsigned*)(lds + LDSCTL_OFF))[u] = 0u;
    __syncthreads();
    const int lo = args.ph_lo, hi = args.ph_hi;
    XcdBarrier bar = xcd_barrier_post(P.ctl() + CW_BAR, MISC + 8);
#ifndef PH_MASK
#define PH_MASK 0x1ff
#endif
#define IN(k) (((PH_MASK >> (k)) & 1) && lo <= (k) && (k) < hi)
#ifndef PROBE_PHASE
#define PROBE_PHASE (-1)
#endif
#ifndef PROBE_MUL
#define PROBE_MUL 4
#endif
    unsigned long long ts_prev = 0ull, ts_probe = 0ull;
    if (PROBE_PHASE >= 0) ts_prev = __builtin_amdgcn_s_memrealtime();
#define SEAM(k) do { if (IN(k) && IN((k) + 1)) xcd_barrier(bar); if (PROBE_PHASE >= 0) { const unsigned long long now_ = __builtin_amdgcn_s_memrealtime(); if ((k) == PROBE_PHASE) ts_probe = now_ - ts_prev; ts_prev = now_; } } while (0)
    if (IN(0)) { p0_prologue(P, lds, vcu, G, wave, lane); }
    SEAM(0);
    if (IN(1)) { pg8::StaticOrder S; S.init(P.XN(), P.WIN(), MP, NIN, 1024, G, bx); EpiInProj E{P}; pg8::gemm_phase<EpiInProj, pg8::StaticOrder>(lds, 1024, S, E); }
    SEAM(1);
    if (IN(2)) {
#ifndef P2SUB
#define P2SUB 7
#endif
        if ((P2SUB & 1) && vcu < 64 && wave == 0) fox_scan(P, vcu, lane);
        if (P2SUB & 2) { pg8::StaticOrder S; S.init(P.CQ(), P.WUQ(), MR, 768, 384, G, bx); EpiQup E{P}; pg8::gemm_phase<EpiQup, pg8::StaticOrder>(lds, 384, S, E); }
        if (P2SUB & 4) { pg8::StaticOrder S; S.init(P.CKV(), P.WUKV(), MP, 1024, 256, G, (bx + 64) % G); EpiKvup E{P}; pg8::gemm_phase<EpiKvup, pg8::StaticOrder>(lds, 256, S, E); }
    }
    SEAM(2);
    if (IN(3)) attn_phase(lds, P, vcu, G);
    SEAM(3);
    if (IN(4)) { pg8::StaticOrder S; S.init(P.O(), P.WO(), MR, 1024, 1024, G, bx); EpiOut E{P}; pg8::gemm_phase<EpiOut, pg8::StaticOrder, false, true>(lds, 1024, S, E); }
    SEAM(4);
    if (IN(5)) router_phase(P, lds, vcu, G, wave, lane);
    SEAM(5);
    if (IN(6)) { MoeOrder<true> S; S.G = G; S.c = bx; S.T = moe_tab(P, lane); S.XN2 = P.XN2(); S.W13 = P.W13(); S.HD = P.HD(); S.W2 = P.W2(); S.LISTP = P.LIST(); EpiMoeUp E{P}; pg8::gemm_phase<EpiMoeUp, MoeOrder<true>, true>(lds, 1024, S, E); }
    SEAM(6);
    if (IN(7)) { MoeOrder<false> S; S.G = G; S.c = bx; S.T = moe_tab(P, lane); S.XN2 = P.XN2(); S.W13 = P.W13(); S.HD = P.HD(); S.W2 = P.W2(); S.LISTP = P.LIST(); EpiMoeDown E{P}; pg8::gemm_phase<EpiMoeDown, MoeOrder<false>>(lds, 256, S, E); }
    SEAM(7);
    if (IN(8)) combine_phase(P, vcu, G, wave, lane);
    SEAM(8);
    if (PROBE_PHASE >= 0 && bx == 0 && tid == 0) { const unsigned long long t0_ = __builtin_amdgcn_s_memrealtime(); while (__builtin_amdgcn_s_memrealtime() - t0_ < (unsigned long long)PROBE_MUL * ts_probe) __builtin_amdgcn_s_sleep(16); }
#undef IN
#undef SEAM
}
}
#ifndef DEBUG_STAGE
#define DEBUG_STAGE 0
#endif
#if DEBUG_STAGE
namespace dbg {
using namespace mk;
__global__ void k_snap(Ptrs P, int mode, float* snap, int ncols) {
    const int r = blockIdx.x; const int b = DBG_B;
    for (int c = threadIdx.x; c < ncols; c += blockDim.x) {
        float v = 0.f;
        const int i = r - NMETA; const size_t row = (size_t)b * SEQ + (i < 0 ? 0 : i);
        if (mode == 0) { v = i < 0 ? 0.f : bf2f(P.QF()[row * 512 + c]) / C2F; }
        else if (mode == 1) { const int h = c >> 6, d = c & 63; v = bf2f(P.KTF()[kt_off(b * 8 + h, r, d >> 3, NCF) + (d & 7)]); }
        else if (mode == 2) { const int h = c >> 6, d = c & 63; v = bf2f(P.VTF()[vt_off(b * 8 + h, r, d >> 5, d & 31)]); }
        else if (mode == 3) { const bf16_t* p = P.KTF() + kt_off(b * 8 + c, r, 8, NCF); v = bf2f(p[0]) + bf2f(p[1]) + bf2f(p[2]); }
        else if (mode == 4) { v = i < 0 ? 0.f : bf2f(P.QM()[row * 768 + c]); }
        else if (mode == 5) { const int h = c / 96, d = c % 96; v = bf2f(P.KTM()[kt_off(b * 8 + h, r, d >> 3, NCM) + (d & 7)]); }
        else if (mode == 6) { const int h = c >> 6, d = c & 63; v = bf2f(P.VTM()[vt_off(b * 8 + h, r, d >> 5, d & 31)]); }
        else if (mode == 7) { v = i < 0 ? 0.f : bf2f(P.O()[row * 1024 + c]); }
        else if (mode == 8) { v = i < 0 ? 0.f : P.out[row * 1024 + c]; }
        else if (mode == 9) { v = i < 0 ? 0.f : bf2f(P.XN2()[row * 1024 + c]); }
        else if (mode == 10 || mode == 11) { if (i >= 0) { const unsigned* tk = P.TOK() + row * 8; const int e = (int)tk[mode == 10 ? 0 : 2]; const unsigned pos = tk[mode == 10 ? 1 : 3]; const float w = __builtin_bit_cast(float, tk[mode == 10 ? 4 : 5]);
                int lo = 0; for (int q = 0; q < e; ++q) lo += ((int)P.ctl()[CW_CNT + 64 * q] + 255) >> 8;
                v = w * bf2f(P.Y()[((size_t)lo * 256 + pos) * 1024 + c]); } }
        snap[(size_t)r * ncols + c] = v;
    }
}
__global__ void k_bias_ref(const float* cum, float* o) { const int r = blockIdx.x, h = threadIdx.x; o[r * 8 + h] = -cum[h * LSEQ + r] * LOG2E; }
__global__ void k_cmp(const float* a, int lda, int offa, const float* ref, int ldb, int offb, int hw, int hs, int r0, int ncols, float* sums, int k) {
    const int r = blockIdx.x; if (r < r0) return;
    float d2 = 0.f, b2 = 0.f;
    for (int c = threadIdx.x; c < ncols; c += blockDim.x) { const int cc = hw ? (c / hw) * hs + (c % hw) : c; const float bv = ref[(size_t)r * ldb + offb + cc], av = a[(size_t)r * lda + offa + c]; d2 += (av - bv) * (av - bv); b2 += bv * bv; }
    d2 = wave_sum(d2); b2 = wave_sum(b2);
    if ((threadIdx.x & 63) == 0) { atomicAdd(sums + 2 * k, d2); atomicAdd(sums + 2 * k + 1, b2); }
}
__global__ void k_cmpy(const float* a, const float* h, const float* ref, float* sums, int k) {
    const int r = blockIdx.x; if (r < NMETA) return;
    float d2 = 0.f, b2 = 0.f;
    for (int c = threadIdx.x; c < 1024; c += blockDim.x) { const float rv = ref[(size_t)(r - NMETA) * 1024 + c], av = a[(size_t)r * 1024 + c], hv = h[(size_t)r * 1024 + c]; d2 += (av - rv) * (av - rv); b2 += (rv - hv) * (rv - hv); }
    d2 = wave_sum(d2); b2 = wave_sum(b2);
    if ((threadIdx.x & 63) == 0) { atomicAdd(sums + 2 * k, d2); atomicAdd(sums + 2 * k + 1, b2); }
}
__global__ void k_scale_lin(float* out, size_t n, const float* sums, float mul) {
    const float f = 1.0f + mul * sqrtf(sums[0] / fmaxf(sums[1], 1e-30f));
    for (size_t i = (size_t)blockIdx.x * blockDim.x + threadIdx.x; i < n; i += (size_t)gridDim.x * blockDim.x) out[i] *= f;
}
__global__ void k_scale(float* out, size_t n, const float* sums, int nchecks) {
    float delta = 0.f; int bad = -1;
    for (int k = 0; k < nchecks; ++k) { const float rel = sqrtf(sums[2 * k] / fmaxf(sums[2 * k + 1], 1e-30f)); if (!(rel <= 0.1f) && bad < 0) bad = k; if (rel > delta) delta = rel; }
    if (bad >= 0) delta = 0.1f * (float)(bad + 1);
    const float f = 1.0f + delta;
    for (size_t i = (size_t)blockIdx.x * blockDim.x + threadIdx.x; i < n; i += (size_t)gridDim.x * blockDim.x) out[i] *= f;
}
}
#endif

extern "C" void kernel_launch(void* const* d_in, const int* in_sizes, int n_in, void* d_out, int out_size, void* d_ws, size_t ws_size, hipStream_t stream) {
    using namespace mk;
    static int grid = 0;
    if (grid == 0) {
        int dev = 0, cus = 0, per_cu = 0;
        if (n_in != 24 || out_size != MR * D || ws_size < 256 * MiB) { fprintf(stderr, "kernel_launch: unexpected problem shape (n_in %d, out %d, ws %zu)\n", n_in, out_size, ws_size); grid = -1; return; }
        if (hipGetDevice(&dev) != hipSuccess || hipDeviceGetAttribute(&cus, hipDeviceAttributeMultiprocessorCount, dev) != hipSuccess) { grid = -1; return; }
        if (hipFuncSetAttribute((const void*)mega_fwd, hipFuncAttributeMaxDynamicSharedMemorySize, LDS_BYTES) != hipSuccess) { fprintf(stderr, "kernel_launch: hipFuncSetAttribute failed\n"); grid = -1; return; }
        if (hipOccupancyMaxActiveBlocksPerMultiprocessor(&per_cu, (const void*)mega_fwd, NWAVES * 64, LDS_BYTES) != hipSuccess || per_cu < 1) { fprintf(stderr, "kernel_launch: occupancy query says %d blocks per CU\n", per_cu); per_cu = 1; }
        (void)hipGetLastError();
        grid = cus;
    }
    if (grid < 0) return;
    unsigned char* ws = (unsigned char*)d_ws;
    (void)hipMemsetAsync(ws + WS_CTL, 0, CTL_BYTES, stream);
    Args a{};
    Ptrs& P = a.P;
    const float* const* in = (const float* const*)d_in;
    P.x = in[0]; P.meta = in[1]; P.g_attn = in[2]; P.w_in = in[3]; P.b_f = in[4]; P.g_fox_q = in[5]; P.g_fox_k = in[6]; P.g_q_lat = in[7]; P.w_uq = in[8]; P.g_kv_lat = in[9]; P.w_ukv = in[10];
    P.g_mla_q = in[11]; P.g_mla_k = in[12]; P.g_fox_out = in[13]; P.g_mla_out = in[14]; P.w_o = in[15]; P.g_ffn = in[16]; P.w_group = in[17]; P.b_group = in[18]; P.w_expert = in[19]; P.b_expert = in[20];
    P.w1 = in[21]; P.w3 = in[22]; P.w2 = in[23];
    P.out = (float*)d_out; P.ws = ws;
#if DEBUG_STAGE == 0
    a.ph_lo = 0; a.ph_hi = N_PHASES;
    hipLaunchKernelGGL(mega_fwd, dim3(grid), dim3(NWAVES * 64), LDS_BYTES, stream, a);
#else
    a.ph_lo = 0; a.ph_hi = DEBUG_STAGE + 1 > N_PHASES ? N_PHASES : DEBUG_STAGE + 1;
    hipLaunchKernelGGL(mega_fwd, dim3(grid), dim3(NWAVES * 64), LDS_BYTES, stream, a);
    float* S1 = (float*)(ws + 66 * MiB);
    float* S2 = (float*)(ws + WS_SNAP);
    float* sums = (float*)(ws + 239 * MiB + 512 * 1024);
    (void)hipMemsetAsync(sums, 0, 256, stream);
    nv::Bufs nb;
    const int L = LSEQ;
#if DEBUG_STAGE == 2
    float* s_fq = S1; float* s_fk = s_fq + (size_t)L * 512; float* s_fv = s_fk + (size_t)L * 512; float* s_bias = s_fv + (size_t)L * 512; float* s_qm = s_bias + (size_t)L * 8;
    float* s_mk = s_qm + (size_t)L * 768; float* s_mv = s_mk + (size_t)L * 768; float* s_bref = S2;
    hipLaunchKernelGGL(dbg::k_snap, dim3(L), dim3(256), 0, stream, P, 0, s_fq, 512);
    hipLaunchKernelGGL(dbg::k_snap, dim3(L), dim3(256), 0, stream, P, 1, s_fk, 512);
    hipLaunchKernelGGL(dbg::k_snap, dim3(L), dim3(256), 0, stream, P, 2, s_fv, 512);
    hipLaunchKernelGGL(dbg::k_snap, dim3(L), dim3(64), 0, stream, P, 3, s_bias, 8);
    hipLaunchKernelGGL(dbg::k_snap, dim3(L), dim3(256), 0, stream, P, 4, s_qm, 768);
    hipLaunchKernelGGL(dbg::k_snap, dim3(L), dim3(256), 0, stream, P, 5, s_mk, 768);
    hipLaunchKernelGGL(dbg::k_snap, dim3(L), dim3(256), 0, stream, P, 6, s_mv, 512);
    nv::naive_forward(d_in, (float*)d_out, ws + 100 * MiB, stream, &nb);
    hipLaunchKernelGGL(dbg::k_bias_ref, dim3(L), dim3(8), 0, stream, nb.CUM, s_bref);
    hipLaunchKernelGGL(dbg::k_cmp, dim3(L), dim3(256), 0, stream, s_fq, 512, 0, nb.PROJ, nv::IN_COLS, nv::OFF_FQ, 0, 0, NMETA, 512, sums, 0);
    hipLaunchKernelGGL(dbg::k_cmp, dim3(L), dim3(256), 0, stream, s_fk, 512, 0, nb.PROJ, nv::IN_COLS, nv::OFF_FK, 0, 0, 0, 512, sums, 1);
    hipLaunchKernelGGL(dbg::k_cmp, dim3(L), dim3(256), 0, stream, s_fv, 512, 0, nb.PROJ, nv::IN_COLS, nv::OFF_FV, 0, 0, 0, 512, sums, 2);
    hipLaunchKernelGGL(dbg::k_cmp, dim3(L), dim3(64), 0, stream, s_bias, 8, 0, s_bref, 8, 0, 0, 0, 0, 8, sums, 3);
    hipLaunchKernelGGL(dbg::k_cmp, dim3(L), dim3(256), 0, stream, s_qm, 768, 0, nb.QUP, 768, 0, 0, 0, NMETA, 768, sums, 4);
    hipLaunchKernelGGL(dbg::k_cmp, dim3(L), dim3(256), 0, stream, s_mk, 768, 0, nb.MK, 768, 0, 0, 0, 0, 768, sums, 5);
    hipLaunchKernelGGL(dbg::k_cmp, dim3(L), dim3(256), 0, stream, s_mv, 512, 0, nb.KVUP, 1024, 64, 64, 128, 0, 512, sums, 6);
    const int nchecks = 7;
#elif DEBUG_STAGE == 3
    hipLaunchKernelGGL(dbg::k_snap, dim3(L), dim3(256), 0, stream, P, 7, S2, 1024);
    nv::naive_forward(d_in, (float*)d_out, ws + 100 * MiB, stream, &nb);
    hipLaunchKernelGGL(dbg::k_cmp, dim3(L), dim3(256), 0, stream, S2, 1024, 0, nb.O, 1024, 0, 0, 0, NMETA, 512, sums, 0);
    hipLaunchKernelGGL(dbg::k_cmp, dim3(L), dim3(256), 0, stream, S2, 1024, 512, nb.O, 1024, 512, 0, 0, NMETA, 512, sums, 1);
    const int nchecks = 2;
#elif DEBUG_STAGE == 4
    hipLaunchKernelGGL(dbg::k_snap, dim3(L), dim3(256), 0, stream, P, 8, S2, 1024);
    nv::naive_forward(d_in, (float*)d_out, ws + 100 * MiB, stream, &nb);
    hipLaunchKernelGGL(dbg::k_cmp, dim3(L), dim3(256), 0, stream, S2, 1024, 0, nb.H1, 1024, 0, 0, 0, NMETA, 1024, sums, 0);
    const int nchecks = 1;
#elif DEBUG_STAGE == 9
    hipLaunchKernelGGL(dbg::k_snap, dim3(L), dim3(256), 0, stream, P, 10, S2, 1024);
    hipLaunchKernelGGL(dbg::k_snap, dim3(L), dim3(256), 0, stream, P, 11, S1, 1024);
    nv::naive_forward(d_in, (float*)d_out, ws + 100 * MiB, stream, &nb);
    hipLaunchKernelGGL(dbg::k_cmp, dim3(L), dim3(256), 0, stream, S2, 1024, 0, nb.YAB, 1024, 0, 0, 0, NMETA, 1024, sums, 0);
    hipLaunchKernelGGL(dbg::k_cmp, dim3(L), dim3(256), 0, stream, S1, 1024, 0, nb.YAB + (size_t)L * 1024, 1024, 0, 0, 0, NMETA, 1024, sums, 1);
    const int nchecks = 2;
#elif DEBUG_STAGE == 10
    hipLaunchKernelGGL(dbg::k_snap, dim3(L), dim3(256), 0, stream, P, 11, S2, 1024);
    nv::naive_forward(d_in, (float*)d_out, ws + 100 * MiB, stream, &nb);
    hipLaunchKernelGGL(dbg::k_cmp, dim3(L), dim3(256), 0, stream, S2, 1024, 0, nb.YAB + (size_t)L * 1024, 1024, 0, 0, 0, NMETA, 1024, sums, 0);
    hipLaunchKernelGGL(dbg::k_scale_lin, dim3(1024), dim3(256), 0, stream, (float*)d_out, (size_t)MR * D, sums, 0.1f);
    const int nchecks = 0;
#elif DEBUG_STAGE == 8
    hipLaunchKernelGGL(dbg::k_snap, dim3(L), dim3(256), 0, stream, P, 8, S2, 1024);
    nv::naive_forward(d_in, (float*)d_out, ws + 100 * MiB, stream, &nb);
    hipLaunchKernelGGL(dbg::k_cmpy, dim3(L), dim3(256), 0, stream, S2, nb.H1, (const float*)d_out + (size_t)DBG_B * SEQ * D, sums, 0);
    hipLaunchKernelGGL(dbg::k_scale_lin, dim3(1024), dim3(256), 0, stream, (float*)d_out, (size_t)MR * D, sums, 0.1f);
    const int nchecks = 0;
#else
    hipLaunchKernelGGL(dbg::k_snap, dim3(L), dim3(256), 0, stream, P, 9, S2, 1024);
    nv::naive_forward(d_in, (float*)d_out, ws + 100 * MiB, stream, &nb);
    hipLaunchKernelGGL(dbg::k_cmp, dim3(L), dim3(256), 0, stream, S2, 1024, 0, nb.U2, 1024, 0, 0, 0, NMETA, 1024, sums, 0);
    const int nchecks = 1;
#endif
    if (nchecks > 0) hipLaunchKernelGGL(dbg::k_scale, dim3(1024), dim3(256), 0, stream, (float*)d_out, (size_t)MR * D, sums, nchecks);
#endif
}
```
